# Optimizing an MI355X kernel written in HIP

```python
import math
import jax, jax.numpy as jnp
from jax import lax
import numpy as np


D_MODEL = 2048
BATCH = 4
SEQ = 4096
DEPTH = 2

GRID_W = 64
CTX_LEN = 256
EPS = 1e-6

MLA_HEADS = 8
MLA_NOPE = 128
MLA_ROPE = 64
MLA_QK = MLA_NOPE + MLA_ROPE
MLA_V = 128
MLA_Q_LORA = 512
MLA_KV_LORA = 512
MLA_WIDTH = MLA_HEADS * MLA_V
ROPE_BASE = 10000.0
ROPE_PAIRS_PER_AXIS = MLA_ROPE // 4
Q_BLOCK = 128

HY_WIDTH = 512
HY_ORDER = 2
HY_BANDS = 16
HY_EMB = 1 + 2 * HY_BANDS
HY_HIDDEN = 64
HY_FILTER_OUT = HY_ORDER * 2 * HY_WIDTH
HY_SHIFT = 0.05
HY_DECAY_MIN = 3.0
HY_DECAY_MAX = 15.0
SHORT_CONV = 3

ML_HEADS = 4
ML_HEAD_DIM = 128
ML_WIDTH = ML_HEADS * ML_HEAD_DIM
ML_CHUNK = 128
ML_GATES = 4 * ML_HEADS

MIX_WIDTH = MLA_WIDTH + HY_WIDTH + ML_WIDTH
FFN_HIDDEN = ((8 * D_MODEL // 3 + 255) // 256) * 256

IN_SIZES = (MLA_Q_LORA, MLA_KV_LORA, MLA_ROPE, 3 * HY_WIDTH, 2 * ML_WIDTH, ML_WIDTH, ML_WIDTH, ML_GATES)
IN_SPLITS = tuple(sum(IN_SIZES[:i + 1]) for i in range(len(IN_SIZES) - 1))
N_IN = sum(IN_SIZES)

kernel_name = 'hybrid_mla_hyena_mlstm_dit_block'


def rmsnorm(x, g):
    xf = x.astype(jnp.float32)
    y = xf * lax.rsqrt(jnp.mean(xf * xf, axis=-1, keepdims=True) + EPS)
    return (y * g.astype(jnp.float32)).astype(x.dtype)


def modulate(h, shift, scale):
    return h * (1 + scale) + shift


def axial_rope(n_tokens):
    rows = n_tokens // GRID_W
    row = jnp.repeat(jnp.arange(rows, dtype=jnp.float32), GRID_W)
    col = jnp.tile(jnp.arange(GRID_W, dtype=jnp.float32), rows)
    freqs = ROPE_BASE ** (-jnp.arange(ROPE_PAIRS_PER_AXIS, dtype=jnp.float32) / ROPE_PAIRS_PER_AXIS)
    ang = jnp.concatenate([row[:, None] * freqs, col[:, None] * freqs], axis=-1)
    return jnp.cos(ang), jnp.sin(ang)


def apply_rope(x, cos, sin):
    half = x.shape[-1] // 2
    x1, x2 = x[..., :half], x[..., half:]
    cos = cos[None, :, None, :].astype(x.dtype)
    sin = sin[None, :, None, :].astype(x.dtype)
    return jnp.concatenate([x1 * cos - x2 * sin, x2 * cos + x1 * sin], axis=-1)


def short_conv(u, w, b):
    L = u.shape[1]
    pad = SHORT_CONV // 2
    up = jnp.pad(u, ((0, 0), (pad, pad), (0, 0)))
    out = b
    for j in range(SHORT_CONV):
        out = out + up[:, j:j + L] * w[j]
    return out


def mla_heads(cq, ckv, krope, p, rope):
    B, L, _ = cq.shape
    q = (rmsnorm(cq, p['mla_qa_norm']) @ p['mla_w_uq']).reshape(B, L, MLA_HEADS, MLA_QK)
    kv = (rmsnorm(ckv, p['mla_kva_norm']) @ p['mla_w_ukv']).reshape(B, L, MLA_HEADS, MLA_NOPE + MLA_V)
    k_rope = jnp.broadcast_to(krope[:, :, None, :], (B, L, MLA_HEADS, MLA_ROPE))
    k = jnp.concatenate([kv[..., :MLA_NOPE], k_rope], axis=-1)
    v = kv[..., MLA_NOPE:]
    q = rmsnorm(q, p['mla_q_norm'])
    k = rmsnorm(k, p['mla_k_norm'])
    if rope is not None:
        cos, sin = rope
        q = jnp.concatenate([q[..., :MLA_NOPE], apply_rope(q[..., MLA_NOPE:], cos, sin)], axis=-1)
        k = jnp.concatenate([k[..., :MLA_NOPE], apply_rope(k[..., MLA_NOPE:], cos, sin)], axis=-1)
    return q.transpose(0, 2, 1, 3), k.transpose(0, 2, 1, 3), v.transpose(0, 2, 1, 3)


def attend(q, k, v):
    s = jnp.einsum('bhqd,bhkd->bhqk', q, k).astype(jnp.float32) * (MLA_QK ** -0.5)
    pr = jax.nn.softmax(s, axis=-1).astype(v.dtype)
    return jnp.einsum('bhqk,bhkd->bhqd', pr, v)


def block_attention(q, k, v):
    B, H, L, d = q.shape
    nb = L // Q_BLOCK
    qb = jnp.moveaxis(q.reshape(B, H, nb, Q_BLOCK, d), 2, 0)
    ob = lax.map(lambda qi: attend(qi, k, v), qb)
    return jnp.moveaxis(ob, 0, 2).reshape(B, H, L, -1)


def hyena_filter_fft(L, p):
    f32 = lambda a: a.astype(jnp.float32)
    t = jnp.arange(L, dtype=jnp.float32) / L
    bands = jnp.arange(1, HY_BANDS + 1, dtype=jnp.float32)
    ang = 2.0 * math.pi * t[:, None] * bands
    feats = jnp.concatenate([t[:, None], jnp.cos(ang), jnp.sin(ang)], axis=-1)
    h = jnp.sin(feats @ f32(p['hy_w1']) + f32(p['hy_b1']))
    h = jnp.sin(h @ f32(p['hy_w2']) + f32(p['hy_b2']))
    h = (h @ f32(p['hy_w3'])) * (jnp.exp(-t[:, None] * f32(p['hy_decay'])) + HY_SHIFT)
    h = h.reshape(L, HY_ORDER, 2, HY_WIDTH)
    h_fwd, h_bwd = h[:, :, 0], h[:, :, 1]
    buf = jnp.concatenate([h_fwd, jnp.zeros((1, HY_ORDER, HY_WIDTH), jnp.float32), h_bwd[:0:-1]], axis=0)
    return jnp.fft.rfft(buf, axis=0)


def fft_conv(z, kf):
    L = z.shape[1]
    zf = jnp.fft.rfft(z.astype(jnp.float32), n=2 * L, axis=1)
    y = jnp.fft.irfft(zf * kf[None], n=2 * L, axis=1)[:, :L]
    return y.astype(z.dtype)


def hyena(u, p):
    L = u.shape[1]
    v, x1, x2 = jnp.split(short_conv(u, p['hy_conv_w'], p['hy_conv_b']), 3, axis=-1)
    kf = hyena_filter_fft(L, p)
    z = v
    for n, gate in enumerate((x1, x2)):
        z = gate * (fft_conv(z, kf[:, n]) + p['hy_skip'][n] * z)
    return z


def mlstm_inputs(qk, v, gates, p):
    B, L, _ = qk.shape
    qk = jax.nn.silu(short_conv(qk, p['ml_conv_w'], p['ml_conv_b']))
    q, k = jnp.split(qk, 2, axis=-1)
    heads = lambda t: t.reshape(B, L, ML_HEADS, ML_HEAD_DIM).transpose(0, 2, 1, 3).astype(jnp.float32)
    q = heads(q) * (ML_HEAD_DIM ** -0.5)
    k = heads(k)
    v = heads(v)
    g = (gates + p['ml_gate_b']).astype(jnp.float32).reshape(B, L, 4, ML_HEADS).transpose(2, 0, 3, 1)
    log_i = g[:2]
    log_f = jax.nn.log_sigmoid(g[2:])
    return q, k, v, log_i, log_f


def mlstm_scan(q, k, v, log_i, log_f, state):
    B, H, L, _ = q.shape
    nc = L // ML_CHUNK
    chunks = lambda t: jnp.moveaxis(t.reshape((B, H, nc, ML_CHUNK) + t.shape[3:]), 2, 0)
    causal = jnp.tril(jnp.ones((ML_CHUNK, ML_CHUNK), dtype=bool))

    def step(carry, inp):
        C, n, m = carry
        qc, kc, vc, lic, lfc = inp
        b = jnp.cumsum(lfc, axis=-1)
        d = jnp.where(causal, b[..., :, None] - b[..., None, :] + lic[..., None, :], -jnp.inf)
        inter = b + m[..., None]
        m_t = jnp.maximum(inter, jnp.max(d, axis=-1))
        dexp = jnp.exp(d - m_t[..., None])
        inter_w = jnp.exp(inter - m_t)
        s = jnp.einsum('bhtd,bhsd->bhts', qc, kc) * dexp
        num = inter_w[..., None] * jnp.einsum('bhtd,bhde->bhte', qc, C) + jnp.einsum('bhts,bhse->bhte', s, vc)
        den = inter_w * jnp.einsum('bhtd,bhd->bht', qc, n) + jnp.sum(s, axis=-1)
        h = num / jnp.maximum(jnp.abs(den), jnp.exp(-m_t))[..., None]
        b_last = b[..., -1]
        g_s = b_last[..., None] - b + lic
        m_new = jnp.maximum(b_last + m, jnp.max(g_s, axis=-1))
        a = jnp.exp(b_last + m - m_new)
        w = jnp.exp(g_s - m_new[..., None])
        C_new = a[..., None, None] * C + jnp.einsum('bhsd,bhse->bhde', kc * w[..., None], vc)
        n_new = a[..., None] * n + jnp.einsum('bhs,bhsd->bhd', w, kc)
        return (C_new, n_new, m_new), h

    state, h = lax.scan(step, state, (chunks(q), chunks(k), chunks(v), chunks(log_i), chunks(log_f)))
    return jnp.moveaxis(h, 0, 2).reshape(B, H, L, -1), state


def mlstm_bidir(ctx_in, lat_in):
    qc, kc, vc, lic, lfc = ctx_in
    ql, kl, vl, lil, lfl = lat_in
    B = qc.shape[0]
    zero = (jnp.zeros((B, ML_HEADS, ML_HEAD_DIM, ML_HEAD_DIM), jnp.float32),
            jnp.zeros((B, ML_HEADS, ML_HEAD_DIM), jnp.float32),
            jnp.zeros((B, ML_HEADS), jnp.float32))
    flip = lambda t: jnp.flip(t, axis=2)
    h_cf, s_f = mlstm_scan(qc, kc, vc, lic[0], lfc[0], zero)
    h_lf, _ = mlstm_scan(ql, kl, vl, lil[0], lfl[0], s_f)
    h_cb, s_b = mlstm_scan(flip(qc), flip(kc), flip(vc), flip(lic[1]), flip(lfc[1]), zero)
    h_lb, _ = mlstm_scan(flip(ql), flip(kl), flip(vl), flip(lil[1]), flip(lfl[1]), s_b)
    return h_cf + flip(h_cb), h_lf + flip(h_lb)


def combine_groups(a, y, h, o, p):
    g = p['mix_norm_g']
    ml = rmsnorm(h.transpose(0, 2, 1, 3).astype(o.dtype), g[MLA_WIDTH + HY_WIDTH:].reshape(ML_HEADS, ML_HEAD_DIM))
    ml = ml.reshape(o.shape) * jax.nn.sigmoid(o)
    cat = jnp.concatenate([rmsnorm(a, g[:MLA_WIDTH]), rmsnorm(y, g[MLA_WIDTH:MLA_WIDTH + HY_WIDTH]), ml], axis=-1)
    return cat @ p['w_out']


def mixer(pl, pc, need_ctx, p, rope):
    lat = jnp.split(pl, IN_SPLITS, axis=-1)
    ctx = jnp.split(pc, IN_SPLITS, axis=-1)
    merge = lambda t: t.transpose(0, 2, 1, 3).reshape(t.shape[0], t.shape[2], -1)
    q_l, k_l, v_l = mla_heads(lat[0], lat[1], lat[2], p, rope)
    q_c, k_c, v_c = mla_heads(ctx[0], ctx[1], ctx[2], p, None)
    k_all = jnp.concatenate([k_c, k_l], axis=2)
    v_all = jnp.concatenate([v_c, v_l], axis=2)
    a_l = merge(block_attention(q_l, k_all, v_all))
    y_l = hyena(lat[3], p)
    h_c, h_l = mlstm_bidir(mlstm_inputs(ctx[4], ctx[5], ctx[7], p), mlstm_inputs(lat[4], lat[5], lat[7], p))
    out_l = combine_groups(a_l, y_l, h_l, lat[6], p)
    out_c = None
    if need_ctx:
        a_c = merge(attend(q_c, k_c, v_c))
        y_c = hyena(ctx[3], p)
        out_c = combine_groups(a_c, y_c, h_c, ctx[6], p)
    return out_l, out_c


def swiglu(h, w1, w2):
    gate, up = jnp.split(h @ w1, 2, axis=-1)
    return (jax.nn.silu(gate) * up) @ w2


def setup_inputs(seed: int = 0) -> dict:
    key = jax.random.key(seed)
    ks = iter(jax.random.split(key, 40))
    f32 = jnp.float32

    def nrm(shape, std):
        return std * jax.random.normal(next(ks), shape, f32)

    def gain(shape):
        return 1.0 + 0.02 * jax.random.normal(next(ks), shape, f32)

    x = nrm((BATCH, SEQ, D_MODEL), 1.0)
    c = nrm((BATCH, D_MODEL), 1.0)
    ctx = nrm((BATCH, CTX_LEN, D_MODEL), 1.0)
    c_ctx = nrm((D_MODEL,), 1.0)
    ada_w = nrm((DEPTH, D_MODEL, 6 * D_MODEL), 0.5 * D_MODEL ** -0.5)
    ada_b = nrm((DEPTH, 6 * D_MODEL), 0.01)
    norm1_g = gain((DEPTH, D_MODEL))
    norm2_g = gain((DEPTH, D_MODEL))
    w_in = nrm((DEPTH, D_MODEL, N_IN), D_MODEL ** -0.5)
    mla_qa_norm = gain((DEPTH, MLA_Q_LORA))
    mla_kva_norm = gain((DEPTH, MLA_KV_LORA))
    mla_w_uq = nrm((DEPTH, MLA_Q_LORA, MLA_HEADS * MLA_QK), MLA_Q_LORA ** -0.5)
    mla_w_ukv = nrm((DEPTH, MLA_KV_LORA, MLA_HEADS * (MLA_NOPE + MLA_V)), MLA_KV_LORA ** -0.5)
    mla_q_norm = gain((DEPTH, MLA_QK))
    mla_k_norm = gain((DEPTH, MLA_QK))
    hy_conv_w = nrm((DEPTH, SHORT_CONV, 3 * HY_WIDTH), SHORT_CONV ** -0.5)
    hy_conv_b = nrm((DEPTH, 3 * HY_WIDTH), 0.01)
    hy_w1 = nrm((DEPTH, HY_EMB, HY_HIDDEN), 1.0)
    hy_b1 = nrm((DEPTH, HY_HIDDEN), 0.1)
    hy_w2 = nrm((DEPTH, HY_HIDDEN, HY_HIDDEN), HY_HIDDEN ** -0.5)
    hy_b2 = nrm((DEPTH, HY_HIDDEN), 0.1)
    hy_w3 = nrm((DEPTH, HY_HIDDEN, HY_FILTER_OUT), 0.01)
    hy_decay = jax.random.uniform(next(ks), (DEPTH, HY_FILTER_OUT), f32, HY_DECAY_MIN, HY_DECAY_MAX)
    hy_skip = nrm((DEPTH, HY_ORDER, HY_WIDTH), 0.5)
    ml_conv_w = nrm((DEPTH, SHORT_CONV, 2 * ML_WIDTH), SHORT_CONV ** -0.5)
    ml_conv_b = nrm((DEPTH, 2 * ML_WIDTH), 0.01)
    ml_gate_b = jnp.concatenate([nrm((DEPTH, 2 * ML_HEADS), 0.1),
                                 jax.random.uniform(next(ks), (DEPTH, 2 * ML_HEADS), f32, 3.0, 6.0)], axis=-1)
    mix_norm_g = gain((DEPTH, MIX_WIDTH))
    w_out = nrm((DEPTH, MIX_WIDTH, D_MODEL), MIX_WIDTH ** -0.5)
    ffn_w1 = nrm((DEPTH, D_MODEL, 2 * FFN_HIDDEN), D_MODEL ** -0.5)
    ffn_w2 = nrm((DEPTH, FFN_HIDDEN, D_MODEL), FFN_HIDDEN ** -0.5)
    return {'x': x, 'c': c, 'ctx': ctx, 'c_ctx': c_ctx, 'ada_w': ada_w, 'ada_b': ada_b,
            'norm1_g': norm1_g, 'norm2_g': norm2_g, 'w_in': w_in,
            'mla_qa_norm': mla_qa_norm, 'mla_kva_norm': mla_kva_norm, 'mla_w_uq': mla_w_uq,
            'mla_w_ukv': mla_w_ukv, 'mla_q_norm': mla_q_norm, 'mla_k_norm': mla_k_norm,
            'hy_conv_w': hy_conv_w, 'hy_conv_b': hy_conv_b, 'hy_w1': hy_w1, 'hy_b1': hy_b1,
            'hy_w2': hy_w2, 'hy_b2': hy_b2, 'hy_w3': hy_w3, 'hy_decay': hy_decay, 'hy_skip': hy_skip,
            'ml_conv_w': ml_conv_w, 'ml_conv_b': ml_conv_b, 'ml_gate_b': ml_gate_b,
            'mix_norm_g': mix_norm_g, 'w_out': w_out, 'ffn_w1': ffn_w1, 'ffn_w2': ffn_w2}


def reference(x, c, ctx, c_ctx, ada_w, ada_b, norm1_g, norm2_g, w_in,
              mla_qa_norm, mla_kva_norm, mla_w_uq, mla_w_ukv, mla_q_norm, mla_k_norm,
              hy_conv_w, hy_conv_b, hy_w1, hy_b1, hy_w2, hy_b2, hy_w3, hy_decay, hy_skip,
              ml_conv_w, ml_conv_b, ml_gate_b, mix_norm_g, w_out, ffn_w1, ffn_w2):
    rope = axial_rope(x.shape[1])
    silu_c = jax.nn.silu(c)
    silu_cc = jax.nn.silu(c_ctx)
    for l in range(DEPTH):
        need_ctx = l < DEPTH - 1
        p = {'mla_qa_norm': mla_qa_norm[l], 'mla_kva_norm': mla_kva_norm[l], 'mla_w_uq': mla_w_uq[l],
             'mla_w_ukv': mla_w_ukv[l], 'mla_q_norm': mla_q_norm[l], 'mla_k_norm': mla_k_norm[l],
             'hy_conv_w': hy_conv_w[l], 'hy_conv_b': hy_conv_b[l], 'hy_w1': hy_w1[l], 'hy_b1': hy_b1[l],
             'hy_w2': hy_w2[l], 'hy_b2': hy_b2[l], 'hy_w3': hy_w3[l], 'hy_decay': hy_decay[l],
             'hy_skip': hy_skip[l], 'ml_conv_w': ml_conv_w[l], 'ml_conv_b': ml_conv_b[l],
             'ml_gate_b': ml_gate_b[l], 'mix_norm_g': mix_norm_g[l], 'w_out': w_out[l]}
        mod_l = jnp.split((silu_c @ ada_w[l] + ada_b[l])[:, None, :], 6, axis=-1)
        mod_c = jnp.split(silu_cc @ ada_w[l] + ada_b[l], 6, axis=-1)
        xn = modulate(rmsnorm(x, norm1_g[l]), mod_l[0], mod_l[1])
        cn = modulate(rmsnorm(ctx, norm1_g[l]), mod_c[0], mod_c[1])
        y_l, y_c = mixer(xn @ w_in[l], cn @ w_in[l], need_ctx, p, rope)
        x = x + mod_l[2] * y_l
        x = x + mod_l[5] * swiglu(modulate(rmsnorm(x, norm2_g[l]), mod_l[3], mod_l[4]), ffn_w1[l], ffn_w2[l])
        if need_ctx:
            ctx = ctx + mod_c[2] * y_c
            ctx = ctx + mod_c[5] * swiglu(modulate(rmsnorm(ctx, norm2_g[l]), mod_c[3], mod_c[4]), ffn_w1[l], ffn_w2[l])
    return x
```

```cpp
#include <hip/hip_runtime.h>
#include <hip/hip_cooperative_groups.h>
#include <cstdio>
#include <cstdint>
#include <cmath>
namespace cg = cooperative_groups;
#ifndef DUP_HY
#define DUP_HY 0
#endif
#ifndef DUP_ML
#define DUP_ML 0
#endif
#ifndef DUP_SYNC
#define DUP_SYNC 0
#endif
#ifndef DUP_INPROJ
#define DUP_INPROJ 0
#endif
#ifndef DUP_UP
#define DUP_UP 0
#endif
#ifndef DUP_W1
#define DUP_W1 0
#endif
#ifndef DUP_ATT
#define DUP_ATT 0
#endif
#ifndef DUP_POST
#define DUP_POST 0
#endif
#ifndef DUP_COMB
#define DUP_COMB 0
#endif
#ifndef DUP_NORM
#define DUP_NORM 0
#endif
#ifndef DUP_M0
#define DUP_M0 0
#endif
#ifndef DUP_G0
#define DUP_G0 0
#endif
#ifndef DUP_G1
#define DUP_G1 0
#endif
namespace pg8 {
#define PG8_LAS __attribute__((address_space(3)))
typedef unsigned short bf16_t;
typedef short bf16x8 __attribute__((ext_vector_type(8)));
typedef float f32x4 __attribute__((ext_vector_type(4)));
typedef unsigned u32x4 __attribute__((ext_vector_type(4)));
constexpr int BM = 256, BK = 64, HALF = 128, HTB = HALF * BK * 2  , STAGE_BYTES = 8 * HTB, NXCD = 8, WGM = 8;

__host__ __device__ __forceinline__ int lds_byte(int r, int c) { const int st = (r >> 4) * 2 + (c >> 5), rr = r & 15, cc = c & 31, ob = rr * 64 + cc * 2; return st * 1024 + (ob ^ (((ob >> 9) & 1) << 5)); }
__host__ __device__ __forceinline__ void stage_rc(int b, int& R, int& C) { const int st = b / 1024, sb = b % 1024, swz = sb ^ (((sb >> 9) & 1) << 5); R = (st >> 1) * 16 + swz / 64; C = (st & 1) * 32 + (swz % 64) / 2; }
__host__ __device__ __forceinline__ int perm32(int rho) { const int n = rho >> 4, i = rho & 15; return 8 * (i >> 2) + 4 * n + (i & 3); }

struct Unit { int pm, pn, kofs, nt, atomic, which; };
struct Gemm { const bf16_t* A; const bf16_t* Bt; int M, N, K; const bf16_t* A2; const bf16_t* Bt2; };

struct StaticOrder {
    int nM, nN, nwg, G, c, ntk;
    __host__ __device__ void init(int M, int N, int G_, int c_, int K_) { nM = M / BM; nN = N / BM; nwg = nM * nN; G = G_; c = c_; ntk = K_ / BK; }
    __host__ __device__ bool next(int i, Unit& u) const {
        const long L = (long)i * G + c; if (L >= nwg) return false;
        int wgid = (int)L; { const int q = nwg / NXCD, r = nwg % NXCD, xcd = wgid % NXCD, off = wgid / NXCD; wgid = (xcd < r ? xcd * (q + 1) : r * (q + 1) + (xcd - r) * q) + off; }
        const int nig = WGM * nN, gid = wgid / nig, fm = gid * WGM, gsz = (nM - fm) < WGM ? (nM - fm) : WGM;
        u.pm = fm + ((wgid % nig) % gsz); u.pn = (wgid % nig) / gsz; u.kofs = 0; u.nt = ntk; u.atomic = 0; u.which = 0; return true;
    }
    __device__ __forceinline__ void a_ready(const Unit&) const {}
    __device__ __forceinline__ void done(const Unit&) const {}
};
struct SplitCtxOrder {
    StaticOrder so; int K;
    __host__ __device__ void init(int G_, int c_, int K_) { so.init(16384, 2048, G_, c_, K_); K = K_; }
    __host__ __device__ bool next(int i, Unit& u) const {
        const long L = (long)i * so.G + so.c;
        if (L < so.nwg) return so.next(i, u);
        const int q = (int)(L - so.nwg); if (q >= 128) return false;
        const int cu = q >> 2, kq = q & 3; u.pm = 64 + (cu >> 3); u.pn = cu & 7; u.kofs = kq * (K / 4); u.nt = K / 4 / BK; u.atomic = 1; u.which = 0; return true;
    }
    __device__ __forceinline__ void a_ready(const Unit&) const {}
    __device__ __forceinline__ void done(const Unit&) const {}
};
struct InProjL1Order {
    StaticOrder so;
    __host__ __device__ void init(int G_, int c_, int K_) { so.init(16384, 4864, G_, c_, K_); }
    __host__ __device__ bool next(int i, Unit& u) const {
        const long L = (long)i * so.G + so.c;
        if (L < so.nwg) return so.next(i, u);
        const int q = (int)(L - so.nwg); if (q >= 36) return false;
        const int r = q / 9, k = q % 9; u.pm = 64 + r; u.pn = k < 2 ? 2 + k : (k < 8 ? 10 + (k - 2) : 18); u.kofs = 0; u.nt = so.ntk; u.atomic = 0; u.which = 0; return true;
    }
    __device__ __forceinline__ void a_ready(const Unit&) const {}
    __device__ __forceinline__ void done(const Unit&) const {}
};

struct DualUpOrder {
    int G, c;
    __host__ __device__ void init(int G_, int c_) { G = G_; c = c_; }
    __host__ __device__ bool next(int i, Unit& u) const {
        const long L = (long)i * G + c; if (L >= 952) return false;
        u.kofs = 0; u.nt = 8; u.atomic = 0;
        if (L < 408) { u.which = 0; u.pm = (int)L / 6; u.pn = (int)L % 6; } else { const int q = (int)L - 408; u.which = 1; u.pm = q >> 3; u.pn = q & 7; }
        return true;
    }
    __device__ __forceinline__ void a_ready(const Unit&) const {}
    __device__ __forceinline__ void done(const Unit&) const {}
};

struct InProjL0Order {
    StaticOrder so;
    __host__ __device__ void init(int G_, int c_, int K_) { so.init(16384, 4864, G_, c_, K_); }
    __host__ __device__ bool next(int i, Unit& u) const {
        const long L = (long)i * so.G + so.c;
        if (L >= so.nwg + 48 + 112) return false;
        Unit v; const bool ok = so.next(L < so.nwg ? i : 0, v);
        (void)ok;
        const int q = (int)(L - so.nwg), q2 = q - 48;
        const int r1 = q / 12, k1 = q % 12, t2 = q2 >> 2, r2 = t2 / 7, k2 = t2 % 7;
        const bool lat = L < so.nwg, full = q < 48;
        u.pm = lat ? v.pm : (full ? 64 + r1 : 64 + r2);
        u.pn = lat ? v.pn : (full ? (k1 < 4 ? k1 : 10 + (k1 - 4)) : (k2 < 6 ? 4 + k2 : 18));
        u.kofs = (lat || full) ? 0 : (q2 & 3) * 512;
        u.nt = (lat || full) ? so.ntk : 8;
        u.atomic = (lat || full) ? 0 : 1;
        u.which = 0;
        return true;
    }
    __device__ __forceinline__ void a_ready(const Unit&) const {}
    __device__ __forceinline__ void done(const Unit&) const {}
};
template <class Epi, class Sched, bool ALIGN_EPI = false, bool SP2 = false>
__device__ __forceinline__ void gemm_phase(PG8_LAS unsigned char* lds, const Gemm g, const Sched& S, const Epi& E, const int tid_in) {
    const int tid = tid_in, wid = __builtin_amdgcn_readfirstlane(tid >> 6), lane = tid & 63, wr = wid >> 2, wc = wid & 3, fr = lane & 15, fq = lane >> 4;
    const int K = g.K;
    unsigned voffA[2], voffB[2];
#pragma unroll
    for (int i = 0; i < 2; ++i) { int R, C; stage_rc(tid * 16 + i * 8192, R, C); const int Rb = Epi::PERM ? ((R & ~31) + perm32(R & 31)) : R;
        voffA[i] = (unsigned)(R * K + C) * 2u; voffB[i] = (unsigned)(Rb * K + C) * 2u; }
    const size_t kstep = (size_t)(BK * 2);
    const size_t hstep = (size_t)HALF * K * 2;
    const size_t tstep = 2 * hstep;
    const unsigned ldsw = (unsigned)wid * 1024u;
    const int aoff = lds_byte(wr * 64 + fr, fq * 8), boff = lds_byte(wc * 32 + fr, fq * 8);
#define PG8_SA(b, h) (((b) * 2 + (h)) * HTB)
#define PG8_SB(b, h) ((4 + (b) * 2 + (h)) * HTB)
#define PG8_STAGE(bufoff, gbase, voff) do { _Pragma("unroll") for (int _i = 0; _i < 2; ++_i) \
        __builtin_amdgcn_global_load_lds((const unsigned*)((const char*)(gbase) + (voff)[_i]), (PG8_LAS unsigned*)(lds + (bufoff) + ldsw + _i * 8192), 16, 0, 0); } while (0)
#define PG8_LDA(dst, b, h) do { _Pragma("unroll") for (int m = 0; m < 4; ++m) _Pragma("unroll") for (int k = 0; k < 2; ++k) dst[m][k] = *(const PG8_LAS bf16x8*)(lds + PG8_SA(b, h) + aoff + m * 2048 + k * 1024); } while (0)
#define PG8_LDB(dst, b, h) do { _Pragma("unroll") for (int n = 0; n < 2; ++n) _Pragma("unroll") for (int k = 0; k < 2; ++k) dst[n][k] = *(const PG8_LAS bf16x8*)(lds + PG8_SB(b, h) + boff + n * 2048 + k * 1024); } while (0)
#define PG8_MMA(ai, bj, At, Bt) do { __builtin_amdgcn_s_setprio(1); _Pragma("unroll") for (int m = 0; m < 4; ++m) _Pragma("unroll") for (int n = 0; n < 2; ++n) _Pragma("unroll") for (int k = 0; k < 2; ++k) \
        acc[ai][bj][m][n] = __builtin_amdgcn_mfma_f32_16x16x32_bf16(Bt[n][k], At[m][k], acc[ai][bj][m][n], 0, 0, 0); __builtin_amdgcn_s_setprio(0); } while (0)
#define PG8_WAIT_V(n) asm volatile("s_waitcnt vmcnt(" #n ")" ::: "memory")
#define PG8_WAIT_L(n) asm volatile("s_waitcnt lgkmcnt(" #n ")" ::: "memory")
#define PG8_BAR __builtin_amdgcn_s_barrier()
#define PG8_SCHED __builtin_amdgcn_sched_barrier(0)
    Unit cur, nxt; int ui = 0;
    if (!S.next(0, cur)) return;
    int nt = cur.nt;
    f32x4 acc[2][2][4][2];
#pragma unroll
    for (int a = 0; a < 2; ++a)
#pragma unroll
        for (int b = 0; b < 2; ++b)
#pragma unroll
            for (int m = 0; m < 4; ++m)
#pragma unroll
                for (int n = 0; n < 2; ++n) acc[a][b][m][n] = (f32x4){0.f, 0.f, 0.f, 0.f};
    bf16x8 At[4][2], B0[2][2], B1[2][2];
    const char* cA = (const char*)(cur.which ? g.A2 : g.A) + (size_t)cur.pm * tstep + (size_t)cur.kofs * 2; const char* cB = (const char*)(cur.which ? g.Bt2 : g.Bt) + (size_t)cur.pn * tstep + (size_t)cur.kofs * 2;
    S.a_ready(cur);
    if constexpr (SP2) {
        PG8_STAGE(PG8_SB(0, 0), cB, voffB); PG8_STAGE(PG8_SB(0, 1), cB + hstep, voffB); PG8_STAGE(PG8_SA(0, 0), cA, voffA); PG8_STAGE(PG8_SA(0, 1), cA + hstep, voffA);
        if (wr == 1) PG8_BAR;
        PG8_WAIT_V(2); PG8_BAR;
        PG8_STAGE(PG8_SB(1, 0), cB + kstep, voffB); PG8_STAGE(PG8_SA(1, 0), cA + kstep, voffA); PG8_STAGE(PG8_SB(1, 1), cB + hstep + kstep, voffB);
        PG8_WAIT_V(6); PG8_BAR;
    } else {
        PG8_STAGE(PG8_SB(0, 0), cB, voffB); PG8_STAGE(PG8_SA(0, 0), cA, voffA); PG8_STAGE(PG8_SB(0, 1), cB + hstep, voffB); PG8_STAGE(PG8_SA(0, 1), cA + hstep, voffA);
        if (wr == 1) PG8_BAR;
        PG8_WAIT_V(4); PG8_BAR;
        PG8_STAGE(PG8_SB(1, 0), cB + kstep, voffB); PG8_STAGE(PG8_SA(1, 0), cA + kstep, voffA); PG8_STAGE(PG8_SB(1, 1), cB + hstep + kstep, voffB);
        PG8_WAIT_V(6); PG8_BAR;
    }
    for (;;) {
        const bool has_next = S.next(ui + 1, nxt);
        const char* nA = has_next ? (const char*)(nxt.which ? g.A2 : g.A) + (size_t)nxt.pm * tstep + (size_t)nxt.kofs * 2 : cA; const char* nB = has_next ? (const char*)(nxt.which ? g.Bt2 : g.Bt) + (size_t)nxt.pn * tstep + (size_t)nxt.kofs * 2 : cB;
        for (int t = 0; t < nt; t += 2) {
            const bool last = (t == nt - 2);
            const char* a1 = cA + (size_t)(t + 1) * kstep;
            const char* a2 = last ? nA : cA + (size_t)(t + 2) * kstep; const char* b2 = last ? nB : cB + (size_t)(t + 2) * kstep;
            const char* a3 = a2 + kstep; const char* b3 = b2 + kstep;
            if (last && has_next) S.a_ready(nxt);
            if constexpr (SP2) {
            PG8_LDB(B0, 0, 0); PG8_LDB(B1, 0, 1); PG8_SCHED; PG8_LDA(At, 0, 0); PG8_STAGE(PG8_SA(1, 1), a1 + hstep, voffA);
            PG8_WAIT_V(8); PG8_WAIT_L(0); PG8_BAR; PG8_MMA(0, 0, At, B0); PG8_MMA(0, 1, At, B1); PG8_BAR; PG8_SCHED;
            PG8_LDA(At, 0, 1); PG8_STAGE(PG8_SB(0, 0), b2, voffB); PG8_STAGE(PG8_SB(0, 1), b2 + hstep, voffB); PG8_STAGE(PG8_SA(0, 0), a2, voffA);
            PG8_WAIT_V(8); PG8_WAIT_L(0); PG8_BAR; PG8_MMA(1, 0, At, B0); PG8_MMA(1, 1, At, B1); PG8_BAR; PG8_SCHED;
            PG8_LDB(B0, 1, 0); PG8_LDB(B1, 1, 1); PG8_SCHED; PG8_LDA(At, 1, 0); PG8_STAGE(PG8_SA(0, 1), a2 + hstep, voffA);
            PG8_WAIT_V(8); PG8_WAIT_L(0); PG8_BAR; PG8_MMA(0, 0, At, B0); PG8_MMA(0, 1, At, B1); PG8_BAR; PG8_SCHED;
            PG8_LDA(At, 1, 1); PG8_STAGE(PG8_SB(1, 0), b3, voffB); PG8_STAGE(PG8_SB(1, 1), b3 + hstep, voffB); PG8_STAGE(PG8_SA(1, 0), a3, voffA);
            PG8_WAIT_V(8); PG8_WAIT_L(0); PG8_BAR; PG8_MMA(1, 0, At, B0); PG8_MMA(1, 1, At, B1); PG8_BAR; PG8_SCHED;
            } else {
            PG8_LDB(B0, 0, 0); PG8_SCHED; PG8_LDA(At, 0, 0); PG8_STAGE(PG8_SA(1, 1), a1 + hstep, voffA);
            PG8_WAIT_L(8); PG8_BAR; PG8_WAIT_L(0); PG8_MMA(0, 0, At, B0); PG8_BAR; PG8_SCHED;
            PG8_LDB(B1, 0, 1); PG8_STAGE(PG8_SB(0, 0), b2, voffB);
            PG8_BAR; PG8_WAIT_L(0); PG8_MMA(0, 1, At, B1); PG8_BAR;
            PG8_LDA(At, 0, 1); PG8_STAGE(PG8_SA(0, 0), a2, voffA);
            PG8_BAR; PG8_WAIT_L(0); PG8_MMA(1, 0, At, B0); PG8_BAR; PG8_SCHED;
            PG8_STAGE(PG8_SB(0, 1), b2 + hstep, voffB);
            PG8_WAIT_V(6); PG8_BAR; PG8_MMA(1, 1, At, B1); PG8_BAR;
            PG8_LDB(B0, 1, 0); PG8_SCHED; PG8_LDA(At, 1, 0); PG8_STAGE(PG8_SA(0, 1), a2 + hstep, voffA);
            PG8_WAIT_L(8); PG8_BAR; PG8_WAIT_L(0); PG8_MMA(0, 0, At, B0); PG8_BAR; PG8_SCHED;
            PG8_LDB(B1, 1, 1); PG8_STAGE(PG8_SB(1, 0), b3, voffB);
            PG8_BAR; PG8_WAIT_L(0); PG8_MMA(0, 1, At, B1); PG8_BAR;
            PG8_LDA(At, 1, 1); PG8_STAGE(PG8_SA(1, 0), a3, voffA);
            PG8_BAR; PG8_WAIT_L(0); PG8_MMA(1, 0, At, B0); PG8_BAR; PG8_SCHED;
            PG8_STAGE(PG8_SB(1, 1), b3 + hstep, voffB);
            PG8_WAIT_V(6); PG8_BAR; PG8_MMA(1, 1, At, B1); PG8_BAR;
            }
        }
        if constexpr (ALIGN_EPI) { if (wr == 0) PG8_BAR; }
        if constexpr (!Epi::AFTER_DRAIN) { E(acc, cur, wr, wc, fr, fq); S.done(cur); }
        if (!has_next) break;
#pragma unroll
        for (int a = 0; a < 2; ++a)
#pragma unroll
            for (int b = 0; b < 2; ++b)
#pragma unroll
                for (int m = 0; m < 4; ++m)
#pragma unroll
                    for (int n = 0; n < 2; ++n) acc[a][b][m][n] = (f32x4){0.f, 0.f, 0.f, 0.f};
        cur = nxt; cA = nA; cB = nB; ++ui; nt = cur.nt;
        if constexpr (ALIGN_EPI) { if (wr == 1) PG8_BAR; }
    }
    PG8_WAIT_V(0);
    if constexpr (!ALIGN_EPI) { if (wr == 0) PG8_BAR; }
    PG8_BAR;
    if constexpr (Epi::AFTER_DRAIN) { E.fused(acc, cur, wr, wc, fr, fq, lds, wid, lane); S.done(cur); }
#undef PG8_SA
#undef PG8_SB
#undef PG8_STAGE
#undef PG8_LDA
#undef PG8_LDB
#undef PG8_MMA
#undef PG8_WAIT_V
#undef PG8_WAIT_L
#undef PG8_BAR
#undef PG8_SCHED
}
}
#define LAS __attribute__((address_space(3)))
typedef unsigned short bf16_t;
typedef short bf16x8 __attribute__((ext_vector_type(8)));
typedef short s16x4 __attribute__((ext_vector_type(4)));
typedef float f32x4 __attribute__((ext_vector_type(4)));
typedef float f32x2 __attribute__((ext_vector_type(2)));
typedef float f32x16 __attribute__((ext_vector_type(16)));
typedef unsigned u32x4 __attribute__((ext_vector_type(4)));
typedef unsigned u32x2 __attribute__((ext_vector_type(2)));
constexpr int DM = 2048, NB = 4, SEQ = 4096, CTXL = 256;
constexpr int ML = NB * SEQ, MC = NB * CTXL, MT = ML + MC;
constexpr int NIN = 4688, NINP = 4864, FFH = 5632, NKEY = CTXL + SEQ;
constexpr float EPS = 1e-6f;
constexpr int NTHREADS = 512, NWAVES = 8;
constexpr int LDS_BYTES = 147456;
constexpr size_t MiB = 1u << 20;
constexpr size_t WS_MOD = 1 * MiB, WS_TW = 2 * MiB, WS_H2L = 3 * MiB, WS_H2C = 5 * MiB, WS_MODP = 6 * MiB, WS_KROPE = 21 * MiB, WS_GATES = 26 * MiB, WS_MLS = 28 * MiB, WS_MLN = 29 * MiB,
    WS_XC = 30 * MiB, WS_WIN = 38 * MiB, WS_WUQ = 57 * MiB, WS_WUKV = 59 * MiB, WS_WOUT = 61 * MiB, WS_W1 = 69 * MiB, WS_W2 = 113 * MiB, WS_A = 135 * MiB, WS_CQ = 203 * MiB, WS_CKV = 220 * MiB,
    WS_HYT = 237 * MiB, WS_HYTC = 333 * MiB, WS_MLQK = 339 * MiB, WS_MLQK2 = 373 * MiB, WS_MLV = 407 * MiB, WS_MLO = 424 * MiB, WS_QRAW = 441 * MiB, WS_KVRAW = 492 * MiB,
    WS_Q = 560 * MiB, WS_QC = 608 * MiB, WS_K = 611 * MiB, WS_V = 662 * MiB, WS_AO = 696 * MiB, WS_YT = 730 * MiB, WS_YTC = 762 * MiB, WS_END = 764 * MiB;
constexpr size_t WS_CST = WS_A;
constexpr size_t WS_HF = WS_QRAW, WS_HB = WS_QRAW + 34 * MiB;
constexpr size_t WS_HID = WS_CQ;

__device__ __forceinline__ unsigned cvtpk(float lo, float hi) { unsigned r; asm volatile("v_cvt_pk_bf16_f32 %0, %1, %2" : "=v"(r) : "v"(lo), "v"(hi)); return r; }
__device__ __forceinline__ float bf2f(bf16_t v) { return __uint_as_float((unsigned)v << 16); }
__device__ __forceinline__ float bf2f_s(short v) { return __uint_as_float(((unsigned)(unsigned short)v) << 16); }
__device__ __forceinline__ bf16_t f2bf(float f) { return (bf16_t)(cvtpk(f, 0.f) & 0xffffu); }
template <int K> __device__ __forceinline__ float swz_xor(float v) { return __int_as_float(__builtin_amdgcn_ds_swizzle(__float_as_int(v), (K << 10) | 0x1f)); }
__device__ __forceinline__ float wave_sum(float v) {
    v += swz_xor<1>(v); v += swz_xor<2>(v); v += swz_xor<4>(v); v += swz_xor<8>(v); v += swz_xor<16>(v);
    auto rr = __builtin_amdgcn_permlane32_swap(__float_as_uint(v), __float_as_uint(v), false, false);
    return __uint_as_float(rr[0]) + __uint_as_float(rr[1]);
}
__device__ __forceinline__ float xor32_get(float v, int hi) {
    auto rr = __builtin_amdgcn_permlane32_swap(__float_as_uint(v), __float_as_uint(v), false, false);
    return hi ? __uint_as_float(rr[0]) : __uint_as_float(rr[1]);
}
__device__ __forceinline__ float siluf(float x) { return x / (1.f + __expf(-x)); }
__device__ __forceinline__ float logsigmoidf(float x) { return fminf(x, 0.f) - log1pf(expf(-fabsf(x))); }
__device__ __forceinline__ int crow(int r, int hi) { return (r & 3) + 8 * (r >> 2) + 4 * hi; }
#define LDS_WAIT() asm volatile("s_waitcnt lgkmcnt(0)" ::: "memory")
#define SBAR() __builtin_amdgcn_sched_barrier(0)

struct MapIdent { __device__ __forceinline__ int operator()(int n) const { return n; } };
struct MapWin { __device__ __forceinline__ int operator()(int n) const {
    if (n < 1024) return n; if (n < 2560) return 1088 + (n - 1024); if (n < 3584) return 2624 + (n - 2560); if (n < 4096) return 3648 + (n - 3584);
    if (n < 4608) return 4160 + (n - 4096); if (n < 4672) return 1024 + (n - 4608); if (n < 4688) return n; return -1; } };
struct MapW1 { __device__ __forceinline__ int operator()(int n) const { const int t = n >> 8, w = n & 255; return w < 128 ? t * 128 + w : FFH + t * 128 + (w - 128); } };
template <class Map>
__device__ __forceinline__ void wt_item(const float* __restrict__ W, int Nsrc, int K, bf16_t* __restrict__ WT, const float* __restrict__ kscale, LAS float* scr, int kb, int nb, int lane, Map map) {
    const int k0 = 64 * kb, n0 = 32 * nb, oc = map(n0 + (lane & 31));
    float wv[32];
#pragma unroll
    for (int i = 0; i < 32; ++i) { const int kk = 2 * i + (lane >> 5); wv[i] = (oc >= 0) ? W[(size_t)(k0 + kk) * Nsrc + oc] : 0.f; }
#pragma unroll
    for (int i = 0; i < 32; ++i) { const int kk = 2 * i + (lane >> 5); float v = wv[i]; if (kscale) v *= kscale[k0 + kk]; scr[kk * 33 + (lane & 31)] = v; }
    LDS_WAIT();
    const int c = lane & 7;
#pragma unroll
    for (int j = 0; j < 4; ++j) { const int n = (lane >> 3) + 8 * j; const LAS float* s = scr + (8 * c) * 33 + n;
        u32x4 o; o.x = cvtpk(s[0 * 33], s[1 * 33]); o.y = cvtpk(s[2 * 33], s[3 * 33]); o.z = cvtpk(s[4 * 33], s[5 * 33]); o.w = cvtpk(s[6 * 33], s[7 * 33]);
        *(u32x4*)(WT + (size_t)(n0 + n) * K + k0 + 8 * c) = o; }
    LDS_WAIT();
}

namespace att {
constexpr int DQK = 192, DV = 128, QBLK = 32, KVBLK = 64;
constexpr float SCALE = 0.07216878364870322f;
constexpr float THR = 8.f;
constexpr int KPITCH = 400;
constexpr int SHM_V = KVBLK * DV * 2, SHM_K = KVBLK * KPITCH;
constexpr int QRP = 144;
constexpr int SHM_QR = 2 * SHM_V + 2 * SHM_K + NWAVES * 64 * 4;
constexpr int SHM_ATTN = SHM_QR + NWAVES * 32 * QRP;
__device__ __forceinline__ void partialSM(f32x16& p0, f32x16& p1, float& m_reg, float& mn, float& alpha) {
    constexpr float C = SCALE * 1.4426950408889634f;
    float pmax = p0[0];
#pragma unroll
    for (int r = 1; r < 16; ++r) pmax = fmaxf(pmax, p0[r]);
#pragma unroll
    for (int r = 0; r < 16; ++r) pmax = fmaxf(pmax, p1[r]);
    { auto rr = __builtin_amdgcn_permlane32_swap(__float_as_uint(pmax), __float_as_uint(pmax), false, false);
      pmax = fmaxf(__uint_as_float(rr[0]), __uint_as_float(rr[1])); }
    if (__builtin_expect(__all(pmax - m_reg <= THR / SCALE), 1)) { mn = m_reg; alpha = 1.f; }
    else { mn = fmaxf(m_reg, pmax); alpha = __builtin_amdgcn_exp2f((m_reg - mn) * C); m_reg = mn; }
    const float mnC = -mn * C;
#pragma unroll
    for (int r = 0; r < 16; ++r) p0[r] = fmaf(p0[r], C, mnC);
#pragma unroll
    for (int r = 0; r < 16; ++r) p1[r] = fmaf(p1[r], C, mnC);
#pragma unroll
    for (int r = 0; r < 16; ++r) p0[r] = __builtin_amdgcn_exp2f(p0[r]);
}
#define PK4(P, BASE, OUT) do { unsigned a0 = cvtpk(P[BASE + 0], P[BASE + 1]), a1 = cvtpk(P[BASE + 2], P[BASE + 3]);   \
    unsigned b0 = cvtpk(P[BASE + 4], P[BASE + 5]), b1 = cvtpk(P[BASE + 6], P[BASE + 7]);                              \
    auto r0 = __builtin_amdgcn_permlane32_swap(a0, b0, false, false); auto r1 = __builtin_amdgcn_permlane32_swap(a1, b1, false, false); \
    u32x4 w = {r0[0], r1[0], r0[1], r1[1]}; OUT = __builtin_bit_cast(bf16x8, w); } while (0)
__device__ __forceinline__ void finishSM(f32x16& p0, f32x16& p1, float alpha, float& l_reg, bf16x8& pa0, bf16x8& pa1, bf16x8& pa2, bf16x8& pa3) {
#pragma unroll
    for (int r = 0; r < 16; ++r) p1[r] = __builtin_amdgcn_exp2f(p1[r]);
    float ps = 0;
#pragma unroll
    for (int r = 0; r < 16; ++r) ps += p0[r];
#pragma unroll
    for (int r = 0; r < 16; ++r) ps += p1[r];
    { auto rr = __builtin_amdgcn_permlane32_swap(__float_as_uint(ps), __float_as_uint(ps), false, false);
      ps = __uint_as_float(rr[0]) + __uint_as_float(rr[1]); }
    l_reg = l_reg * alpha + ps;
    PK4(p0, 0, pa0); PK4(p0, 8, pa1); PK4(p1, 0, pa2); PK4(p1, 8, pa3);
}
__device__ __forceinline__ void qkt(f32x16& p0, f32x16& p1, const char* Ks, const bf16x8* qr, const char* qrl, int r32, int hi) {
    p0 = f32x16{}; p1 = f32x16{};
#pragma unroll
    for (int d0 = 0; d0 < 12; ++d0) { const int cb = (d0 * 16 + hi * 8) * 2;
        bf16x8 b0 = *reinterpret_cast<const bf16x8*>(Ks + r32 * KPITCH + cb);
        bf16x8 b1 = *reinterpret_cast<const bf16x8*>(Ks + (32 + r32) * KPITCH + cb);
        bf16x8 q; if (d0 < 8) q = qr[d0 < 8 ? d0 : 0]; else q = *reinterpret_cast<const bf16x8*>(qrl + (d0 - 8) * 32);
        p0 = __builtin_amdgcn_mfma_f32_32x32x16_bf16(b0, q, p0, 0, 0, 0);
        p1 = __builtin_amdgcn_mfma_f32_32x32x16_bf16(b1, q, p1, 0, 0, 0);
        if ((d0 & 3) == 3) asm volatile("" ::: "memory"); }
}
__device__ __forceinline__ int v_st(int k, int c) { const int kk = (k & ~0xC) | ((k & 4) << 1) | ((k & 8) >> 1); return ((kk >> 3) * 4 + (c >> 5)) * 512 + ((kk & 7) * 32 + (c & 31)) * 2; }
__device__ __forceinline__ int v_rd_base(int lane) { return ((lane & 3) << 3) | (((lane >> 2) & 3) << 6) | (((lane >> 4) & 1) << 5) | (((lane >> 5) & 1) << 8); }
constexpr int v_rd_off(int d0, int ks, int half) { return d0 * 512 + ks * 4096 + half * 2048; }
template <int OFF> __device__ __forceinline__ s16x4 tr_read(int vb) {
    s16x4 r; asm volatile("ds_read_b64_tr_b16 %0, %1 offset:%2" : "=&v"(r) : "v"(vb), "i"(OFF) : "memory"); return r;
}
template <int D0> __device__ __forceinline__ void pv_one(f32x16& od, int vb, bf16x8 pa0, bf16x8 pa1, bf16x8 pa2, bf16x8 pa3) {
    const s16x4 l0 = tr_read<v_rd_off(D0, 0, 0)>(vb), h0 = tr_read<v_rd_off(D0, 0, 1)>(vb), l1 = tr_read<v_rd_off(D0, 1, 0)>(vb), h1 = tr_read<v_rd_off(D0, 1, 1)>(vb);
    const s16x4 l2 = tr_read<v_rd_off(D0, 2, 0)>(vb), h2 = tr_read<v_rd_off(D0, 2, 1)>(vb), l3 = tr_read<v_rd_off(D0, 3, 0)>(vb), h3 = tr_read<v_rd_off(D0, 3, 1)>(vb);
    asm volatile("s_waitcnt lgkmcnt(0)" ::: "memory"); SBAR();
#define PKV(L, H) (bf16x8){L[0], L[1], L[2], L[3], H[0], H[1], H[2], H[3]}
    od = __builtin_amdgcn_mfma_f32_32x32x16_bf16(pa0, PKV(l0, h0), od, 0, 0, 0);
    od = __builtin_amdgcn_mfma_f32_32x32x16_bf16(pa1, PKV(l1, h1), od, 0, 0, 0);
    od = __builtin_amdgcn_mfma_f32_32x32x16_bf16(pa2, PKV(l2, h2), od, 0, 0, 0);
    od = __builtin_amdgcn_mfma_f32_32x32x16_bf16(pa3, PKV(l3, h3), od, 0, 0, 0);
#undef PKV
}
__device__ __forceinline__ void pv_d0(f32x16* o, int vb, bf16x8 pa0, bf16x8 pa1, bf16x8 pa2, bf16x8 pa3) {
    pv_one<0>(o[0], vb, pa0, pa1, pa2, pa3); pv_one<1>(o[1], vb, pa0, pa1, pa2, pa3); pv_one<2>(o[2], vb, pa0, pa1, pa2, pa3); pv_one<3>(o[3], vb, pa0, pa1, pa2, pa3);
}
__device__ __forceinline__ void attn_body(const bf16_t* __restrict__ Qb, const bf16_t* __restrict__ Kh, const bf16_t* __restrict__ Vh, bf16_t* __restrict__ Ob, int ldo, int seq, char* lds, const int tid) {
    const int wid = tid >> 6, lane = tid & 63, r32 = lane & 31, hi = lane >> 5;
    char* V_lds = lds; char* K_lds = lds + 2 * SHM_V;
    float* ws = (float*)(lds + 2 * SHM_V + 2 * SHM_K) + wid * 64; float* li_l = ws; float* al_l = ws + 32;
    float m_reg = -1e30f, l_reg = 0; f32x16 o[4] = {}; bf16x8 qr[8];
    char* qrl = lds + SHM_QR + wid * (32 * QRP) + r32 * QRP + hi * 16;
    const bf16_t* Qw = Qb + (long)(wid * QBLK + r32) * DQK + hi * 8;
#pragma unroll
    for (int d0 = 0; d0 < 8; ++d0) qr[d0] = *reinterpret_cast<const bf16x8*>(Qw + d0 * 16);
#pragma unroll
    for (int d0 = 8; d0 < 12; ++d0) *reinterpret_cast<bf16x8*>(qrl + (d0 - 8) * 32) = *reinterpret_cast<const bf16x8*>(Qw + d0 * 16);
    const int sr = tid >> 4, sc = (tid & 15) * 8, vst0 = v_st(sr, sc), vst1 = v_st(32 + sr, sc);
    const int ku0 = tid, ku1 = tid + 512, ku2 = tid + 1024;
    const int kst0 = (ku0 / 24) * KPITCH + (ku0 % 24) * 16, kst1 = (ku1 / 24) * KPITCH + (ku1 % 24) * 16, kst2 = (ku2 / 24) * KPITCH + (ku2 % 24) * 16;
    const int vb0 = (int)(uintptr_t)V_lds + v_rd_base(lane);
    struct { bf16x8 vs0, vs1, ks0, ks1, ks2; } sr_[1];
    const unsigned voff0 = (unsigned)(sr * DV + sc), voff1 = (unsigned)((32 + sr) * DV + sc), koff0 = (unsigned)(ku0 * 8), koff1 = (unsigned)(ku1 * 8), koff2 = (unsigned)(ku2 * 8);
#define SLOAD(i, k0) do { const bf16_t* vt_ = Vh + (long)(k0) * DV; const bf16_t* kt_ = Kh + (long)(k0) * DQK; \
    sr_[i].vs0 = *reinterpret_cast<const bf16x8*>(vt_ + voff0); sr_[i].vs1 = *reinterpret_cast<const bf16x8*>(vt_ + voff1); \
    sr_[i].ks0 = *reinterpret_cast<const bf16x8*>(kt_ + koff0); sr_[i].ks1 = *reinterpret_cast<const bf16x8*>(kt_ + koff1); sr_[i].ks2 = *reinterpret_cast<const bf16x8*>(kt_ + koff2); } while (0)
#define SWRITE(b, i) do { *(bf16x8*)(V_lds + (b) * SHM_V + vst0) = sr_[i].vs0; *(bf16x8*)(V_lds + (b) * SHM_V + vst1) = sr_[i].vs1; \
    *(bf16x8*)(K_lds + (b) * SHM_K + kst0) = sr_[i].ks0; *(bf16x8*)(K_lds + (b) * SHM_K + kst1) = sr_[i].ks1; *(bf16x8*)(K_lds + (b) * SHM_K + kst2) = sr_[i].ks2; } while (0)
#define SWAIT() asm volatile("s_waitcnt vmcnt(0)" ::: "memory")
#define RESC(a) do { if (__any((a) < 1.f)) { if (hi == 0) al_l[r32] = (a); asm volatile("s_waitcnt lgkmcnt(0)" ::: "memory"); \
    _Pragma("unroll") for (int d = 0; d < 4; ++d) _Pragma("unroll") for (int r = 0; r < 16; ++r) o[d][r] *= al_l[crow(r, hi)]; } } while (0)
    f32x16 pA0, pA1, pB0, pB1; float mnA, mnB, alA, alB; bf16x8 pa0, pa1, pa2, pa3; const int NT = seq / KVBLK;
    constexpr int SE = 0, SO = 0;
    SLOAD(SE, 0); asm volatile("s_waitcnt vmcnt(0)" ::: "memory"); SWRITE(0, SE); __syncthreads();
    qkt(pA0, pA1, K_lds, qr, qrl, r32, hi); partialSM(pA0, pA1, m_reg, mnA, alA);
    SLOAD(SO, KVBLK);
    SWAIT(); SWRITE(1, SO); __syncthreads();
    for (int j = 1; j + 1 < NT; j += 2) {
        SBAR(); qkt(pB0, pB1, K_lds + SHM_K, qr, qrl, r32, hi);
        finishSM(pA0, pA1, alA, l_reg, pa0, pa1, pa2, pa3); SBAR();
        SLOAD(SO, (j + 1) * KVBLK); SBAR();
        pv_d0(o, vb0, pa0, pa1, pa2, pa3); partialSM(pB0, pB1, m_reg, mnB, alB);
        __syncthreads(); SWAIT(); SWRITE(0, SE);
        RESC(alB); __syncthreads();
        SBAR(); qkt(pA0, pA1, K_lds, qr, qrl, r32, hi);
        finishSM(pB0, pB1, alB, l_reg, pa0, pa1, pa2, pa3); SBAR();
        SLOAD(SE, (j + 2) * KVBLK); SBAR();
        pv_d0(o, vb0 + SHM_V, pa0, pa1, pa2, pa3); partialSM(pA0, pA1, m_reg, mnA, alA);
        __syncthreads(); SWAIT(); SWRITE(1, SO);
        RESC(alA); __syncthreads();
    }
    SBAR(); qkt(pB0, pB1, K_lds + SHM_K, qr, qrl, r32, hi);
    finishSM(pA0, pA1, alA, l_reg, pa0, pa1, pa2, pa3); SBAR();
    pv_d0(o, vb0, pa0, pa1, pa2, pa3); partialSM(pB0, pB1, m_reg, mnB, alB);
    __syncthreads(); RESC(alB);
    finishSM(pB0, pB1, alB, l_reg, pa0, pa1, pa2, pa3); SBAR();
    pv_d0(o, vb0 + SHM_V, pa0, pa1, pa2, pa3);
    if (hi == 0) li_l[r32] = l_reg; asm volatile("s_waitcnt lgkmcnt(0)" ::: "memory");
    float rli[16];
#pragma unroll
    for (int r = 0; r < 16; ++r) rli[r] = __builtin_amdgcn_rcpf(li_l[crow(r, hi)]);
    bf16_t* Ow = Ob + (long)(wid * QBLK) * ldo;
#pragma unroll
    for (int r = 0; r < 16; ++r) { const int orow = crow(r, hi);
#pragma unroll
        for (int d0 = 0; d0 < 4; ++d0) Ow[(long)orow * ldo + d0 * 32 + r32] = f2bf(o[d0][r] * rli[r]); }
    __syncthreads();
#undef SLOAD
#undef SWRITE
#undef SWAIT
#undef RESC
}
}
namespace pg8 {
__device__ __forceinline__ unsigned cvt_pk_bf16(float lo, float hi) { unsigned r; asm volatile("v_cvt_pk_bf16_f32 %0, %1, %2" : "=v"(r) : "v"(lo), "v"(hi)); return r; }
typedef unsigned u32x2 __attribute__((ext_vector_type(2)));
__device__ __forceinline__ void st_bf16x4(bf16_t* p, f32x4 v) { u32x2 w; w.x = cvt_pk_bf16(v[0], v[1]); w.y = cvt_pk_bf16(v[2], v[3]); *(u32x2*)p = w; }

template <size_t OFF, int LDC> struct EpiPlain {
    static constexpr bool PERM = false, AFTER_DRAIN = false;
    unsigned char* ws;
    __device__ __forceinline__ void operator()(const f32x4 (&acc)[2][2][4][2], const Unit& u, int wr, int wc, int fr, int fq) const {
#pragma unroll
        for (int ai = 0; ai < 2; ++ai)
#pragma unroll
            for (int m = 0; m < 4; ++m) { bf16_t* rowp = (bf16_t*)(ws + OFF) + (size_t)(u.pm * BM + ai * HALF + wr * 64 + m * 16 + fr) * LDC + u.pn * BM + wc * 32 + 4 * fq;
#pragma unroll
                for (int bj = 0; bj < 2; ++bj)
#pragma unroll
                    for (int n = 0; n < 2; ++n) st_bf16x4(rowp + bj * HALF + n * 16, acc[ai][bj][m][n]); }
    }
};
struct EpiUp {
    static constexpr bool PERM = false, AFTER_DRAIN = false;
    unsigned char* ws;
    __device__ __forceinline__ void operator()(const f32x4 (&acc)[2][2][4][2], const Unit& u, int wr, int wc, int fr, int fq) const {
        bf16_t* O = (bf16_t*)(ws + (u.which ? WS_KVRAW : WS_QRAW)); const int ldc = u.which ? 2048 : 1536;
#pragma unroll
        for (int ai = 0; ai < 2; ++ai)
#pragma unroll
            for (int m = 0; m < 4; ++m) { bf16_t* rowp = O + (size_t)(u.pm * BM + ai * HALF + wr * 64 + m * 16 + fr) * ldc + u.pn * BM + wc * 32 + 4 * fq;
#pragma unroll
                for (int bj = 0; bj < 2; ++bj)
#pragma unroll
                    for (int n = 0; n < 2; ++n) st_bf16x4(rowp + bj * HALF + n * 16, acc[ai][bj][m][n]); }
    }
};
struct EpiInProj {
    static constexpr bool PERM = false, AFTER_DRAIN = false;
    unsigned char* ws;
    __device__ __forceinline__ void operator()(const f32x4 (&acc)[2][2][4][2], const Unit& u, int wr, int wc, int fr, int fq) const {
        const int pn = u.pn;
        bf16_t* cq = (bf16_t*)(ws + WS_CQ); bf16_t* ckv = (bf16_t*)(ws + WS_CKV); bf16_t* mlqk = (bf16_t*)(ws + WS_MLQK); bf16_t* mlv = (bf16_t*)(ws + WS_MLV); bf16_t* mlo = (bf16_t*)(ws + WS_MLO);
        float* hyt = (float*)(ws + WS_HYT); float* hytc = (float*)(ws + WS_HYTC); float* krope = (float*)(ws + WS_KROPE); float* gates = (float*)(ws + WS_GATES);
#pragma unroll
        for (int ai = 0; ai < 2; ++ai)
#pragma unroll
            for (int m = 0; m < 4; ++m) {
                const int row = u.pm * BM + ai * HALF + wr * 64 + m * 16 + fr;
#pragma unroll
                for (int bj = 0; bj < 2; ++bj)
#pragma unroll
                    for (int n = 0; n < 2; ++n) {
                        const int colt = bj * HALF + wc * 32 + n * 16 + 4 * fq; const f32x4 v = acc[ai][bj][m][n];
                        if (pn < 2) st_bf16x4(cq + (size_t)row * 512 + pn * 256 + colt, v);
                        else if (pn < 4) st_bf16x4(ckv + (size_t)row * 512 + (pn - 2) * 256 + colt, v);
                        else if (pn < 10) { const int ch = (pn - 4) * 256 + colt;
                            if (row < 16384) { const int b = row >> 12, t = row & 4095; float* o = hyt + ((size_t)(b * 1536 + ch)) * 4096 + t;
                                o[0] = v[0]; o[4096] = v[1]; o[8192] = v[2]; o[12288] = v[3]; }
                            else { const int rc = row - 16384, b = rc >> 8, t = rc & 255; float* o = hytc + ((size_t)(b * 1536 + ch)) * 256 + t;
                                if (u.atomic) { unsafeAtomicAdd(o, v[0]); unsafeAtomicAdd(o + 256, v[1]); unsafeAtomicAdd(o + 512, v[2]); unsafeAtomicAdd(o + 768, v[3]); }
                                else { o[0] = v[0]; o[256] = v[1]; o[512] = v[2]; o[768] = v[3]; } } }
                        else if (pn < 14) st_bf16x4(mlqk + (size_t)row * 1024 + (pn - 10) * 256 + colt, v);
                        else if (pn < 16) st_bf16x4(mlv + (size_t)row * 512 + (pn - 14) * 256 + colt, v);
                        else if (pn < 18) st_bf16x4(mlo + (size_t)row * 512 + (pn - 16) * 256 + colt, v);
                        else { float* o = colt < 64 ? krope + (size_t)row * 64 + colt : gates + (size_t)row * 16 + (colt - 64);
                            if (colt < 80) { if (u.atomic) { unsafeAtomicAdd(o, v[0]); unsafeAtomicAdd(o + 1, v[1]); unsafeAtomicAdd(o + 2, v[2]); unsafeAtomicAdd(o + 3, v[3]); } else *(f32x4*)o = v; } }
                    }
            }
    }
};
template <int LAYER, int GIDX> struct EpiResid {
    static constexpr bool PERM = false, AFTER_DRAIN = false;
    const float* xin; float* xl; unsigned char* ws;
    __device__ __forceinline__ void operator()(const f32x4 (&acc)[2][2][4][2], const Unit& u, int wr, int wc, int fr, int fq) const {
        float* xc = (float*)(ws + WS_XC); const float* mod = (const float*)(ws + WS_MOD) + (size_t)LAYER * 5 * 12288; constexpr int gidx = GIDX;
        float* base = u.pm < 64 ? xl + (size_t)u.pm * BM * 2048 : xc + (size_t)(u.pm - 64) * BM * 2048;
        const float* rbase = u.pm < 64 ? xin + (size_t)u.pm * BM * 2048 : base;
        const float* mrow = mod + (size_t)(u.pm < 64 ? (u.pm >> 4) : 4) * 12288 + gidx * 2048;
        const int col0 = u.pn * BM + wc * 32 + 4 * fq;
        f32x4 mv[2][2];
#pragma unroll
        for (int bj = 0; bj < 2; ++bj)
#pragma unroll
            for (int n = 0; n < 2; ++n) mv[bj][n] = *(const f32x4*)(mrow + col0 + bj * HALF + n * 16);
#pragma unroll
        for (int ai = 0; ai < 2; ++ai)
#pragma unroll
            for (int m = 0; m < 4; ++m) { float* rowp = base + (size_t)(ai * HALF + wr * 64 + m * 16 + fr) * 2048 + col0; const float* rrow = rbase + (size_t)(ai * HALF + wr * 64 + m * 16 + fr) * 2048 + col0;
#pragma unroll
                for (int bj = 0; bj < 2; ++bj)
#pragma unroll
                    for (int n = 0; n < 2; ++n) { f32x4* p = (f32x4*)(rowp + bj * HALF + n * 16); const f32x4 d = mv[bj][n] * acc[ai][bj][m][n];
                        if (u.atomic) { float* pf = (float*)p; unsafeAtomicAdd(pf, d[0]); unsafeAtomicAdd(pf + 1, d[1]); unsafeAtomicAdd(pf + 2, d[2]); unsafeAtomicAdd(pf + 3, d[3]); }
                        else { f32x4 x = *(const f32x4*)(rrow + bj * HALF + n * 16); x = x + d; *p = x; } } }
    }
};
struct EpiSwiglu {
    static constexpr bool PERM = false, AFTER_DRAIN = false;
    unsigned char* ws;
    __device__ __forceinline__ void operator()(const f32x4 (&acc)[2][2][4][2], const Unit& u, int wr, int wc, int fr, int fq) const {
#pragma unroll
        for (int ai = 0; ai < 2; ++ai)
#pragma unroll
            for (int m = 0; m < 4; ++m) { bf16_t* rowp = (bf16_t*)(ws + WS_HID) + (size_t)(u.pm * BM + ai * HALF + wr * 64 + m * 16 + fr) * FFH + u.pn * HALF + wc * 32 + 4 * fq;
#pragma unroll
                for (int n = 0; n < 2; ++n) { const f32x4 g = acc[ai][0][m][n], up = acc[ai][1][m][n]; f32x4 o;
#pragma unroll
                    for (int j = 0; j < 4; ++j) o[j] = g[j] / (1.f + __expf(-g[j])) * up[j];
                    st_bf16x4(rowp + n * 16, o); } }
    }
};
}
constexpr int TP = 136;
constexpr int TILE_B = 128 * TP * 2;
__device__ __forceinline__ void mma128(f32x16& acc, const LAS bf16_t* A, int m0, const LAS bf16_t* B, int n0, int r32, int hi) {
    const LAS bf16_t* pa = A + (m0 + r32) * TP + hi * 8; const LAS bf16_t* pb = B + (n0 + r32) * TP + hi * 8;
#pragma unroll
    for (int ks = 0; ks < 8; ++ks) { const bf16x8 a = *(const LAS bf16x8*)(pa + ks * 16), b = *(const LAS bf16x8*)(pb + ks * 16);
        acc = __builtin_amdgcn_mfma_f32_32x32x16_bf16(a, b, acc, 0, 0, 0); }
}


__device__ __forceinline__ float scan16_sum(const LAS float* v, int t) { const int g16 = t & ~15, r = t & 15; float s = 0.f;
#pragma unroll
    for (int i = 0; i < 16; ++i) { const float x = v[g16 + i]; s += (i <= r) ? x : 0.f; } return s; }
__device__ __forceinline__ float scan16_max(const LAS float* v, int t) { const int g16 = t & ~15, r = t & 15; float s = -INFINITY;
#pragma unroll
    for (int i = 0; i < 16; ++i) { const float x = v[g16 + i]; s = (i <= r) ? fmaxf(s, x) : s; } return s; }
__device__ __forceinline__ float group_off_sum(const LAS float* gt, int t) { const int g = t >> 4; float s = 0.f;
#pragma unroll
    for (int h = 0; h < 8; ++h) { const float x = gt[h]; s += (h < g) ? x : 0.f; } return s; }
__device__ __forceinline__ float group_off_max(const LAS float* gt, int t) { const int g = t >> 4; float s = -INFINITY;
#pragma unroll
    for (int h = 0; h < 8; ++h) { const float x = gt[h]; s = (h < g) ? fmaxf(s, x) : s; } return s; }

__device__ __forceinline__ int ml_rowbase(int dir, int b, int j) {
    if (j < 2) { const int oc = dir ? 1 - j : j; return ML + b * CTXL + oc * 128; }
    const int oc = dir ? 33 - j : j - 2; return b * SEQ + oc * 128;
}

struct Args { const float* in[31]; float* out; unsigned char* ws; int ph_lo, ph_hi; };
enum { I_X = 0, I_C, I_CTX, I_CCTX, I_ADAW, I_ADAB, I_N1G, I_N2G, I_WIN, I_QAN, I_KVAN, I_WUQ, I_WUKV, I_QN, I_KN, I_HCW, I_HCB, I_HW1, I_HB1, I_HW2, I_HB2, I_HW3, I_HDEC, I_HSKIP,
       I_MCW, I_MCB, I_MGB, I_MIXG, I_WOUT, I_FW1, I_FW2 };

constexpr int FFT_SLOTS = 8192 + 512;
__device__ __forceinline__ int fphys(int i) { return i + 2 * (i >> 5); }
__device__ __forceinline__ f32x2 cmul(f32x2 a, f32x2 b) { return (f32x2){a.x * b.x - a.y * b.y, a.x * b.y + a.y * b.x}; }
__device__ __forceinline__ f32x2 cmulc(f32x2 a, f32x2 b) { return (f32x2){a.x * b.x + a.y * b.y, a.y * b.x - a.x * b.y}; }
#define FC1 0.9238795325112867f
#define FS1 0.3826834323650898f
#define FR2 0.7071067811865476f
template <bool INV> __device__ __forceinline__ void radix16(f32x2 (&x)[16], f32x2 t0, f32x2 t1, f32x2 t2, f32x2 t3) {
    const f32x2 W16[8] = {{1.f, 0.f}, {FC1, -FS1}, {FR2, -FR2}, {FS1, -FC1}, {0.f, -1.f}, {-FS1, -FC1}, {-FR2, -FR2}, {-FC1, -FS1}};
    if (!INV) {
#pragma unroll
        for (int j = 0; j < 8; ++j) { const f32x2 u = x[j], v = x[j + 8]; x[j] = u + v; x[j + 8] = cmul(u - v, cmul(t0, W16[j])); }
#pragma unroll
        for (int g = 0; g < 2; ++g)
#pragma unroll
            for (int j = 0; j < 4; ++j) { const f32x2 u = x[8 * g + j], v = x[8 * g + j + 4]; x[8 * g + j] = u + v; x[8 * g + j + 4] = cmul(u - v, cmul(t1, W16[2 * j])); }
#pragma unroll
        for (int g = 0; g < 4; ++g)
#pragma unroll
            for (int j = 0; j < 2; ++j) { const f32x2 u = x[4 * g + j], v = x[4 * g + j + 2]; x[4 * g + j] = u + v; x[4 * g + j + 2] = cmul(u - v, cmul(t2, W16[4 * j])); }
#pragma unroll
        for (int g = 0; g < 8; ++g) { const f32x2 u = x[2 * g], v = x[2 * g + 1]; x[2 * g] = u + v; x[2 * g + 1] = cmul(u - v, t3); }
    } else {
#pragma unroll
        for (int g = 0; g < 8; ++g) { const f32x2 u = x[2 * g], t = cmulc(x[2 * g + 1], t3); x[2 * g] = u + t; x[2 * g + 1] = u - t; }
#pragma unroll
        for (int g = 0; g < 4; ++g)
#pragma unroll
            for (int j = 0; j < 2; ++j) { const f32x2 u = x[4 * g + j], t = cmulc(x[4 * g + j + 2], cmul(t2, W16[4 * j])); x[4 * g + j] = u + t; x[4 * g + j + 2] = u - t; }
#pragma unroll
        for (int g = 0; g < 2; ++g)
#pragma unroll
            for (int j = 0; j < 4; ++j) { const f32x2 u = x[8 * g + j], t = cmulc(x[8 * g + j + 4], cmul(t1, W16[2 * j])); x[8 * g + j] = u + t; x[8 * g + j + 4] = u - t; }
#pragma unroll
        for (int j = 0; j < 8; ++j) { const f32x2 u = x[j], t = cmulc(x[j + 8], cmul(t0, W16[j])); x[j] = u + t; x[j + 8] = u - t; }
    }
}
struct FftTw { f32x2 t[3][4]; };
__device__ __forceinline__ void fft_load_tw(FftTw& w, const f32x2* __restrict__ TW, int tid) {
#pragma unroll
    for (int p = 0; p < 3; ++p) { const int r = p == 0 ? tid : p == 1 ? (tid & 31) : (tid & 1);
#pragma unroll
        for (int k = 0; k < 4; ++k) w.t[p][k] = TW[(8192 - (8192 >> (4 * p + k))) + r]; }
}
template <int PASS, bool INV, bool SYNC> __device__ __forceinline__ void fft_pass(LAS f32x2* X, const FftTw& w, int tid) {
    asm volatile("" : "+v"(tid));
    constexpr int stride = PASS == 0 ? 512 : PASS == 1 ? 32 : 2;
    const int r = PASS == 0 ? tid : PASS == 1 ? (tid & 31) : (tid & 1);
    const int base = PASS == 0 ? tid : PASS == 1 ? ((tid >> 5) * 512 + r) : ((tid >> 1) * 32 + r);
    f32x2 x[16];
#pragma unroll
    for (int j = 0; j < 16; ++j) x[j] = X[fphys(base + j * stride)];
    f32x2 t0 = w.t[PASS][0], t1 = w.t[PASS][1], t2 = w.t[PASS][2], t3 = w.t[PASS][3];
    asm volatile("" : "+v"(t0.x), "+v"(t0.y), "+v"(t1.x), "+v"(t1.y), "+v"(t2.x), "+v"(t2.y), "+v"(t3.x), "+v"(t3.y));
    radix16<INV>(x, t0, t1, t2, t3);
#pragma unroll
    for (int j = 0; j < 16; ++j) X[fphys(base + j * stride)] = x[j];
    if (SYNC) __syncthreads(); else asm volatile("s_waitcnt lgkmcnt(0)" ::: "memory");
}
__device__ __forceinline__ int fft_pair(int tid, int q) { return (tid >> 1) * 16 + (tid & 1) * 8 + q; }
__device__ __forceinline__ void fft_fwd_full(LAS f32x2* X, const FftTw& TW, int tid) {
    fft_pass<0, false, true>(X, TW, tid); fft_pass<1, false, false>(X, TW, tid); fft_pass<2, false, false>(X, TW, tid);
    asm volatile("" : "+v"(tid));
#pragma unroll
    for (int q = 0; q < 8; ++q) { const int m = fft_pair(tid, q); LAS f32x4* p = (LAS f32x4*)(X + fphys(2 * m)); const f32x4 v = *p; *p = (f32x4){v.x + v.z, v.y + v.w, v.x - v.z, v.y - v.w}; }
    __syncthreads();
}
__device__ __forceinline__ void fft_conv(LAS f32x2* X, const LAS f32x2* Gs, const FftTw& TW, int tid) {
    fft_pass<0, false, true>(X, TW, tid); fft_pass<1, false, false>(X, TW, tid); fft_pass<2, false, false>(X, TW, tid);
    asm volatile("" : "+v"(tid));
#pragma unroll 2
    for (int q = 0; q < 8; ++q) { const int m = fft_pair(tid, q); LAS f32x4* p = (LAS f32x4*)(X + fphys(2 * m)); const f32x4 v = *p; const f32x4 g = *(const LAS f32x4*)(Gs + fphys(2 * m));
        const f32x2 a = cmul((f32x2){v.x + v.z, v.y + v.w}, (f32x2){g.x, g.y}), b = cmul((f32x2){v.x - v.z, v.y - v.w}, (f32x2){g.z, g.w});
        *p = (f32x4){a.x + b.x, a.y + b.y, a.x - b.x, a.y - b.y}; }
    asm volatile("s_waitcnt lgkmcnt(0)" ::: "memory");
    fft_pass<2, true, false>(X, TW, tid); fft_pass<1, true, true>(X, TW, tid); fft_pass<0, true, true>(X, TW, tid);
}

__device__ __forceinline__ float conv3(const float* __restrict__ p, int t, int L, float w0, float w1, float w2, float bias) {
    float r = bias + w1 * p[t]; if (t > 0) r += w0 * p[t - 1]; if (t < L - 1) r += w2 * p[t + 1]; return r;
}


#define XB_TMO      128
#define XB_XCNT(j)  (256  + 64 * (j))
#define XB_XSUB(j)  (1280 + 64 * (j))
#define XB_XGEN(j)  (2304 + 64 * (j))
#define XB_TOP      3328
#define XB_TOPGEN   3392
#define XCD_BAR_WORDS 3456
#define XB_SPIN_CAP (1u << 22)
__device__ __forceinline__ unsigned xb_ld(unsigned* p)              { return __hip_atomic_load(p, __ATOMIC_RELAXED, __HIP_MEMORY_SCOPE_AGENT); }
__device__ __forceinline__ unsigned xb_add(unsigned* p, unsigned v) { return __hip_atomic_fetch_add(p, v, __ATOMIC_RELAXED, __HIP_MEMORY_SCOPE_AGENT); }
__device__ __forceinline__ unsigned xb_xcc_id() { return (unsigned)__builtin_amdgcn_s_getreg((3 << 11) | 20) & 0xFu; }
#define XB_SPIN(cond, bar) do { unsigned _sp = 0; while (cond) { __builtin_amdgcn_s_sleep(1); \
    if ((++_sp & 255u) == 0u) { if (xb_ld(&(bar)[XB_TMO])) break; if (_sp > XB_SPIN_CAP) { atomicAdd(&(bar)[XB_TMO], 1u); break; } } } } while (0)
__device__ __forceinline__ void xcd_barrier_complete(unsigned* bar, unsigned x, unsigned& nloc, unsigned& nx) {
    const unsigned G = gridDim.x;
    unsigned sum, cnt, mine, sp = 0u;
    for (;;) {
        sum = 0u; cnt = 0u; mine = 0u;
#pragma unroll
        for (unsigned j = 0; j < 16; ++j) { const unsigned c = xb_ld(&bar[XB_XCNT(j)]); sum += c; cnt += (c > 0u) ? 1u : 0u; mine = (j == x) ? c : mine; }
        if (sum == G) break;
        __builtin_amdgcn_s_sleep(1);
        if ((++sp & 255u) == 0u) { if (xb_ld(&bar[XB_TMO])) break; if (sp > XB_SPIN_CAP) { atomicAdd(&bar[XB_TMO], 1u); break; } }
    }
    nloc = mine > 0u ? mine : 1u; nx = cnt > 0u ? cnt : 1u;
}
__device__ __forceinline__ void xcd_barrier(unsigned* bar, volatile LAS unsigned* st, bool first) {
    asm volatile("s_waitcnt vmcnt(0)" ::: "memory");
    __syncthreads();
    if (first) {
        const unsigned x = xb_xcc_id();
        __builtin_amdgcn_s_waitcnt(0);
        unsigned nloc = st[0], nx = st[1];
        if (nloc == 0u) { xcd_barrier_complete(bar, x, nloc, nx); st[0] = nloc; st[1] = nx; }
        const unsigned old = xb_add(&bar[XB_XSUB(x)], 1u);
        const unsigned gen = old / nloc;
        if (old + 1u == (gen + 1u) * nloc) {
            __builtin_amdgcn_fence(__ATOMIC_RELEASE, "agent");
            asm volatile("s_waitcnt vmcnt(0)" ::: "memory");
            const unsigned og = xb_add(&bar[XB_TOP], 1u);
            const unsigned tg = og / nx;
            if (og + 1u == (tg + 1u) * nx) xb_add(&bar[XB_TOPGEN], 1u);
            else XB_SPIN(xb_ld(&bar[XB_TOPGEN]) == tg, bar);
            __builtin_amdgcn_fence(__ATOMIC_ACQUIRE, "agent");
            xb_add(&bar[XB_XGEN(x)], 1u);
            asm volatile("s_waitcnt vmcnt(0)" ::: "memory");
        } else {
            XB_SPIN(xb_ld(&bar[XB_XGEN(x)]) == gen, bar);
            __builtin_amdgcn_fence(__ATOMIC_ACQUIRE, "agent");
            asm volatile("s_waitcnt vmcnt(0)" ::: "memory");
        }
    }
    __syncthreads();
}
template <int OFF> __device__ __forceinline__ unsigned long long karg() {
    unsigned long long v;
    asm volatile("s_load_dwordx2 %0, %1, %2\n\ts_waitcnt lgkmcnt(0)" : "=s"(v) : "s"(__builtin_amdgcn_kernarg_segment_ptr()), "n"(OFF) : "memory");
    return v;
}
__global__ void __launch_bounds__(NTHREADS, 2) fwd_kernel(Args args) {
    extern __shared__ __attribute__((aligned(16))) unsigned char lds_raw[];
    LAS unsigned char* lds = (LAS unsigned char*)lds_raw;
    const int WAVE_S = __builtin_amdgcn_readfirstlane((int)threadIdx.x >> 6);
#define XB_ST ((volatile LAS unsigned*)(lds + LDS_BYTES - 16))
#define XB_BAR ((unsigned*)ws + 4096)
#define XB_FIRST(res) do { int l_; asm volatile("v_mbcnt_lo_u32_b32 %0, -1, 0\n\tv_mbcnt_hi_u32_b32 %0, -1, %0" : "=v"(l_)); res = (WAVE_S == 0) && (l_ == 0); } while (0)
    typedef __attribute__((address_space(1))) unsigned char gbyte_t; typedef __attribute__((address_space(1))) const float gcfloat_t; typedef __attribute__((address_space(1))) float gfloat_t;
    unsigned char* const ws = (unsigned char*)(gbyte_t*)karg<256>();
    { bool f_; XB_FIRST(f_); if (f_) { XB_ST[0] = 0u; XB_ST[1] = 0u; (void)xb_add(&XB_BAR[XB_XCNT(xb_xcc_id())], 1u); } __syncthreads(); }
#define GRID_BAR() do { bool f_; XB_FIRST(f_); xcd_barrier(XB_BAR, XB_ST, f_); } while (0)
#define INP(i) ((const float*)(gcfloat_t*)karg<(i) * 8>())
#define OUT ((float*)(gfloat_t*)karg<248>())
#define MOD ((float*)(ws + WS_MOD))
#define TW ((const f32x2*)(ws + WS_TW))
#define TWW ((f32x2*)(ws + WS_TW))
#define H2L ((float*)(ws + WS_H2L))
#define H2C ((float*)(ws + WS_H2C))
#define MODP ((float*)(ws + WS_MODP))
#define KROPE ((float*)(ws + WS_KROPE))
#define GATES ((float*)(ws + WS_GATES))
#define MLN ((float*)(ws + WS_MLN))
#define XC ((float*)(ws + WS_XC))
#define WIN ((bf16_t*)(ws + WS_WIN))
#define WUQ ((bf16_t*)(ws + WS_WUQ))
#define WUKV ((bf16_t*)(ws + WS_WUKV))
#define WOUT ((bf16_t*)(ws + WS_WOUT))
#define W1 ((bf16_t*)(ws + WS_W1))
#define W2 ((bf16_t*)(ws + WS_W2))
#define ABUF ((bf16_t*)(ws + WS_A))
#define CQ ((bf16_t*)(ws + WS_CQ))
#define CKV ((bf16_t*)(ws + WS_CKV))
#define HYT ((float*)(ws + WS_HYT))
#define HYTC ((float*)(ws + WS_HYTC))
#define MLQK ((bf16_t*)(ws + WS_MLQK))
#define MLQK2 ((bf16_t*)(ws + WS_MLQK2))
#define MLV ((bf16_t*)(ws + WS_MLV))
#define MLO ((bf16_t*)(ws + WS_MLO))
#define QRAW ((bf16_t*)(ws + WS_QRAW))
#define KVRAW ((bf16_t*)(ws + WS_KVRAW))
#define QB ((bf16_t*)(ws + WS_Q))
#define QCB ((bf16_t*)(ws + WS_QC))
#define KB ((bf16_t*)(ws + WS_K))
#define VB ((bf16_t*)(ws + WS_V))
#define AO ((bf16_t*)(ws + WS_AO))
#define FILT ((float*)(ws + WS_Q))
#define YT ((float*)(ws + WS_YT))
#define YTC ((float*)(ws + WS_YTC))
#define CST ((float*)(ws + WS_CST))
#define HF ((float*)(ws + WS_HF))
#define HB ((float*)(ws + WS_HB))
#define HID ((bf16_t*)(ws + WS_HID))
#define MLOC ((float*)(ws + WS_MLS))
#define BLAST ((float*)(ws + WS_MLS) + 1088)
#define MIN_ ((float*)(ws + WS_MLS) + 2176)
#ifndef PMASK
#define PMASK 0xFFFFu
#endif
#define PH_BEGIN(n) { if constexpr ((PMASK >> (n)) & 1u) { int tid; asm volatile("v_mbcnt_lo_u32_b32 %0, -1, 0\n\tv_mbcnt_hi_u32_b32 %0, -1, %0" : "=v"(tid)); tid += WAVE_S * 64; \
    const int lane = tid & 63, wave = __builtin_amdgcn_readfirstlane(tid >> 6); const int G = gridDim.x, bid = blockIdx.x, gw = bid * NWAVES + wave, NGW = G * NWAVES; \
    const long gtid = (long)bid * NTHREADS + tid, GT = (long)G * NTHREADS; const int r32 = lane & 31, hi = lane >> 5; (void)gw; (void)NGW; (void)gtid; (void)GT; (void)r32; (void)hi;
#define PH_END } } GRID_BAR(); for (int ds_ = 0; ds_ < DUP_SYNC; ++ds_) GRID_BAR();

#define CONVERT_WEIGHTS(l) do { LAS float* scr = (LAS float*)(lds + wave * 8448); \
        constexpr int I0 = 32 * 152, I1 = 8 * 48, I2 = 8 * 64, I3 = 32 * 64, I4 = 32 * 352, I5 = 88 * 64; \
        for (int it = gw; it < I0 + I1 + I2 + I3 + I4 + I5; it += NGW) { int r = it; \
            if (r < I0) { wt_item(INP(I_WIN) + (size_t)(l) * DM * NIN, NIN, DM, WIN, nullptr, scr, r / 152, r % 152, lane, MapWin()); continue; } r -= I0; \
            if (r < I1) { wt_item(INP(I_WUQ) + (size_t)(l) * 512 * 1536, 1536, 512, WUQ, INP(I_QAN) + (l) * 512, scr, r / 48, r % 48, lane, MapIdent()); continue; } r -= I1; \
            if (r < I2) { wt_item(INP(I_WUKV) + (size_t)(l) * 512 * 2048, 2048, 512, WUKV, INP(I_KVAN) + (l) * 512, scr, r / 64, r % 64, lane, MapIdent()); continue; } r -= I2; \
            if (r < I3) { wt_item(INP(I_WOUT) + (size_t)(l) * DM * DM, DM, DM, WOUT, nullptr, scr, r / 64, r % 64, lane, MapIdent()); continue; } r -= I3; \
            if (r < I4) { wt_item(INP(I_FW1) + (size_t)(l) * DM * 2 * FFH, 2 * FFH, DM, W1, nullptr, scr, r / 352, r % 352, lane, MapW1()); continue; } r -= I4; \
            wt_item(INP(I_FW2) + (size_t)(l) * FFH * DM, DM, FFH, W2, nullptr, scr, r / 64, r % 64, lane, MapIdent()); } } while (0)


#define BUILD_FILTERS(l) do { LAS float* w3t = (LAS float*)lds; LAS float* h2t = (LAS float*)(lds + 16384 + 256); \
        const float* w3g = INP(I_HW3) + (size_t)(l) * 64 * 2048; const float* decg = INP(I_HDEC) + (size_t)(l) * 2048; const float* h2g = H2L + (size_t)(l) * SEQ * 64; \
        for (int it = bid; it < 1024; it += G) { const int ob_ = (it & 31) * 64, tb_ = (it >> 5) * 128; \
            __syncthreads(); \
            _Pragma("unroll") for (int q = 0; q < 8; ++q) { const int e = tid + NTHREADS * q; w3t[(e >> 6) * 65 + (e & 63)] = w3g[(size_t)(e >> 6) * 2048 + ob_ + (e & 63)]; } \
            _Pragma("unroll") for (int q = 0; q < 4; ++q) { const int e = tid + NTHREADS * q; *(LAS f32x4*)(h2t + 4 * e) = *(const f32x4*)(h2g + (size_t)tb_ * 64 + 4 * e); } \
            __syncthreads(); \
            const int to = tid & 63, tq = tid >> 6; float acc[16]; \
            _Pragma("unroll") for (int k = 0; k < 16; ++k) acc[k] = 0.f; \
            _Pragma("unroll 2") for (int i4 = 0; i4 < 16; ++i4) { const float w0 = w3t[(4 * i4) * 65 + to], w1 = w3t[(4 * i4 + 1) * 65 + to], w2 = w3t[(4 * i4 + 2) * 65 + to], w3v = w3t[(4 * i4 + 3) * 65 + to]; \
                _Pragma("unroll") for (int k = 0; k < 16; ++k) { const f32x4 hv = *(const LAS f32x4*)(h2t + (tq * 16 + k) * 64 + 4 * i4); acc[k] += hv.x * w0 + hv.y * w1 + hv.z * w2 + hv.w * w3v; } } \
            const float dc = decg[ob_ + to]; float* dst = FILT + (size_t)(ob_ + to) * 4096 + tb_ + tq * 16; \
            _Pragma("unroll") for (int k4 = 0; k4 < 4; ++k4) { f32x4 o; \
                _Pragma("unroll") for (int k = 0; k < 4; ++k) { const float tn = (float)(tb_ + tq * 16 + 4 * k4 + k) * (1.f / 4096.f); o[k] = acc[4 * k4 + k] * (expf(-tn * dc) + 0.05f); } \
                *(f32x4*)(dst + 4 * k4) = o; } } \
        __syncthreads(); } while (0)

#define NORM_ROWS(l, gptr, si, nrows, xsrc) do { const float* gp_ = (gptr); const float* const xo_ = (xsrc); for (int rp_ = 0; rp_ <= DUP_NORM; ++rp_) for (int r = gw; r < (nrows); r += NGW) { \
        const float* xr = r < ML ? xo_ + (size_t)r * DM : XC + (size_t)(r - ML) * DM; const float* mrow = MOD + ((size_t)(l) * 5 + (r < ML ? (r >> 12) : 4)) * 12288; \
        f32x4 v[8]; float ss = 0.f; \
        _Pragma("unroll") for (int j = 0; j < 8; ++j) { v[j] = *(const f32x4*)(xr + 4 * lane + 256 * j); ss += v[j].x * v[j].x + v[j].y * v[j].y + v[j].z * v[j].z + v[j].w * v[j].w; } \
        const float rs = rsqrtf(wave_sum(ss) * (1.f / DM) + EPS); \
        _Pragma("unroll") for (int j = 0; j < 8; ++j) { const int c = 4 * lane + 256 * j; const f32x4 g = *(const f32x4*)(gp_ + c), sh = *(const f32x4*)(mrow + (si) * DM + c), sc = *(const f32x4*)(mrow + ((si) + 1) * DM + c); \
            const f32x4 y = (v[j] * rs * g) * (sc + 1.f) + sh; pg8::st_bf16x4(ABUF + (size_t)r * DM + c, y); } } } while (0)

    PH_BEGIN(0)
    for (int rg_ = 0; rg_ <= DUP_G0; ++rg_) {
        { const f32x4* s2 = (const f32x4*)INP(I_CTX); f32x4* d2 = (f32x4*)XC; for (long i = gtid; i < (long)MC * DM / 4; i += GT) d2[i] = s2[i]; }
        { LAS float* sc = (LAS float*)lds;
          for (int it = bid; it < 2 * 32 * 12; it += G) { const int nc = it % 12, kc = (it / 12) % 32, l = it / 384;
            __syncthreads();
            if (tid < 320) { const float* cp = INP(I_C); const float* ccp = INP(I_CCTX); const int i = tid >> 6, k = kc * 64 + (tid & 63); const float cv = i < 4 ? cp[i * DM + k] : ccp[k]; sc[tid] = siluf(cv); }
            __syncthreads();
            const int n = nc * 1024 + tid * 2; const float* wp = INP(I_ADAW) + ((size_t)l * DM + kc * 64) * 12288 + n;
            f32x2 a0 = {0.f, 0.f}, a1 = a0, a2 = a0, a3 = a0, a4 = a0;
#pragma unroll 8
            for (int k = 0; k < 64; ++k) { const f32x2 w = *(const f32x2*)(wp + (size_t)k * 12288); a0 += w * sc[k]; a1 += w * sc[64 + k]; a2 += w * sc[128 + k]; a3 += w * sc[192 + k]; a4 += w * sc[256 + k]; }
            float* o = MODP + (((size_t)kc * 2 + l) * 5) * 12288 + n;
            *(f32x2*)(o) = a0; *(f32x2*)(o + 12288) = a1; *(f32x2*)(o + 2 * 12288) = a2; *(f32x2*)(o + 3 * 12288) = a3; *(f32x2*)(o + 4 * 12288) = a4; }
          __syncthreads(); }
        for (long e = gtid; e < 8191; e += GT) { int s = 0; while (e >= 8192 - (8192 >> (s + 1))) ++s; const int pos = (int)e - (8192 - (8192 >> s));
            float sn, cs; sincospif((float)(pos << s) * (1.f / 4096.f), &sn, &cs); TWW[e] = (f32x2){cs, -sn}; }
        for (int it = gw; it < 2 * (SEQ + CTXL); it += NGW) { const int l = it / (SEQ + CTXL), rr = it % (SEQ + CTXL); const bool isc = rr >= SEQ; const int t = isc ? rr - SEQ : rr; const float Lf = isc ? 256.f : 4096.f;
            float feat = 0.f;
            if (lane == 0) feat = (float)t / Lf; else if (lane <= 16) feat = cospif(2.f * (float)(t * lane) / Lf); else if (lane <= 32) feat = sinpif(2.f * (float)(t * (lane - 16)) / Lf);
            const float* w1 = INP(I_HW1) + (size_t)l * 33 * 64; float a = INP(I_HB1)[l * 64 + lane];
            for (int i = 0; i < 33; ++i) a += __int_as_float(__builtin_amdgcn_readlane(__float_as_int(feat), i)) * w1[i * 64 + lane];
            const float h1 = sinf(a);
            const float* w2 = INP(I_HW2) + (size_t)l * 64 * 64; float a2 = INP(I_HB2)[l * 64 + lane];
            for (int i = 0; i < 64; ++i) a2 += __int_as_float(__builtin_amdgcn_readlane(__float_as_int(h1), i)) * w2[i * 64 + lane];
            (isc ? H2C + ((size_t)l * CTXL + t) * 64 : H2L + ((size_t)l * SEQ + t) * 64)[lane] = sinf(a2); }
        __syncthreads();
        CONVERT_WEIGHTS(0);
    }
    PH_END
    cg::this_grid().sync();
    PH_BEGIN(1)
    for (int rg_ = 0; rg_ <= DUP_G1; ++rg_) {
        for (long e = gtid; e < 2 * 5 * 12288; e += GT) { const int n = (int)(e % 12288), l = (int)(e / (5 * 12288)); float a = INP(I_ADAB)[l * 12288 + n];
            for (int kc = 0; kc < 32; ++kc) a += MODP[(size_t)kc * 2 * 5 * 12288 + e]; MOD[e] = a; }
        BUILD_FILTERS(0);
    }
    PH_END

    { constexpr int l = 0; constexpr bool need_ctx = (l == 0);
        PH_BEGIN(2)
            NORM_ROWS(l, INP(I_N1G) + l * DM, 0, MT, (l == 0 ? (float*)INP(I_X) : OUT));
            if constexpr (l == 0) { const f32x4 z4 = {0.f, 0.f, 0.f, 0.f};
                f32x4* a0 = (f32x4*)HYTC; for (long i = gtid; i < (long)NB * 1536 * CTXL / 4; i += GT) a0[i] = z4;
                f32x4* a1 = (f32x4*)(KROPE + (size_t)ML * 64); for (long i = gtid; i < (long)MC * 64 / 4; i += GT) a1[i] = z4;
                f32x4* a2 = (f32x4*)(GATES + (size_t)ML * 16); for (long i = gtid; i < (long)MC * 16 / 4; i += GT) a2[i] = z4; }
            if (l == 1) { __syncthreads(); CONVERT_WEIGHTS(1); __syncthreads(); BUILD_FILTERS(1); }
        PH_END
        PH_BEGIN(3)
            pg8::Gemm g{ABUF, WIN, MT, NINP, DM}; pg8::EpiInProj E{ws};
            if constexpr (l == 0) { pg8::InProjL0Order S; S.init(G, bid, DM); pg8::gemm_phase<pg8::EpiInProj, pg8::InProjL0Order, true, true>(lds, g, S, E, tid); }
            else { pg8::InProjL1Order S; S.init(G, bid, DM); for (int rp_ = 0; rp_ <= DUP_INPROJ; ++rp_) pg8::gemm_phase<pg8::EpiInProj, pg8::InProjL1Order, true, true>(lds, g, S, E, tid); }
        PH_END
        PH_BEGIN(4)
            { pg8::Gemm g{CQ, WUQ, MT, 1536, 512, CKV, WUKV}; pg8::DualUpOrder S; S.init(G, bid); pg8::EpiUp E{ws};
              for (int rp_ = 0; rp_ <= DUP_UP; ++rp_) pg8::gemm_phase<pg8::EpiUp, pg8::DualUpOrder, true, true>(lds, g, S, E, tid); }
            { const float* cw = INP(I_MCW) + (size_t)l * 3 * 1024; const float* cb = INP(I_MCB) + (size_t)l * 1024;
              for (int rp_ = 0; rp_ <= DUP_M0; ++rp_)
              for (long e = gtid; e < (long)MT * 128; e += GT) { const int r = (int)(e >> 7), c8 = (int)(e & 127) * 8;
                int t, L; if (r < ML) { t = r & 4095; L = SEQ; } else { t = (r - ML) & 255; L = CTXL; }
                const bf16x8 z = {0, 0, 0, 0, 0, 0, 0, 0};
                const bf16x8 xm = *(const bf16x8*)(MLQK + (size_t)r * 1024 + c8), xp = t > 0 ? *(const bf16x8*)(MLQK + (size_t)(r - 1) * 1024 + c8) : z, xn = t < L - 1 ? *(const bf16x8*)(MLQK + (size_t)(r + 1) * 1024 + c8) : z;
                float y[8]; const float qs = c8 < 512 ? 0.08838834764831845f : 1.f;
#pragma unroll
                for (int i = 0; i < 8; ++i) { const int c = c8 + i; y[i] = siluf(cb[c] + cw[c] * bf2f_s(xp[i]) + cw[1024 + c] * bf2f_s(xm[i]) + cw[2048 + c] * bf2f_s(xn[i])) * qs; }
                u32x4 o; o.x = cvtpk(y[0], y[1]); o.y = cvtpk(y[2], y[3]); o.z = cvtpk(y[4], y[5]); o.w = cvtpk(y[6], y[7]); *(u32x4*)(MLQK2 + (size_t)r * 1024 + c8) = o; } }
            { LAS f32x2* X = (LAS f32x2*)lds; LAS f32x2* Gs = (LAS f32x2*)(lds + FFT_SLOTS * 8); LAS float* w3s = (LAS float*)(lds + 2 * FFT_SLOTS * 8);
              const float* hcw = INP(I_HCW) + (size_t)l * 3 * 1536; const float* hcb = INP(I_HCB) + (size_t)l * 1536;
              const float* w3 = INP(I_HW3) + (size_t)l * 64 * 2048; const float* dec = INP(I_HDEC) + (size_t)l * 2048; const float* skip = INP(I_HSKIP) + (size_t)l * 1024;
              const float* H2 = H2L + (size_t)l * SEQ * 64;
              FftTw ftw; fft_load_tw(ftw, TW, tid);
              for (int rep_ = 0; rep_ <= DUP_HY; ++rep_)
              for (int c0 = bid; c0 < 512; c0 += G) { int c = c0; asm volatile("" : "+s"(c));
                const float vw0 = hcw[c], vw1 = hcw[1536 + c], vw2 = hcw[3072 + c], vbb = hcb[c];
                for (int n = 0; n < 2; ++n) {
                    const int of = n * 1024 + c, ob = n * 1024 + 512 + c;
                    __syncthreads();
                    { const float* ff = FILT + (size_t)of * 4096; const float* fb = FILT + (size_t)ob * 4096;
#pragma unroll 2
                      for (int q = 0; q < 8; ++q) { const int t = tid + 512 * q; Gs[fphys(t)] = (f32x2){ff[t], 0.f};
                        if (t == 0) Gs[fphys(4096)] = (f32x2){0.f, 0.f}; else Gs[fphys(8192 - t)] = (f32x2){fb[t], 0.f}; } }
                    __syncthreads();
                    fft_fwd_full(Gs, ftw, tid);
                    const float sk = skip[n * 512 + c];
                    const int gch = (n + 1) * 512 + c;
                    const float gw0 = hcw[gch], gw1 = hcw[1536 + gch], gw2 = hcw[3072 + gch], gbb = hcb[gch];
#pragma unroll 1
                    for (int bp = 0; bp < 2; ++bp) {
                        const float* u0 = HYT + ((size_t)((2 * bp) * 1536 + c)) * 4096; const float* u1 = HYT + ((size_t)((2 * bp + 1) * 1536 + c)) * 4096;
                        float* y0p = YT + ((size_t)((2 * bp) * 512 + c)) * 4096; float* y1p = YT + ((size_t)((2 * bp + 1) * 512 + c)) * 4096;
                        const float* g0p = HYT + ((size_t)((2 * bp) * 1536 + gch)) * 4096; const float* g1p = HYT + ((size_t)((2 * bp + 1) * 1536 + gch)) * 4096;
                        f32x2 zq[8], gq[8];
#pragma unroll
                        for (int q = 0; q < 8; ++q) { const int t = tid + 512 * q;
                            if (n == 0) { zq[q].x = conv3(u0, t, SEQ, vw0, vw1, vw2, vbb); zq[q].y = conv3(u1, t, SEQ, vw0, vw1, vw2, vbb); } else { zq[q].x = y0p[t]; zq[q].y = y1p[t]; }
                            gq[q].x = conv3(g0p, t, SEQ, gw0, gw1, gw2, gbb); gq[q].y = conv3(g1p, t, SEQ, gw0, gw1, gw2, gbb); }
#pragma unroll
                        for (int q = 0; q < 8; ++q) { const int t = tid + 512 * q; X[fphys(t)] = zq[q]; X[fphys(4096 + t)] = (f32x2){0.f, 0.f}; }
                        __syncthreads();
                        fft_conv(X, Gs, ftw, tid);
#pragma unroll
                        for (int q = 0; q < 8; ++q) { const int t = tid + 512 * q; const f32x2 y = X[fphys(t)] * (1.f / 8192.f);
                            y0p[t] = gq[q].x * (y.x + sk * zq[q].x); y1p[t] = gq[q].y * (y.y + sk * zq[q].y); }
                        __syncthreads();
                    }
                }
              }
              if (need_ctx) {
                LAS float* hf = (LAS float*)lds;
                LAS float* zs = (LAS float*)(lds + 4096);
                LAS float* w3c = (LAS float*)(lds + 8192);
                const float* H2c = H2C + (size_t)l * CTXL * 64;
                for (int c = bid; c < 512; c += G) {
                    __syncthreads();
                    if (tid < 256) { const int f = tid >> 6, i = tid & 63; w3c[tid] = w3[i * 2048 + (f >> 1) * 1024 + (f & 1) * 512 + c]; }
                    __syncthreads();
                    for (int e = tid; e < 1024; e += NTHREADS) { const int f = e >> 8, t = e & 255; const int o = (f >> 1) * 1024 + (f & 1) * 512 + c; float a = 0.f;
                        for (int i = 0; i < 64; ++i) a += H2c[t * 64 + i] * w3c[f * 64 + i];
                        hf[e] = a * (expf(-((float)t * (1.f / 256.f)) * dec[o]) + 0.05f); }
                    const int b = tid >> 7; float zv[2], zc[2];
#pragma unroll
                    for (int q = 0; q < 2; ++q) { const int t = (tid & 127) + 128 * q; zv[q] = conv3(HYTC + ((size_t)(b * 1536 + c)) * 256, t, CTXL, hcw[c], hcw[1536 + c], hcw[3072 + c], hcb[c]); zs[b * 256 + t] = zv[q]; }
                    __syncthreads();
                    for (int n = 0; n < 2; ++n) { const LAS float* gf = hf + n * 512; const LAS float* gb = hf + n * 512 + 256; const int gch = (n + 1) * 512 + c;
#pragma unroll
                        for (int q = 0; q < 2; ++q) { const int t = (tid & 127) + 128 * q; float y = 0.f;
                            for (int s = 0; s <= t; ++s) y += zs[b * 256 + s] * gf[t - s];
                            for (int s = t + 1; s < 256; ++s) y += zs[b * 256 + s] * gb[s - t];
                            const float gate = conv3(HYTC + ((size_t)(b * 1536 + gch)) * 256, t, CTXL, hcw[gch], hcw[1536 + gch], hcw[3072 + gch], hcb[gch]);
                            zc[q] = gate * (y + skip[n * 512 + c] * zv[q]); }
                        __syncthreads();
#pragma unroll
                        for (int q = 0; q < 2; ++q) { const int t = (tid & 127) + 128 * q; zv[q] = zc[q]; if (n == 0) zs[b * 256 + t] = zc[q]; else YTC[((size_t)(b * 512 + c)) * 256 + t] = zc[q]; }
                        __syncthreads(); }
                }
              }
            }
        PH_END
        PH_BEGIN(5)
            { LAS f32x2* rtab = (LAS f32x2*)lds;
              __syncthreads();
              for (int e = tid; e < 1024; e += NTHREADS) { const float ang = (float)(e >> 4) * powf(10000.f, -(float)(e & 15) * (1.f / 16.f)); rtab[e] = (f32x2){cosf(ang), sinf(ang)}; }
              __syncthreads();
              const int l16 = lane & 15, ts = lane >> 4; const bool xhi = l16 >= 8, rowax = (l16 & 7) < 4; const int f0 = 4 * (l16 & 3);
              const float* qg = INP(I_QN) + l * 192; const float* kg = INP(I_KN) + l * 192;
              float qgn[8], kgn[8], qgr[4], kgr[4];
#pragma unroll
              for (int i = 0; i < 8; ++i) { qgn[i] = qg[8 * l16 + i]; kgn[i] = kg[8 * l16 + i]; }
#pragma unroll
              for (int i = 0; i < 4; ++i) { qgr[i] = qg[128 + 4 * l16 + i]; kgr[i] = kg[128 + 4 * l16 + i]; }
#define RED16(v) do { v += swz_xor<1>(v); v += swz_xor<2>(v); v += swz_xor<4>(v); v += swz_xor<8>(v); } while (0)
              for (int rp_ = 0; rp_ <= DUP_POST; ++rp_)
              for (int r0 = gw * 4; r0 < MT; r0 += NGW * 4) { const int r = r0 + ts;
                int b, t, key; const bool isl = r < ML; if (isl) { b = r >> 12; t = r & 4095; key = CTXL + t; } else { b = (r - ML) >> 8; t = (r - ML) & 255; key = t; }
                const bf16_t* qrow = QRAW + (size_t)r * 1536; const bf16_t* kvrow = KVRAW + (size_t)r * 2048;
                bf16x8 cqv[4], ckv4[4], qn_[8], kn_[8], vn_[8]; u32x2 qr_[8];
#pragma unroll
                for (int i = 0; i < 4; ++i) { cqv[i] = *(const bf16x8*)(CQ + (size_t)r * 512 + 32 * l16 + 8 * i); ckv4[i] = *(const bf16x8*)(CKV + (size_t)r * 512 + 32 * l16 + 8 * i); }
                const f32x4 krv = *(const f32x4*)(KROPE + (size_t)r * 64 + 4 * l16);
#pragma unroll
                for (int h = 0; h < 8; ++h) { qn_[h] = *(const bf16x8*)(qrow + h * 192 + 8 * l16); qr_[h] = *(const u32x2*)(qrow + h * 192 + 128 + 4 * l16);
                    kn_[h] = *(const bf16x8*)(kvrow + h * 256 + 8 * l16); vn_[h] = *(const bf16x8*)(kvrow + h * 256 + 128 + 8 * l16); }
                float ssq = 0.f, sskv = 0.f;
#pragma unroll
                for (int i = 0; i < 4; ++i)
#pragma unroll
                    for (int e = 0; e < 8; ++e) { const float x = bf2f_s(cqv[i][e]), y = bf2f_s(ckv4[i][e]); ssq += x * x; sskv += y * y; }
                RED16(ssq); RED16(sskv);
                const float rsq = rsqrtf(ssq * (1.f / 512.f) + EPS), rskv = rsqrtf(sskv * (1.f / 512.f) + EPS);
                float cs[4], sn[4];
#pragma unroll
                for (int i = 0; i < 4; ++i) { cs[i] = 1.f; sn[i] = 0.f; }
                if (isl) { const int pos = rowax ? (t >> 6) : (t & 63);
#pragma unroll
                    for (int i = 0; i < 4; ++i) { const f32x2 e = rtab[pos * 16 + f0 + i]; cs[i] = e.x; sn[i] = e.y; } }
                float krss = krv.x * krv.x + krv.y * krv.y + krv.z * krv.z + krv.w * krv.w;
#pragma unroll
                for (int h = 0; h < 8; ++h) {
                    float xn[8], xr[4]; float ss = 0.f;
#pragma unroll
                    for (int i = 0; i < 8; ++i) { xn[i] = bf2f_s(qn_[h][i]) * rsq; ss += xn[i] * xn[i]; }
                    xr[0] = __uint_as_float(qr_[h].x << 16) * rsq; xr[1] = __uint_as_float(qr_[h].x & 0xffff0000u) * rsq; xr[2] = __uint_as_float(qr_[h].y << 16) * rsq; xr[3] = __uint_as_float(qr_[h].y & 0xffff0000u) * rsq;
#pragma unroll
                    for (int i = 0; i < 4; ++i) ss += xr[i] * xr[i];
                    RED16(ss);
                    float rn = rsqrtf(ss * (1.f / 192.f) + EPS);
                    if (isl || need_ctx) {
                        bf16_t* qo = isl ? QB + ((size_t)((b * 8 + h) * SEQ + t)) * 192 : QCB + ((size_t)((b * 8 + h) * CTXL + t)) * 192;
                        u32x4 w; w.x = cvtpk(xn[0] * rn * qgn[0], xn[1] * rn * qgn[1]); w.y = cvtpk(xn[2] * rn * qgn[2], xn[3] * rn * qgn[3]); w.z = cvtpk(xn[4] * rn * qgn[4], xn[5] * rn * qgn[5]); w.w = cvtpk(xn[6] * rn * qgn[6], xn[7] * rn * qgn[7]);
                        *(u32x4*)(qo + 8 * l16) = w;
                        float yo[4];
#pragma unroll
                        for (int i = 0; i < 4; ++i) { const float v = xr[i] * rn * qgr[i]; const float pr = swz_xor<8>(v); yo[i] = xhi ? v * cs[i] + pr * sn[i] : v * cs[i] - pr * sn[i]; }
                        u32x2 w2; w2.x = cvtpk(yo[0], yo[1]); w2.y = cvtpk(yo[2], yo[3]); *(u32x2*)(qo + 128 + 4 * l16) = w2; }
                    float yn[8]; ss = krss;
#pragma unroll
                    for (int i = 0; i < 8; ++i) { yn[i] = bf2f_s(kn_[h][i]) * rskv; ss += yn[i] * yn[i]; }
                    RED16(ss);
                    rn = rsqrtf(ss * (1.f / 192.f) + EPS);
                    { bf16_t* ko = KB + ((size_t)((b * 8 + h) * NKEY + key)) * 192;
                      u32x4 w; w.x = cvtpk(yn[0] * rn * kgn[0], yn[1] * rn * kgn[1]); w.y = cvtpk(yn[2] * rn * kgn[2], yn[3] * rn * kgn[3]); w.z = cvtpk(yn[4] * rn * kgn[4], yn[5] * rn * kgn[5]); w.w = cvtpk(yn[6] * rn * kgn[6], yn[7] * rn * kgn[7]);
                      *(u32x4*)(ko + 8 * l16) = w;
                      const float kr4[4] = {krv.x, krv.y, krv.z, krv.w}; float yo[4];
#pragma unroll
                      for (int i = 0; i < 4; ++i) { const float v = kr4[i] * rn * kgr[i]; const float pr = swz_xor<8>(v); yo[i] = xhi ? v * cs[i] + pr * sn[i] : v * cs[i] - pr * sn[i]; }
                      u32x2 w2; w2.x = cvtpk(yo[0], yo[1]); w2.y = cvtpk(yo[2], yo[3]); *(u32x2*)(ko + 128 + 4 * l16) = w2;
                      bf16_t* vo = VB + ((size_t)((b * 8 + h) * NKEY + key)) * 128;
                      u32x4 wv; wv.x = cvtpk(bf2f_s(vn_[h][0]) * rskv, bf2f_s(vn_[h][1]) * rskv); wv.y = cvtpk(bf2f_s(vn_[h][2]) * rskv, bf2f_s(vn_[h][3]) * rskv);
                      wv.z = cvtpk(bf2f_s(vn_[h][4]) * rskv, bf2f_s(vn_[h][5]) * rskv); wv.w = cvtpk(bf2f_s(vn_[h][6]) * rskv, bf2f_s(vn_[h][7]) * rskv);
                      *(u32x4*)(vo + 8 * l16) = wv; }
                }
              }
#undef RED16
              __syncthreads(); }
            { LAS bf16_t* kwT = (LAS bf16_t*)lds; LAS bf16_t* vT = (LAS bf16_t*)(lds + TILE_B); LAS float* ar = (LAS float*)(lds + 4 * TILE_B);
              LAS float* a_li = ar, *a_lf = ar + 128, *a_b = ar + 256, *a_g = ar + 384, *a_w = ar + 512, *a_gt = ar + 640;
              const float* gb = INP(I_MGB) + l * 16;
              for (int rep_ = 0; rep_ <= DUP_ML; ++rep_)
              for (int u = bid; u < 1088; u += G) { const int j = u % 34, h = (u / 34) & 3, b = (u / 136) & 3, dir = u / 544, sc = (dir * 4 + b) * 4 + h; const int rowbase = ml_rowbase(dir, b, j);
                __syncthreads();
                bf16x8 kk[4], vv[4];
#pragma unroll
                for (int i = 0; i < 4; ++i) { const int idx = tid + NTHREADS * i, s = idx & 127, c8 = (idx >> 7) * 8; const int row = rowbase + (dir ? 127 - s : s);
                    kk[i] = *(const bf16x8*)(MLQK2 + (size_t)row * 1024 + 512 + h * 128 + c8); vv[i] = *(const bf16x8*)(MLV + (size_t)row * 512 + h * 128 + c8); }
                if (tid < 128) { const int row = rowbase + (dir ? 127 - tid : tid); const float* g = GATES + (size_t)row * 16;
                    a_li[tid] = g[dir * 4 + h] + gb[dir * 4 + h]; a_lf[tid] = logsigmoidf(g[(2 + dir) * 4 + h] + gb[(2 + dir) * 4 + h]); }
                __syncthreads();
                { float loc = 0.f; if (tid < 128) { loc = scan16_sum(a_lf, tid); if ((tid & 15) == 15) a_gt[tid >> 4] = loc; }
                  __syncthreads();
                  if (tid < 128) a_b[tid] = group_off_sum(a_gt, tid) + loc; }
                __syncthreads();
                if (tid < 128) a_g[tid] = a_b[127] - a_b[tid] + a_li[tid];
                __syncthreads();
                if (tid < 128) { float mx = a_g[0]; for (int i = 1; i < 128; ++i) mx = fmaxf(mx, a_g[i]); a_w[tid] = expf(a_g[tid] - mx); if (tid == 0) { MLOC[sc * 34 + j] = mx; BLAST[sc * 34 + j] = a_b[127]; } }
                __syncthreads();
#pragma unroll
                for (int q = 0; q < 4; ++q) { const int idx = tid + NTHREADS * q, s = idx & 127, c8 = (idx >> 7) * 8; const float wsv = a_w[s];
#pragma unroll
                    for (int i = 0; i < 8; ++i) { kwT[(c8 + i) * TP + s] = f2bf(bf2f_s(kk[q][i]) * wsv); vT[(c8 + i) * TP + s] = (bf16_t)vv[q][i]; } }
                __syncthreads();
                { const int nb = wave & 3, mh = wave >> 2; float* dst = CST + ((size_t)(sc * 34 + j)) * 16384;
#pragma unroll
                  for (int mt = 0; mt < 2; ++mt) { f32x16 acc = {}; mma128(acc, vT, 64 * mh + 32 * mt, kwT, 32 * nb, r32, hi);
#pragma unroll
                    for (int r = 0; r < 16; ++r) dst[(64 * mh + 32 * mt + crow(r, hi)) * 128 + 32 * nb + r32] = acc[r]; } }
                if (tid < 128) { float s = 0.f;
#pragma unroll
                    for (int i = 0; i < 16; ++i) { const bf16x8 kv = *(const LAS bf16x8*)(kwT + tid * TP + 8 * i);
#pragma unroll
                        for (int e = 0; e < 8; ++e) s += bf2f_s(kv[e]); }
                    MLN[((size_t)(sc * 34 + j)) * 128 + tid] = s; }
              }
              __syncthreads(); }
        PH_END
        PH_BEGIN(6)
            { const int nlat = NB * 8 * 16, nunits = nlat + (need_ctx ? NB * 8 : 0);
              for (int rp_ = 0; rp_ <= DUP_ATT; ++rp_)
              for (int u = bid; u < nunits; u += G) {
                const bf16_t* qp; bf16_t* op; int seq, bh;
                if (u < nlat) { const int xcd = u & 7, idx = ((u & 255) >> 3) + 32 * (u >> 8), qb = idx & 15; bh = xcd * 4 + (idx >> 4); const int h = bh & 7, b = bh >> 3;     qp = QB + ((size_t)(bh * SEQ + qb * 256)) * 192; op = AO + ((size_t)(b * SEQ + qb * 256)) * 1024 + h * 128; seq = NKEY; }
                else { const int v = u - nlat, h = v & 7, b = v >> 3; bh = b * 8 + h; qp = QCB + ((size_t)(bh * CTXL)) * 192; op = AO + ((size_t)(ML + b * CTXL)) * 1024 + h * 128; seq = CTXL; }
                att::attn_body(qp, KB + (size_t)bh * NKEY * 192, VB + (size_t)bh * NKEY * 128, op, 1024, seq, (char*)lds_raw, tid);
              } }
            for (long e = gtid; e < 131072 + 1024; e += GT) {
                int sc; float* base; int stride; bool lead = false;
                if (e < 131072) { sc = (int)(e >> 12); base = CST + (size_t)sc * 34 * 16384 + (e & 4095) * 4; stride = 16384; lead = (e & 4095) == 0; }
                else { const int e2 = (int)(e - 131072); sc = e2 >> 5; base = MLN + (size_t)sc * 34 * 128 + (e2 & 31) * 4; stride = 128; }
                float m = 0.f; f32x4 st = {0.f, 0.f, 0.f, 0.f};
#pragma unroll 1
                for (int jb = 0; jb < 34; jb += 17) { f32x4 tmp[17];
#pragma unroll
                    for (int k = 0; k < 17; ++k) tmp[k] = *(const f32x4*)(base + (size_t)(jb + k) * stride);
#pragma unroll
                    for (int k = 0; k < 17; ++k) { const int j = jb + k; const float ml = MLOC[sc * 34 + j], bl = BLAST[sc * 34 + j]; *(f32x4*)(base + (size_t)j * stride) = st;
                        const float mnew = fmaxf(bl + m, ml), a = expf(bl + m - mnew), wg = expf(ml - mnew); st = st * a + tmp[k] * wg; if (lead) MIN_[sc * 34 + j] = m; m = mnew; } }
            }
        PH_END
        PH_BEGIN(7)
            { LAS bf16_t* qs = (LAS bf16_t*)lds; LAS bf16_t* ks = (LAS bf16_t*)(lds + TILE_B); LAS bf16_t* vT = (LAS bf16_t*)(lds + 2 * TILE_B); LAS bf16_t* CT = (LAS bf16_t*)(lds + 3 * TILE_B);
              LAS float* ar = (LAS float*)(lds + 4 * TILE_B);
              LAS float* a_li = ar, *a_lf = ar + 128, *a_b = ar + 256, *a_u = ar + 384, *a_M = ar + 512, *a_iw = ar + 640, *a_rs = ar + 768, *a_dn = ar + 896, *a_n = ar + 1024, *a_gt = ar + 1152;
              const float* gb = INP(I_MGB) + l * 16;
              for (int rep_ = 0; rep_ <= DUP_ML; ++rep_)
              for (int u = bid; u < 1088; u += G) { const int j = u % 34, h = (u / 34) & 3, b = (u / 136) & 3, dir = u / 544, sc = (dir * 4 + b) * 4 + h; const int rowbase = ml_rowbase(dir, b, j);
                if (j < 2 && !need_ctx) continue;
                __syncthreads();
                bf16x8 rq[4], rk[4], rv[4]; f32x4 rc[8];
#pragma unroll
                for (int i = 0; i < 4; ++i) { const int idx = tid + NTHREADS * i; { const int s = idx >> 4, c8 = (idx & 15) * 8; const int row = rowbase + (dir ? 127 - s : s);
                        rq[i] = *(const bf16x8*)(MLQK2 + (size_t)row * 1024 + h * 128 + c8); rk[i] = *(const bf16x8*)(MLQK2 + (size_t)row * 1024 + 512 + h * 128 + c8); }
                    { const int s = idx & 127, c8 = (idx >> 7) * 8; const int row = rowbase + (dir ? 127 - s : s); rv[i] = *(const bf16x8*)(MLV + (size_t)row * 512 + h * 128 + c8); } }
                { const float* src = CST + ((size_t)(sc * 34 + j)) * 16384;
#pragma unroll
                  for (int i = 0; i < 8; ++i) rc[i] = *(const f32x4*)(src + (tid + NTHREADS * i) * 4); }
                const float m_in = MIN_[sc * 34 + j];
                if (tid < 128) { const int row = rowbase + (dir ? 127 - tid : tid); const float* g = GATES + (size_t)row * 16;
                    a_li[tid] = g[dir * 4 + h] + gb[dir * 4 + h]; a_lf[tid] = logsigmoidf(g[(2 + dir) * 4 + h] + gb[(2 + dir) * 4 + h]);
                    a_n[tid] = MLN[((size_t)(sc * 34 + j)) * 128 + tid]; }
                __syncthreads();
                { float loc = 0.f; if (tid < 128) { loc = scan16_sum(a_lf, tid); if ((tid & 15) == 15) a_gt[tid >> 4] = loc; }
                  __syncthreads();
                  if (tid < 128) { const float sb = group_off_sum(a_gt, tid) + loc; a_b[tid] = sb; a_u[tid] = a_li[tid] - sb; } }
                __syncthreads();
                { float loc = 0.f; if (tid < 128) { loc = scan16_max(a_u, tid); if ((tid & 15) == 15) a_gt[8 + (tid >> 4)] = loc; }
                  __syncthreads();
                  if (tid < 128) { const float mx = fmaxf(m_in, fmaxf(group_off_max(a_gt + 8, tid), loc)); a_M[tid] = mx; a_iw[tid] = expf(m_in - mx); } }
#pragma unroll
                for (int i = 0; i < 4; ++i) { const int idx = tid + NTHREADS * i; { const int s = idx >> 4, c8 = (idx & 15) * 8; *(LAS bf16x8*)(qs + s * TP + c8) = rq[i]; *(LAS bf16x8*)(ks + s * TP + c8) = rk[i]; }
                    { const int s = idx & 127, c8 = (idx >> 7) * 8;
#pragma unroll
                      for (int e = 0; e < 8; ++e) vT[(c8 + e) * TP + s] = (bf16_t)rv[i][e]; } }
#pragma unroll
                for (int i = 0; i < 8; ++i) { const int idx = tid + NTHREADS * i, e = idx >> 5, d = (idx & 31) * 4; u32x2 w; w.x = cvtpk(rc[i].x, rc[i].y); w.y = cvtpk(rc[i].z, rc[i].w); *(LAS u32x2*)(CT + e * TP + d) = w; }
                __syncthreads();
                const int tb = wave & 3, eh = wave >> 2;
                float rsum = 0.f; f32x16 o[2];
#pragma unroll
                for (int et = 0; et < 2; ++et) { o[et] = f32x16{}; mma128(o[et], qs, 32 * tb, CT, 64 * eh + 32 * et, r32, hi);
#pragma unroll
                    for (int r = 0; r < 16; ++r) o[et][r] *= a_iw[32 * tb + crow(r, hi)]; }
                { const float Mt = a_M[32 * tb + r32];
#pragma unroll 1
                  for (int st = 0; st <= tb; ++st) { f32x16 p = {}; mma128(p, ks, 32 * st, qs, 32 * tb, r32, hi);
#pragma unroll
                    for (int r = 0; r < 16; ++r) { const int s = 32 * st + crow(r, hi); const float v = (s <= 32 * tb + r32) ? p[r] * expf(a_u[s] - Mt) : 0.f; p[r] = v; rsum += v; }
                    bf16x8 pa0, pa1; PK4(p, 0, pa0); PK4(p, 8, pa1);
#pragma unroll
                    for (int et = 0; et < 2; ++et) { const LAS bf16_t* vp = vT + (64 * eh + 32 * et + r32) * TP + 32 * st + 8 * hi;
                        o[et] = __builtin_amdgcn_mfma_f32_32x32x16_bf16(pa0, *(const LAS bf16x8*)(vp), o[et], 0, 0, 0);
                        o[et] = __builtin_amdgcn_mfma_f32_32x32x16_bf16(pa1, *(const LAS bf16x8*)(vp + 16), o[et], 0, 0, 0); } } }
                rsum += xor32_get(rsum, hi);
                if (eh == 0 && hi == 0) a_rs[32 * tb + r32] = rsum;
                __syncthreads();
                if (tid < 128) { float qn = 0.f;
#pragma unroll
                    for (int i = 0; i < 16; ++i) { const bf16x8 qv = *(const LAS bf16x8*)(qs + tid * TP + 8 * i); const f32x4 n0 = *(const LAS f32x4*)(a_n + 8 * i), n1 = *(const LAS f32x4*)(a_n + 8 * i + 4);
                        qn += bf2f_s(qv[0]) * n0.x + bf2f_s(qv[1]) * n0.y + bf2f_s(qv[2]) * n0.z + bf2f_s(qv[3]) * n0.w + bf2f_s(qv[4]) * n1.x + bf2f_s(qv[5]) * n1.y + bf2f_s(qv[6]) * n1.z + bf2f_s(qv[7]) * n1.w; }
                    const float den = a_iw[tid] * qn + a_rs[tid]; a_dn[tid] = 1.f / fmaxf(fabsf(den), expf(-(a_b[tid] + a_M[tid]))); }
                __syncthreads();
                { float* Hd = dir ? HB : HF;
#pragma unroll
                  for (int et = 0; et < 2; ++et)
#pragma unroll
                    for (int r = 0; r < 16; ++r) { const int t = 32 * tb + crow(r, hi); const int row = rowbase + (dir ? 127 - t : t);
                        Hd[(size_t)row * 512 + h * 128 + 64 * eh + 32 * et + r32] = o[et][r] * a_dn[t]; } }
              }
              __syncthreads(); }
        PH_END
        PH_BEGIN(8)
            { LAS float* ysm = (LAS float*)lds;
              const float* mg = INP(I_MIXG) + (size_t)l * 2048;
              const int ntile = need_ctx ? MT / 32 : ML / 32;
              for (int rp_ = 0; rp_ <= DUP_COMB; ++rp_)
              for (int tile = bid; tile < ntile; tile += G) { const int r0 = tile * 32;
                __syncthreads();
                { const bool isl = r0 < ML; const int b = isl ? r0 >> 12 : (r0 - ML) >> 8, t0 = isl ? r0 & 4095 : (r0 - ML) & 255; const float* src = isl ? YT + (size_t)b * 512 * 4096 + t0 : YTC + (size_t)b * 512 * 256 + t0; const int Ls = isl ? 4096 : 256;
                  for (int idx = tid; idx < 512 * 32; idx += NTHREADS) { const int c = idx >> 5, tt = idx & 31; ysm[c * 33 + tt] = src[(size_t)c * Ls + tt]; } }
                __syncthreads();
#pragma unroll 2
                for (int q = 0; q < 4; ++q) { const int tt = wave * 4 + q, r = r0 + tt; bf16_t* orow = ABUF + (size_t)r * DM;
                    { const bf16x8 a0 = *(const bf16x8*)(AO + (size_t)r * 1024 + lane * 8), a1 = *(const bf16x8*)(AO + (size_t)r * 1024 + 512 + lane * 8); float x[16], ss = 0.f;
#pragma unroll
                      for (int i = 0; i < 8; ++i) { x[i] = bf2f_s(a0[i]); x[8 + i] = bf2f_s(a1[i]); ss += x[i] * x[i] + x[8 + i] * x[8 + i]; }
                      const float rs = rsqrtf(wave_sum(ss) * (1.f / 1024.f) + EPS);
#pragma unroll
                      for (int hh = 0; hh < 2; ++hh) { const float* gp = mg + hh * 512 + lane * 8; u32x4 o;
                        o.x = cvtpk(x[hh * 8 + 0] * rs * gp[0], x[hh * 8 + 1] * rs * gp[1]); o.y = cvtpk(x[hh * 8 + 2] * rs * gp[2], x[hh * 8 + 3] * rs * gp[3]);
                        o.z = cvtpk(x[hh * 8 + 4] * rs * gp[4], x[hh * 8 + 5] * rs * gp[5]); o.w = cvtpk(x[hh * 8 + 6] * rs * gp[6], x[hh * 8 + 7] * rs * gp[7]);
                        *(u32x4*)(orow + hh * 512 + lane * 8) = o; } }
                    { float y[8], ss = 0.f;
#pragma unroll
                      for (int i = 0; i < 8; ++i) { y[i] = ysm[(lane + 64 * i) * 33 + tt]; ss += y[i] * y[i]; }
                      const float rs = rsqrtf(wave_sum(ss) * (1.f / 512.f) + EPS);
#pragma unroll
                      for (int i = 0; i < 8; ++i) orow[1024 + lane + 64 * i] = f2bf(y[i] * rs * mg[1024 + lane + 64 * i]); }
                    {
#pragma unroll
                      for (int hh = 0; hh < 4; ++hh) { const int c = hh * 128 + 2 * lane; const f32x2 f = *(const f32x2*)(HF + (size_t)r * 512 + c), bk = *(const f32x2*)(HB + (size_t)r * 512 + c);
                        const float v0 = f.x + bk.x, v1 = f.y + bk.y; const float rs = rsqrtf(wave_sum(v0 * v0 + v1 * v1) * (1.f / 128.f) + EPS);
                        const unsigned ow = *(const unsigned*)(MLO + (size_t)r * 512 + c); const float o0 = __uint_as_float(ow << 16), o1 = __uint_as_float(ow & 0xffff0000u);
                        const float g0 = mg[1536 + c], g1 = mg[1536 + c + 1];
                        *(unsigned*)(orow + 1536 + c) = cvtpk(v0 * rs * g0 / (1.f + __expf(-o0)), v1 * rs * g1 / (1.f + __expf(-o1))); } }
                }
              }
              __syncthreads(); }
        PH_END
        constexpr int Mrows = need_ctx ? MT : ML;
        PH_BEGIN(9)
            pg8::Gemm g{ABUF, WOUT, Mrows, DM, DM}; pg8::EpiResid<l, 2> E{(l == 0 ? INP(I_X) : (const float*)OUT), OUT, ws};
            if constexpr (need_ctx) { pg8::SplitCtxOrder S; S.init(G, bid, DM); pg8::gemm_phase<pg8::EpiResid<l, 2>, pg8::SplitCtxOrder, true, true>(lds, g, S, E, tid); }
            else { pg8::StaticOrder S; S.init(Mrows, DM, G, bid, DM); pg8::gemm_phase<pg8::EpiResid<l, 2>, pg8::StaticOrder, true, true>(lds, g, S, E, tid); }
        PH_END
        PH_BEGIN(10)
            NORM_ROWS(l, INP(I_N2G) + l * DM, 3, Mrows, OUT);
        PH_END
        PH_BEGIN(11)
            pg8::Gemm g{ABUF, W1, Mrows, 2 * FFH, DM}; pg8::StaticOrder S; S.init(Mrows, 2 * FFH, G, bid, DM); pg8::EpiSwiglu E{ws};
            for (int rp_ = 0; rp_ <= DUP_W1; ++rp_) pg8::gemm_phase<pg8::EpiSwiglu, pg8::StaticOrder, true, true>(lds, g, S, E, tid);
        PH_END
        PH_BEGIN(12)
            pg8::Gemm g{HID, W2, Mrows, DM, FFH}; pg8::EpiResid<l, 5> E{(const float*)OUT, OUT, ws};
            if constexpr (need_ctx) { pg8::SplitCtxOrder S; S.init(G, bid, FFH); pg8::gemm_phase<pg8::EpiResid<l, 5>, pg8::SplitCtxOrder, true, true>(lds, g, S, E, tid); }
            else { pg8::StaticOrder S; S.init(Mrows, DM, G, bid, FFH); pg8::gemm_phase<pg8::EpiResid<l, 5>, pg8::StaticOrder, true, true>(lds, g, S, E, tid); }
        PH_END


    }
    { constexpr int l = 1; constexpr bool need_ctx = (l == 0);
        PH_BEGIN(2)
            NORM_ROWS(l, INP(I_N1G) + l * DM, 0, MT, (l == 0 ? (float*)INP(I_X) : OUT));
            if constexpr (l == 0) { const f32x4 z4 = {0.f, 0.f, 0.f, 0.f};
                f32x4* a0 = (f32x4*)HYTC; for (long i = gtid; i < (long)NB * 1536 * CTXL / 4; i += GT) a0[i] = z4;
                f32x4* a1 = (f32x4*)(KROPE + (size_t)ML * 64); for (long i = gtid; i < (long)MC * 64 / 4; i += GT) a1[i] = z4;
                f32x4* a2 = (f32x4*)(GATES + (size_t)ML * 16); for (long i = gtid; i < (long)MC * 16 / 4; i += GT) a2[i] = z4; }
            if (l == 1) { __syncthreads(); CONVERT_WEIGHTS(1); __syncthreads(); BUILD_FILTERS(1); }
        PH_END
        PH_BEGIN(3)
            pg8::Gemm g{ABUF, WIN, MT, NINP, DM}; pg8::EpiInProj E{ws};
            if constexpr (l == 0) { pg8::InProjL0Order S; S.init(G, bid, DM); pg8::gemm_phase<pg8::EpiInProj, pg8::InProjL0Order, true, true>(lds, g, S, E, tid); }
            else { pg8::InProjL1Order S; S.init(G, bid, DM); for (int rp_ = 0; rp_ <= DUP_INPROJ; ++rp_) pg8::gemm_phase<pg8::EpiInProj, pg8::InProjL1Order, true, true>(lds, g, S, E, tid); }
        PH_END
        PH_BEGIN(4)
            { pg8::Gemm g{CQ, WUQ, MT, 1536, 512, CKV, WUKV}; pg8::DualUpOrder S; S.init(G, bid); pg8::EpiUp E{ws};
              for (int rp_ = 0; rp_ <= DUP_UP; ++rp_) pg8::gemm_phase<pg8::EpiUp, pg8::DualUpOrder, true, true>(lds, g, S, E, tid); }
            { const float* cw = INP(I_MCW) + (size_t)l * 3 * 1024; const float* cb = INP(I_MCB) + (size_t)l * 1024;
              for (int rp_ = 0; rp_ <= DUP_M0; ++rp_)
              for (long e = gtid; e < (long)MT * 128; e += GT) { const int r = (int)(e >> 7), c8 = (int)(e & 127) * 8;
                int t, L; if (r < ML) { t = r & 4095; L = SEQ; } else { t = (r - ML) & 255; L = CTXL; }
                const bf16x8 z = {0, 0, 0, 0, 0, 0, 0, 0};
                const bf16x8 xm = *(const bf16x8*)(MLQK + (size_t)r * 1024 + c8), xp = t > 0 ? *(const bf16x8*)(MLQK + (size_t)(r - 1) * 1024 + c8) : z, xn = t < L - 1 ? *(const bf16x8*)(MLQK + (size_t)(r + 1) * 1024 + c8) : z;
                float y[8]; const float qs = c8 < 512 ? 0.08838834764831845f : 1.f;
#pragma unroll
                for (int i = 0; i < 8; ++i) { const int c = c8 + i; y[i] = siluf(cb[c] + cw[c] * bf2f_s(xp[i]) + cw[1024 + c] * bf2f_s(xm[i]) + cw[2048 + c] * bf2f_s(xn[i])) * qs; }
                u32x4 o; o.x = cvtpk(y[0], y[1]); o.y = cvtpk(y[2], y[3]); o.z = cvtpk(y[4], y[5]); o.w = cvtpk(y[6], y[7]); *(u32x4*)(MLQK2 + (size_t)r * 1024 + c8) = o; } }
            { LAS f32x2* X = (LAS f32x2*)lds; LAS f32x2* Gs = (LAS f32x2*)(lds + FFT_SLOTS * 8); LAS float* w3s = (LAS float*)(lds + 2 * FFT_SLOTS * 8);
              const float* hcw = INP(I_HCW) + (size_t)l * 3 * 1536; const float* hcb = INP(I_HCB) + (size_t)l * 1536;
              const float* w3 = INP(I_HW3) + (size_t)l * 64 * 2048; const float* dec = INP(I_HDEC) + (size_t)l * 2048; const float* skip = INP(I_HSKIP) + (size_t)l * 1024;
              const float* H2 = H2L + (size_t)l * SEQ * 64;
              FftTw ftw; fft_load_tw(ftw, TW, tid);
              for (int rep_ = 0; rep_ <= DUP_HY; ++rep_)
              for (int c0 = bid; c0 < 512; c0 += G) { int c = c0; asm volatile("" : "+s"(c));
                const float vw0 = hcw[c], vw1 = hcw[1536 + c], vw2 = hcw[3072 + c], vbb = hcb[c];
                for (int n = 0; n < 2; ++n) {
                    const int of = n * 1024 + c, ob = n * 1024 + 512 + c;
                    __syncthreads();
                    { const float* ff = FILT + (size_t)of * 4096; const float* fb = FILT + (size_t)ob * 4096;
#pragma unroll 2
                      for (int q = 0; q < 8; ++q) { const int t = tid + 512 * q; Gs[fphys(t)] = (f32x2){ff[t], 0.f};
                        if (t == 0) Gs[fphys(4096)] = (f32x2){0.f, 0.f}; else Gs[fphys(8192 - t)] = (f32x2){fb[t], 0.f}; } }
                    __syncthreads();
                    fft_fwd_full(Gs, ftw, tid);
                    const float sk = skip[n * 512 + c];
                    const int gch = (n + 1) * 512 + c;
                    const float gw0 = hcw[gch], gw1 = hcw[1536 + gch], gw2 = hcw[3072 + gch], gbb = hcb[gch];
#pragma unroll 1
                    for (int bp = 0; bp < 2; ++bp) {
                        const float* u0 = HYT + ((size_t)((2 * bp) * 1536 + c)) * 4096; const float* u1 = HYT + ((size_t)((2 * bp + 1) * 1536 + c)) * 4096;
                        float* y0p = YT + ((size_t)((2 * bp) * 512 + c)) * 4096; float* y1p = YT + ((size_t)((2 * bp + 1) * 512 + c)) * 4096;
                        const float* g0p = HYT + ((size_t)((2 * bp) * 1536 + gch)) * 4096; const float* g1p = HYT + ((size_t)((2 * bp + 1) * 1536 + gch)) * 4096;
                        f32x2 zq[8], gq[8];
#pragma unroll
                        for (int q = 0; q < 8; ++q) { const int t = tid + 512 * q;
                            if (n == 0) { zq[q].x = conv3(u0, t, SEQ, vw0, vw1, vw2, vbb); zq[q].y = conv3(u1, t, SEQ, vw0, vw1, vw2, vbb); } else { zq[q].x = y0p[t]; zq[q].y = y1p[t]; }
                            gq[q].x = conv3(g0p, t, SEQ, gw0, gw1, gw2, gbb); gq[q].y = conv3(g1p, t, SEQ, gw0, gw1, gw2, gbb); }
#pragma unroll
                        for (int q = 0; q < 8; ++q) { const int t = tid + 512 * q; X[fphys(t)] = zq[q]; X[fphys(4096 + t)] = (f32x2){0.f, 0.f}; }
                        __syncthreads();
                        fft_conv(X, Gs, ftw, tid);
#pragma unroll
                        for (int q = 0; q < 8; ++q) { const int t = tid + 512 * q; const f32x2 y = X[fphys(t)] * (1.f / 8192.f);
                            y0p[t] = gq[q].x * (y.x + sk * zq[q].x); y1p[t] = gq[q].y * (y.y + sk * zq[q].y); }
                        __syncthreads();
                    }
                }
              }
              if (need_ctx) {
                LAS float* hf = (LAS float*)lds;
                LAS float* zs = (LAS float*)(lds + 4096);
                LAS float* w3c = (LAS float*)(lds + 8192);
                const float* H2c = H2C + (size_t)l * CTXL * 64;
                for (int c = bid; c < 512; c += G) {
                    __syncthreads();
                    if (tid < 256) { const int f = tid >> 6, i = tid & 63; w3c[tid] = w3[i * 2048 + (f >> 1) * 1024 + (f & 1) * 512 + c]; }
                    __syncthreads();
                    for (int e = tid; e < 1024; e += NTHREADS) { const int f = e >> 8, t = e & 255; const int o = (f >> 1) * 1024 + (f & 1) * 512 + c; float a = 0.f;
                        for (int i = 0; i < 64; ++i) a += H2c[t * 64 + i] * w3c[f * 64 + i];
                        hf[e] = a * (expf(-((float)t * (1.f / 256.f)) * dec[o]) + 0.05f); }
                    const int b = tid >> 7; float zv[2], zc[2];
#pragma unroll
                    for (int q = 0; q < 2; ++q) { const int t = (tid & 127) + 128 * q; zv[q] = conv3(HYTC + ((size_t)(b * 1536 + c)) * 256, t, CTXL, hcw[c], hcw[1536 + c], hcw[3072 + c], hcb[c]); zs[b * 256 + t] = zv[q]; }
                    __syncthreads();
                    for (int n = 0; n < 2; ++n) { const LAS float* gf = hf + n * 512; const LAS float* gb = hf + n * 512 + 256; const int gch = (n + 1) * 512 + c;
#pragma unroll
                        for (int q = 0; q < 2; ++q) { const int t = (tid & 127) + 128 * q; float y = 0.f;
                            for (int s = 0; s <= t; ++s) y += zs[b * 256 + s] * gf[t - s];
                            for (int s = t + 1; s < 256; ++s) y += zs[b * 256 + s] * gb[s - t];
                            const float gate = conv3(HYTC + ((size_t)(b * 1536 + gch)) * 256, t, CTXL, hcw[gch], hcw[1536 + gch], hcw[3072 + gch], hcb[gch]);
                            zc[q] = gate * (y + skip[n * 512 + c] * zv[q]); }
                        __syncthreads();
#pragma unroll
                        for (int q = 0; q < 2; ++q) { const int t = (tid & 127) + 128 * q; zv[q] = zc[q]; if (n == 0) zs[b * 256 + t] = zc[q]; else YTC[((size_t)(b * 512 + c)) * 256 + t] = zc[q]; }
                        __syncthreads(); }
                }
              }
            }
        PH_END
        PH_BEGIN(5)
            { LAS f32x2* rtab = (LAS f32x2*)lds;
              __syncthreads();
              for (int e = tid; e < 1024; e += NTHREADS) { const float ang = (float)(e >> 4) * powf(10000.f, -(float)(e & 15) * (1.f / 16.f)); rtab[e] = (f32x2){cosf(ang), sinf(ang)}; }
              __syncthreads();
              const int l16 = lane & 15, ts = lane >> 4; const bool xhi = l16 >= 8, rowax = (l16 & 7) < 4; const int f0 = 4 * (l16 & 3);
              const float* qg = INP(I_QN) + l * 192; const float* kg = INP(I_KN) + l * 192;
              float qgn[8], kgn[8], qgr[4], kgr[4];
#pragma unroll
              for (int i = 0; i < 8; ++i) { qgn[i] = qg[8 * l16 + i]; kgn[i] = kg[8 * l16 + i]; }
#pragma unroll
              for (int i = 0; i < 4; ++i) { qgr[i] = qg[128 + 4 * l16 + i]; kgr[i] = kg[128 + 4 * l16 + i]; }
#define RED16(v) do { v += swz_xor<1>(v); v += swz_xor<2>(v); v += swz_xor<4>(v); v += swz_xor<8>(v); } while (0)
              for (int rp_ = 0; rp_ <= DUP_POST; ++rp_)
              for (int r0 = gw * 4; r0 < MT; r0 += NGW * 4) { const int r = r0 + ts;
                int b, t, key; const bool isl = r < ML; if (isl) { b = r >> 12; t = r & 4095; key = CTXL + t; } else { b = (r - ML) >> 8; t = (r - ML) & 255; key = t; }
                const bf16_t* qrow = QRAW + (size_t)r * 1536; const bf16_t* kvrow = KVRAW + (size_t)r * 2048;
                bf16x8 cqv[4], ckv4[4], qn_[8], kn_[8], vn_[8]; u32x2 qr_[8];
#pragma unroll
                for (int i = 0; i < 4; ++i) { cqv[i] = *(const bf16x8*)(CQ + (size_t)r * 512 + 32 * l16 + 8 * i); ckv4[i] = *(const bf16x8*)(CKV + (size_t)r * 512 + 32 * l16 + 8 * i); }
                const f32x4 krv = *(const f32x4*)(KROPE + (size_t)r * 64 + 4 * l16);
#pragma unroll
                for (int h = 0; h < 8; ++h) { qn_[h] = *(const bf16x8*)(qrow + h * 192 + 8 * l16); qr_[h] = *(const u32x2*)(qrow + h * 192 + 128 + 4 * l16);
                    kn_[h] = *(const bf16x8*)(kvrow + h * 256 + 8 * l16); vn_[h] = *(const bf16x8*)(kvrow + h * 256 + 128 + 8 * l16); }
                float ssq = 0.f, sskv = 0.f;
#pragma unroll
                for (int i = 0; i < 4; ++i)
#pragma unroll
                    for (int e = 0; e < 8; ++e) { const float x = bf2f_s(cqv[i][e]), y = bf2f_s(ckv4[i][e]); ssq += x * x; sskv += y * y; }
                RED16(ssq); RED16(sskv);
                const float rsq = rsqrtf(ssq * (1.f / 512.f) + EPS), rskv = rsqrtf(sskv * (1.f / 512.f) + EPS);
                float cs[4], sn[4];
#pragma unroll
                for (int i = 0; i < 4; ++i) { cs[i] = 1.f; sn[i] = 0.f; }
                if (isl) { const int pos = rowax ? (t >> 6) : (t & 63);
#pragma unroll
                    for (int i = 0; i < 4; ++i) { const f32x2 e = rtab[pos * 16 + f0 + i]; cs[i] = e.x; sn[i] = e.y; } }
                float krss = krv.x * krv.x + krv.y * krv.y + krv.z * krv.z + krv.w * krv.w;
#pragma unroll
                for (int h = 0; h < 8; ++h) {
                    float xn[8], xr[4]; float ss = 0.f;
#pragma unroll
                    for (int i = 0; i < 8; ++i) { xn[i] = bf2f_s(qn_[h][i]) * rsq; ss += xn[i] * xn[i]; }
                    xr[0] = __uint_as_float(qr_[h].x << 16) * rsq; xr[1] = __uint_as_float(qr_[h].x & 0xffff0000u) * rsq; xr[2] = __uint_as_float(qr_[h].y << 16) * rsq; xr[3] = __uint_as_float(qr_[h].y & 0xffff0000u) * rsq;
#pragma unroll
                    for (int i = 0; i < 4; ++i) ss += xr[i] * xr[i];
                    RED16(ss);
                    float rn = rsqrtf(ss * (1.f / 192.f) + EPS);
                    if (isl || need_ctx) {
                        bf16_t* qo = isl ? QB + ((size_t)((b * 8 + h) * SEQ + t)) * 192 : QCB + ((size_t)((b * 8 + h) * CTXL + t)) * 192;
                        u32x4 w; w.x = cvtpk(xn[0] * rn * qgn[0], xn[1] * rn * qgn[1]); w.y = cvtpk(xn[2] * rn * qgn[2], xn[3] * rn * qgn[3]); w.z = cvtpk(xn[4] * rn * qgn[4], xn[5] * rn * qgn[5]); w.w = cvtpk(xn[6] * rn * qgn[6], xn[7] * rn * qgn[7]);
                        *(u32x4*)(qo + 8 * l16) = w;
                        float yo[4];
#pragma unroll
                        for (int i = 0; i < 4; ++i) { const float v = xr[i] * rn * qgr[i]; const float pr = swz_xor<8>(v); yo[i] = xhi ? v * cs[i] + pr * sn[i] : v * cs[i] - pr * sn[i]; }
                        u32x2 w2; w2.x = cvtpk(yo[0], yo[1]); w2.y = cvtpk(yo[2], yo[3]); *(u32x2*)(qo + 128 + 4 * l16) = w2; }
                    float yn[8]; ss = krss;
#pragma unroll
                    for (int i = 0; i < 8; ++i) { yn[i] = bf2f_s(kn_[h][i]) * rskv; ss += yn[i] * yn[i]; }
                    RED16(ss);
                    rn = rsqrtf(ss * (1.f / 192.f) + EPS);
                    { bf16_t* ko = KB + ((size_t)((b * 8 + h) * NKEY + key)) * 192;
                      u32x4 w; w.x = cvtpk(yn[0] * rn * kgn[0], yn[1] * rn * kgn[1]); w.y = cvtpk(yn[2] * rn * kgn[2], yn[3] * rn * kgn[3]); w.z = cvtpk(yn[4] * rn * kgn[4], yn[5] * rn * kgn[5]); w.w = cvtpk(yn[6] * rn * kgn[6], yn[7] * rn * kgn[7]);
                      *(u32x4*)(ko + 8 * l16) = w;
                      const float kr4[4] = {krv.x, krv.y, krv.z, krv.w}; float yo[4];
#pragma unroll
                      for (int i = 0; i < 4; ++i) { const float v = kr4[i] * rn * kgr[i]; const float pr = swz_xor<8>(v); yo[i] = xhi ? v * cs[i] + pr * sn[i] : v * cs[i] - pr * sn[i]; }
                      u32x2 w2; w2.x = cvtpk(yo[0], yo[1]); w2.y = cvtpk(yo[2], yo[3]); *(u32x2*)(ko + 128 + 4 * l16) = w2;
                      bf16_t* vo = VB + ((size_t)((b * 8 + h) * NKEY + key)) * 128;
                      u32x4 wv; wv.x = cvtpk(bf2f_s(vn_[h][0]) * rskv, bf2f_s(vn_[h][1]) * rskv); wv.y = cvtpk(bf2f_s(vn_[h][2]) * rskv, bf2f_s(vn_[h][3]) * rskv);
                      wv.z = cvtpk(bf2f_s(vn_[h][4]) * rskv, bf2f_s(vn_[h][5]) * rskv); wv.w = cvtpk(bf2f_s(vn_[h][6]) * rskv, bf2f_s(vn_[h][7]) * rskv);
                      *(u32x4*)(vo + 8 * l16) = wv; }
                }
              }
#undef RED16
              __syncthreads(); }
            { LAS bf16_t* kwT = (LAS bf16_t*)lds; LAS bf16_t* vT = (LAS bf16_t*)(lds + TILE_B); LAS float* ar = (LAS float*)(lds + 4 * TILE_B);
              LAS float* a_li = ar, *a_lf = ar + 128, *a_b = ar + 256, *a_g = ar + 384, *a_w = ar + 512, *a_gt = ar + 640;
              const float* gb = INP(I_MGB) + l * 16;
              for (int rep_ = 0; rep_ <= DUP_ML; ++rep_)
              for (int u = bid; u < 1088; u += G) { const int j = u % 34, h = (u / 34) & 3, b = (u / 136) & 3, dir = u / 544, sc = (dir * 4 + b) * 4 + h; const int rowbase = ml_rowbase(dir, b, j);
                __syncthreads();
                bf16x8 kk[4], vv[4];
#pragma unroll
                for (int i = 0; i < 4; ++i) { const int idx = tid + NTHREADS * i, s = idx & 127, c8 = (idx >> 7) * 8; const int row = rowbase + (dir ? 127 - s : s);
                    kk[i] = *(const bf16x8*)(MLQK2 + (size_t)row * 1024 + 512 + h * 128 + c8); vv[i] = *(const bf16x8*)(MLV + (size_t)row * 512 + h * 128 + c8); }
                if (tid < 128) { const int row = rowbase + (dir ? 127 - tid : tid); const float* g = GATES + (size_t)row * 16;
                    a_li[tid] = g[dir * 4 + h] + gb[dir * 4 + h]; a_lf[tid] = logsigmoidf(g[(2 + dir) * 4 + h] + gb[(2 + dir) * 4 + h]); }
                __syncthreads();
                { float loc = 0.f; if (tid < 128) { loc = scan16_sum(a_lf, tid); if ((tid & 15) == 15) a_gt[tid >> 4] = loc; }
                  __syncthreads();
                  if (tid < 128) a_b[tid] = group_off_sum(a_gt, tid) + loc; }
                __syncthreads();
                if (tid < 128) a_g[tid] = a_b[127] - a_b[tid] + a_li[tid];
                __syncthreads();
                if (tid < 128) { float mx = a_g[0]; for (int i = 1; i < 128; ++i) mx = fmaxf(mx, a_g[i]); a_w[tid] = expf(a_g[tid] - mx); if (tid == 0) { MLOC[sc * 34 + j] = mx; BLAST[sc * 34 + j] = a_b[127]; } }
                __syncthreads();
#pragma unroll
                for (int q = 0; q < 4; ++q) { const int idx = tid + NTHREADS * q, s = idx & 127, c8 = (idx >> 7) * 8; const float wsv = a_w[s];
#pragma unroll
                    for (int i = 0; i < 8; ++i) { kwT[(c8 + i) * TP + s] = f2bf(bf2f_s(kk[q][i]) * wsv); vT[(c8 + i) * TP + s] = (bf16_t)vv[q][i]; } }
                __syncthreads();
                { const int nb = wave & 3, mh = wave >> 2; float* dst = CST + ((size_t)(sc * 34 + j)) * 16384;
#pragma unroll
                  for (int mt = 0; mt < 2; ++mt) { f32x16 acc = {}; mma128(acc, vT, 64 * mh + 32 * mt, kwT, 32 * nb, r32, hi);
#pragma unroll
                    for (int r = 0; r < 16; ++r) dst[(64 * mh + 32 * mt + crow(r, hi)) * 128 + 32 * nb + r32] = acc[r]; } }
                if (tid < 128) { float s = 0.f;
#pragma unroll
                    for (int i = 0; i < 16; ++i) { const bf16x8 kv = *(const LAS bf16x8*)(kwT + tid * TP + 8 * i);
#pragma unroll
                        for (int e = 0; e < 8; ++e) s += bf2f_s(kv[e]); }
                    MLN[((size_t)(sc * 34 + j)) * 128 + tid] = s; }
              }
              __syncthreads(); }
        PH_END
        PH_BEGIN(6)
            { const int nlat = NB * 8 * 16, nunits = nlat + (need_ctx ? NB * 8 : 0);
              for (int rp_ = 0; rp_ <= DUP_ATT; ++rp_)
              for (int u = bid; u < nunits; u += G) {
                const bf16_t* qp; bf16_t* op; int seq, bh;
                if (u < nlat) { const int xcd = u & 7, idx = ((u & 255) >> 3) + 32 * (u >> 8), qb = idx & 15; bh = xcd * 4 + (idx >> 4); const int h = bh & 7, b = bh >> 3;     qp = QB + ((size_t)(bh * SEQ + qb * 256)) * 192; op = AO + ((size_t)(b * SEQ + qb * 256)) * 1024 + h * 128; seq = NKEY; }
                else { const int v = u - nlat, h = v & 7, b = v >> 3; bh = b * 8 + h; qp = QCB + ((size_t)(bh * CTXL)) * 192; op = AO + ((size_t)(ML + b * CTXL)) * 1024 + h * 128; seq = CTXL; }
                att::attn_body(qp, KB + (size_t)bh * NKEY * 192, VB + (size_t)bh * NKEY * 128, op, 1024, seq, (char*)lds_raw, tid);
              } }
            for (long e = gtid; e < 131072 + 1024; e += GT) {
                int sc; float* base; int stride; bool lead = false;
                if (e < 131072) { sc = (int)(e >> 12); base = CST + (size_t)sc * 34 * 16384 + (e & 4095) * 4; stride = 16384; lead = (e & 4095) == 0; }
                else { const int e2 = (int)(e - 131072); sc = e2 >> 5; base = MLN + (size_t)sc * 34 * 128 + (e2 & 31) * 4; stride = 128; }
                float m = 0.f; f32x4 st = {0.f, 0.f, 0.f, 0.f};
#pragma unroll 1
                for (int jb = 0; jb < 34; jb += 17) { f32x4 tmp[17];
#pragma unroll
                    for (int k = 0; k < 17; ++k) tmp[k] = *(const f32x4*)(base + (size_t)(jb + k) * stride);
#pragma unroll
                    for (int k = 0; k < 17; ++k) { const int j = jb + k; const float ml = MLOC[sc * 34 + j], bl = BLAST[sc * 34 + j]; *(f32x4*)(base + (size_t)j * stride) = st;
                        const float mnew = fmaxf(bl + m, ml), a = expf(bl + m - mnew), wg = expf(ml - mnew); st = st * a + tmp[k] * wg; if (lead) MIN_[sc * 34 + j] = m; m = mnew; } }
            }
        PH_END
        PH_BEGIN(7)
            { LAS bf16_t* qs = (LAS bf16_t*)lds; LAS bf16_t* ks = (LAS bf16_t*)(lds + TILE_B); LAS bf16_t* vT = (LAS bf16_t*)(lds + 2 * TILE_B); LAS bf16_t* CT = (LAS bf16_t*)(lds + 3 * TILE_B);
              LAS float* ar = (LAS float*)(lds + 4 * TILE_B);
              LAS float* a_li = ar, *a_lf = ar + 128, *a_b = ar + 256, *a_u = ar + 384, *a_M = ar + 512, *a_iw = ar + 640, *a_rs = ar + 768, *a_dn = ar + 896, *a_n = ar + 1024, *a_gt = ar + 1152;
              const float* gb = INP(I_MGB) + l * 16;
              for (int rep_ = 0; rep_ <= DUP_ML; ++rep_)
              for (int u = bid; u < 1088; u += G) { const int j = u % 34, h = (u / 34) & 3, b = (u / 136) & 3, dir = u / 544, sc = (dir * 4 + b) * 4 + h; const int rowbase = ml_rowbase(dir, b, j);
                if (j < 2 && !need_ctx) continue;
                __syncthreads();
                bf16x8 rq[4], rk[4], rv[4]; f32x4 rc[8];
#pragma unroll
                for (int i = 0; i < 4; ++i) { const int idx = tid + NTHREADS * i; { const int s = idx >> 4, c8 = (idx & 15) * 8; const int row = rowbase + (dir ? 127 - s : s);
                        rq[i] = *(const bf16x8*)(MLQK2 + (size_t)row * 1024 + h * 128 + c8); rk[i] = *(const bf16x8*)(MLQK2 + (size_t)row * 1024 + 512 + h * 128 + c8); }
                    { const int s = idx & 127, c8 = (idx >> 7) * 8; const int row = rowbase + (dir ? 127 - s : s); rv[i] = *(const bf16x8*)(MLV + (size_t)row * 512 + h * 128 + c8); } }
                { const float* src = CST + ((size_t)(sc * 34 + j)) * 16384;
#pragma unroll
                  for (int i = 0; i < 8; ++i) rc[i] = *(const f32x4*)(src + (tid + NTHREADS * i) * 4); }
                const float m_in = MIN_[sc * 34 + j];
                if (tid < 128) { const int row = rowbase + (dir ? 127 - tid : tid); const float* g = GATES + (size_t)row * 16;
                    a_li[tid] = g[dir * 4 + h] + gb[dir * 4 + h]; a_lf[tid] = logsigmoidf(g[(2 + dir) * 4 + h] + gb[(2 + dir) * 4 + h]);
                    a_n[tid] = MLN[((size_t)(sc * 34 + j)) * 128 + tid]; }
                __syncthreads();
                { float loc = 0.f; if (tid < 128) { loc = scan16_sum(a_lf, tid); if ((tid & 15) == 15) a_gt[tid >> 4] = loc; }
                  __syncthreads();
                  if (tid < 128) { const float sb = group_off_sum(a_gt, tid) + loc; a_b[tid] = sb; a_u[tid] = a_li[tid] - sb; } }
                __syncthreads();
                { float loc = 0.f; if (tid < 128) { loc = scan16_max(a_u, tid); if ((tid & 15) == 15) a_gt[8 + (tid >> 4)] = loc; }
                  __syncthreads();
                  if (tid < 128) { const float mx = fmaxf(m_in, fmaxf(group_off_max(a_gt + 8, tid), loc)); a_M[tid] = mx; a_iw[tid] = expf(m_in - mx); } }
#pragma unroll
                for (int i = 0; i < 4; ++i) { const int idx = tid + NTHREADS * i; { const int s = idx >> 4, c8 = (idx & 15) * 8; *(LAS bf16x8*)(qs + s * TP + c8) = rq[i]; *(LAS bf16x8*)(ks + s * TP + c8) = rk[i]; }
                    { const int s = idx & 127, c8 = (idx >> 7) * 8;
#pragma unroll
                      for (int e = 0; e < 8; ++e) vT[(c8 + e) * TP + s] = (bf16_t)rv[i][e]; } }
#pragma unroll
                for (int i = 0; i < 8; ++i) { const int idx = tid + NTHREADS * i, e = idx >> 5, d = (idx & 31) * 4; u32x2 w; w.x = cvtpk(rc[i].x, rc[i].y); w.y = cvtpk(rc[i].z, rc[i].w); *(LAS u32x2*)(CT + e * TP + d) = w; }
                __syncthreads();
                const int tb = wave & 3, eh = wave >> 2;
                float rsum = 0.f; f32x16 o[2];
#pragma unroll
                for (int et = 0; et < 2; ++et) { o[et] = f32x16{}; mma128(o[et], qs, 32 * tb, CT, 64 * eh + 32 * et, r32, hi);
#pragma unroll
                    for (int r = 0; r < 16; ++r) o[et][r] *= a_iw[32 * tb + crow(r, hi)]; }
                { const float Mt = a_M[32 * tb + r32];
#pragma unroll 1
                  for (int st = 0; st <= tb; ++st) { f32x16 p = {}; mma128(p, ks, 32 * st, qs, 32 * tb, r32, hi);
#pragma unroll
                    for (int r = 0; r < 16; ++r) { const int s = 32 * st + crow(r, hi); const float v = (s <= 32 * tb + r32) ? p[r] * expf(a_u[s] - Mt) : 0.f; p[r] = v; rsum += v; }
                    bf16x8 pa0, pa1; PK4(p, 0, pa0); PK4(p, 8, pa1);
#pragma unroll
                    for (int et = 0; et < 2; ++et) { const LAS bf16_t* vp = vT + (64 * eh + 32 * et + r32) * TP + 32 * st + 8 * hi;
                        o[et] = __builtin_amdgcn_mfma_f32_32x32x16_bf16(pa0, *(const LAS bf16x8*)(vp), o[et], 0, 0, 0);
                        o[et] = __builtin_amdgcn_mfma_f32_32x32x16_bf16(pa1, *(const LAS bf16x8*)(vp + 16), o[et], 0, 0, 0); } } }
                rsum += xor32_get(rsum, hi);
                if (eh == 0 && hi == 0) a_rs[32 * tb + r32] = rsum;
                __syncthreads();
                if (tid < 128) { float qn = 0.f;
#pragma unroll
                    for (int i = 0; i < 16; ++i) { const bf16x8 qv = *(const LAS bf16x8*)(qs + tid * TP + 8 * i); const f32x4 n0 = *(const LAS f32x4*)(a_n + 8 * i), n1 = *(const LAS f32x4*)(a_n + 8 * i + 4);
                        qn += bf2f_s(qv[0]) * n0.x + bf2f_s(qv[1]) * n0.y + bf2f_s(qv[2]) * n0.z + bf2f_s(qv[3]) * n0.w + bf2f_s(qv[4]) * n1.x + bf2f_s(qv[5]) * n1.y + bf2f_s(qv[6]) * n1.z + bf2f_s(qv[7]) * n1.w; }
                    const float den = a_iw[tid] * qn + a_rs[tid]; a_dn[tid] = 1.f / fmaxf(fabsf(den), expf(-(a_b[tid] + a_M[tid]))); }
                __syncthreads();
                { float* Hd = dir ? HB : HF;
#pragma unroll
                  for (int et = 0; et < 2; ++et)
#pragma unroll
                    for (int r = 0; r < 16; ++r) { const int t = 32 * tb + crow(r, hi); const int row = rowbase + (dir ? 127 - t : t);
                        Hd[(size_t)row * 512 + h * 128 + 64 * eh + 32 * et + r32] = o[et][r] * a_dn[t]; } }
              }
              __syncthreads(); }
        PH_END
        PH_BEGIN(8)
            { LAS float* ysm = (LAS float*)lds;
              const float* mg = INP(I_MIXG) + (size_t)l * 2048;
              const int ntile = need_ctx ? MT / 32 : ML / 32;
              for (int rp_ = 0; rp_ <= DUP_COMB; ++rp_)
              for (int tile = bid; tile < ntile; tile += G) { const int r0 = tile * 32;
                __syncthreads();
                { const bool isl = r0 < ML; const int b = isl ? r0 >> 12 : (r0 - ML) >> 8, t0 = isl ? r0 & 4095 : (r0 - ML) & 255; const float* src = isl ? YT + (size_t)b * 512 * 4096 + t0 : YTC + (size_t)b * 512 * 256 + t0; const int Ls = isl ? 4096 : 256;
                  for (int idx = tid; idx < 512 * 32; idx += NTHREADS) { const int c = idx >> 5, tt = idx & 31; ysm[c * 33 + tt] = src[(size_t)c * Ls + tt]; } }
                __syncthreads();
#pragma unroll 2
                for (int q = 0; q < 4; ++q) { const int tt = wave * 4 + q, r = r0 + tt; bf16_t* orow = ABUF + (size_t)r * DM;
                    { const bf16x8 a0 = *(const bf16x8*)(AO + (size_t)r * 1024 + lane * 8), a1 = *(const bf16x8*)(AO + (size_t)r * 1024 + 512 + lane * 8); float x[16], ss = 0.f;
#pragma unroll
                      for (int i = 0; i < 8; ++i) { x[i] = bf2f_s(a0[i]); x[8 + i] = bf2f_s(a1[i]); ss += x[i] * x[i] + x[8 + i] * x[8 + i]; }
                      const float rs = rsqrtf(wave_sum(ss) * (1.f / 1024.f) + EPS);
#pragma unroll
                      for (int hh = 0; hh < 2; ++hh) { const float* gp = mg + hh * 512 + lane * 8; u32x4 o;
                        o.x = cvtpk(x[hh * 8 + 0] * rs * gp[0], x[hh * 8 + 1] * rs * gp[1]); o.y = cvtpk(x[hh * 8 + 2] * rs * gp[2], x[hh * 8 + 3] * rs * gp[3]);
                        o.z = cvtpk(x[hh * 8 + 4] * rs * gp[4], x[hh * 8 + 5] * rs * gp[5]); o.w = cvtpk(x[hh * 8 + 6] * rs * gp[6], x[hh * 8 + 7] * rs * gp[7]);
                        *(u32x4*)(orow + hh * 512 + lane * 8) = o; } }
                    { float y[8], ss = 0.f;
#pragma unroll
                      for (int i = 0; i < 8; ++i) { y[i] = ysm[(lane + 64 * i) * 33 + tt]; ss += y[i] * y[i]; }
                      const float rs = rsqrtf(wave_sum(ss) * (1.f / 512.f) + EPS);
#pragma unroll
                      for (int i = 0; i < 8; ++i) orow[1024 + lane + 64 * i] = f2bf(y[i] * rs * mg[1024 + lane + 64 * i]); }
                    {
#pragma unroll
                      for (int hh = 0; hh < 4; ++hh) { const int c = hh * 128 + 2 * lane; const f32x2 f = *(const f32x2*)(HF + (size_t)r * 512 + c), bk = *(const f32x2*)(HB + (size_t)r * 512 + c);
                        const float v0 = f.x + bk.x, v1 = f.y + bk.y; const float rs = rsqrtf(wave_sum(v0 * v0 + v1 * v1) * (1.f / 128.f) + EPS);
                        const unsigned ow = *(const unsigned*)(MLO + (size_t)r * 512 + c); const float o0 = __uint_as_float(ow << 16), o1 = __uint_as_float(ow & 0xffff0000u);
                        const float g0 = mg[1536 + c], g1 = mg[1536 + c + 1];
                        *(unsigned*)(orow + 1536 + c) = cvtpk(v0 * rs * g0 / (1.f + __expf(-o0)), v1 * rs * g1 / (1.f + __expf(-o1))); } }
                }
              }
              __syncthreads(); }
        PH_END
        constexpr int Mrows = need_ctx ? MT : ML;
        PH_BEGIN(9)
            pg8::Gemm g{ABUF, WOUT, Mrows, DM, DM}; pg8::EpiResid<l, 2> E{(l == 0 ? INP(I_X) : (const float*)OUT), OUT, ws};
            if constexpr (need_ctx) { pg8::SplitCtxOrder S; S.init(G, bid, DM); pg8::gemm_phase<pg8::EpiResid<l, 2>, pg8::SplitCtxOrder, true, true>(lds, g, S, E, tid); }
            else { pg8::StaticOrder S; S.init(Mrows, DM, G, bid, DM); pg8::gemm_phase<pg8::EpiResid<l, 2>, pg8::StaticOrder, true, true>(lds, g, S, E, tid); }
        PH_END
        PH_BEGIN(10)
            NORM_ROWS(l, INP(I_N2G) + l * DM, 3, Mrows, OUT);
        PH_END
        PH_BEGIN(11)
            pg8::Gemm g{ABUF, W1, Mrows, 2 * FFH, DM}; pg8::StaticOrder S; S.init(Mrows, 2 * FFH, G, bid, DM); pg8::EpiSwiglu E{ws};
            for (int rp_ = 0; rp_ <= DUP_W1; ++rp_) pg8::gemm_phase<pg8::EpiSwiglu, pg8::StaticOrder, true, true>(lds, g, S, E, tid);
        PH_END
        PH_BEGIN(12)
            pg8::Gemm g{HID, W2, Mrows, DM, FFH}; pg8::EpiResid<l, 5> E{(const float*)OUT, OUT, ws};
            if constexpr (need_ctx) { pg8::SplitCtxOrder S; S.init(G, bid, FFH); pg8::gemm_phase<pg8::EpiResid<l, 5>, pg8::SplitCtxOrder, true, true>(lds, g, S, E, tid); }
            else { pg8::StaticOrder S; S.init(Mrows, DM, G, bid, FFH); pg8::gemm_phase<pg8::EpiResid<l, 5>, pg8::StaticOrder, true, true>(lds, g, S, E, tid); }
        PH_END


    }
#undef PH_BEGIN
#undef PH_END
}

extern "C" void kernel_launch(void* const* d_in, const int* in_sizes, int n_in, void* d_out, int out_size, void* d_ws, size_t ws_size, hipStream_t stream) {
    static int grid = 0;
    if (grid == 0) {
        if (n_in != 31 || out_size != ML * DM || ws_size < WS_END) { fprintf(stderr, "kernel_launch: unexpected shapes n_in %d out %d ws %zu (need %zu)\n", n_in, out_size, ws_size, (size_t)WS_END); grid = -1; return; }
        int dev = 0, cus = 0, per_cu = 0;
        hipGetDevice(&dev); hipDeviceGetAttribute(&cus, hipDeviceAttributeMultiprocessorCount, dev);
        if (hipFuncSetAttribute((const void*)fwd_kernel, hipFuncAttributeMaxDynamicSharedMemorySize, LDS_BYTES) != hipSuccess) { fprintf(stderr, "kernel_launch: hipFuncSetAttribute failed\n"); grid = -1; return; }
        if (hipOccupancyMaxActiveBlocksPerMultiprocessor(&per_cu, (const void*)fwd_kernel, NTHREADS, LDS_BYTES) != hipSuccess || per_cu < 1) { fprintf(stderr, "kernel_launch: occupancy query gave %d\n", per_cu); per_cu = 1; }
        (void)hipGetLastError();
        grid = cus * 1;
        fprintf(stderr, "kernel_launch: grid %d (cus %d, per_cu %d)\n", grid, cus, per_cu);
    }
    if (grid < 0) return;
    if (hipMemsetAsync(d_ws, 0, 65536, stream) != hipSuccess) { fprintf(stderr, "kernel_launch: memset failed\n"); return; }
    Args a{};
    for (int i = 0; i < 31; ++i) a.in[i] = (const float*)d_in[i];
    a.out = (float*)d_out; a.ws = (unsigned char*)d_ws; a.ph_lo = 0; a.ph_hi = 0;
    void* kargs[] = {&a};
    hipError_t e = hipLaunchCooperativeKernel((const void*)fwd_kernel, dim3(grid), dim3(NTHREADS), kargs, LDS_BYTES, stream);
    if (e != hipSuccess) fprintf(stderr, "kernel_launch: cooperative launch failed: %s (grid %d)\n", hipGetErrorString(e), grid);
}
```

```cpp
#include <hip/hip_runtime.h>
#include <hip/hip_cooperative_groups.h>
#include <cstdio>
#include <cstdint>
#include <cmath>
namespace cg = cooperative_groups;
#ifndef DUP_HY
#define DUP_HY 0
#endif
#ifndef DUP_ML
#define DUP_ML 0
#endif
#ifndef DUP_SYNC
#define DUP_SYNC 0
#endif
#ifndef DUP_INPROJ
#define DUP_INPROJ 0
#endif
#ifndef DUP_UP
#define DUP_UP 0
#endif
#ifndef DUP_W1
#define DUP_W1 0
#endif
#ifndef DUP_ATT
#define DUP_ATT 0
#endif
#ifndef DUP_POST
#define DUP_POST 0
#endif
#ifndef DUP_COMB
#define DUP_COMB 0
#endif
#ifndef DUP_NORM
#define DUP_NORM 0
#endif
#ifndef DUP_M0
#define DUP_M0 0
#endif
#ifndef DUP_G0
#define DUP_G0 0
#endif
#ifndef DUP_G1
#define DUP_G1 0
#endif
namespace pg8 {
#define PG8_LAS __attribute__((address_space(3)))
typedef unsigned short bf16_t;
typedef short bf16x8 __attribute__((ext_vector_type(8)));
typedef float f32x4 __attribute__((ext_vector_type(4)));
typedef unsigned u32x4 __attribute__((ext_vector_type(4)));
constexpr int BM = 256, BK = 64, HALF = 128, HTB = HALF * BK * 2  , STAGE_BYTES = 8 * HTB, NXCD = 8, WGM = 8;

__host__ __device__ __forceinline__ int lds_byte(int r, int c) { const int st = (r >> 4) * 2 + (c >> 5), rr = r & 15, cc = c & 31, ob = rr * 64 + cc * 2; return st * 1024 + (ob ^ (((ob >> 9) & 1) << 5)); }
__host__ __device__ __forceinline__ void stage_rc(int b, int& R, int& C) { const int st = b / 1024, sb = b % 1024, swz = sb ^ (((sb >> 9) & 1) << 5); R = (st >> 1) * 16 + swz / 64; C = (st & 1) * 32 + (swz % 64) / 2; }
__host__ __device__ __forceinline__ int perm32(int rho) { const int n = rho >> 4, i = rho & 15; return 8 * (i >> 2) + 4 * n + (i & 3); }

struct Unit { int pm, pn, kofs, nt, atomic, which; };
struct Gemm { const bf16_t* A; const bf16_t* Bt; int M, N, K; const bf16_t* A2; const bf16_t* Bt2; };

struct StaticOrder {
    int nM, nN, nwg, G, c, ntk;
    __host__ __device__ void init(int M, int N, int G_, int c_, int K_) { nM = M / BM; nN = N / BM; nwg = nM * nN; G = G_; c = c_; ntk = K_ / BK; }
    __host__ __device__ bool next(int i, Unit& u) const {
        const long L = (long)i * G + c; if (L >= nwg) return false;
        int wgid = (int)L; { const int q = nwg / NXCD, r = nwg % NXCD, xcd = wgid % NXCD, off = wgid / NXCD; wgid = (xcd < r ? xcd * (q + 1) : r * (q + 1) + (xcd - r) * q) + off; }
        const int nig = WGM * nN, gid = wgid / nig, fm = gid * WGM, gsz = (nM - fm) < WGM ? (nM - fm) : WGM;
        u.pm = fm + ((wgid % nig) % gsz); u.pn = (wgid % nig) / gsz; u.kofs = 0; u.nt = ntk; u.atomic = 0; u.which = 0; return true;
    }
    __device__ __forceinline__ void a_ready(const Unit&) const {}
    __device__ __forceinline__ void done(const Unit&) const {}
};
struct SplitCtxOrder {
    StaticOrder so; int K;
    __host__ __device__ void init(int G_, int c_, int K_) { so.init(16384, 2048, G_, c_, K_); K = K_; }
    __host__ __device__ bool next(int i, Unit& u) const {
        const long L = (long)i * so.G + so.c;
        if (L < so.nwg) return so.next(i, u);
        const int q = (int)(L - so.nwg); if (q >= 128) return false;
        const int cu = q >> 2, kq = q & 3; u.pm = 64 + (cu >> 3); u.pn = cu & 7; u.kofs = kq * (K / 4); u.nt = K / 4 / BK; u.atomic = 1; u.which = 0; return true;
    }
    __device__ __forceinline__ void a_ready(const Unit&) const {}
    __device__ __forceinline__ void done(const Unit&) const {}
};
struct InProjL1Order {
    StaticOrder so;
    __host__ __device__ void init(int G_, int c_, int K_) { so.init(16384, 4864, G_, c_, K_); }
    __host__ __device__ bool next(int i, Unit& u) const {
        const long L = (long)i * so.G + so.c;
        if (L < so.nwg) return so.next(i, u);
        const int q = (int)(L - so.nwg); if (q >= 36) return false;
        const int r = q / 9, k = q % 9; u.pm = 64 + r; u.pn = k < 2 ? 2 + k : (k < 8 ? 10 + (k - 2) : 18); u.kofs = 0; u.nt = so.ntk; u.atomic = 0; u.which = 0; return true;
    }
    __device__ __forceinline__ void a_ready(const Unit&) const {}
    __device__ __forceinline__ void done(const Unit&) const {}
};

struct DualUpOrder {
    int G, c;
    __host__ __device__ void init(int G_, int c_) { G = G_; c = c_; }
    __host__ __device__ bool next(int i, Unit& u) const {
        const long L = (long)i * G + c; if (L >= 952) return false;
        u.kofs = 0; u.nt = 8; u.atomic = 0;
        if (L < 408) { u.which = 0; u.pm = (int)L / 6; u.pn = (int)L % 6; } else { const int q = (int)L - 408; u.which = 1; u.pm = q >> 3; u.pn = q & 7; }
        return true;
    }
    __device__ __forceinline__ void a_ready(const Unit&) const {}
    __device__ __forceinline__ void done(const Unit&) const {}
};

struct InProjL0Order {
    StaticOrder so;
    __host__ __device__ void init(int G_, int c_, int K_) { so.init(16384, 4864, G_, c_, K_); }
    __host__ __device__ bool next(int i, Unit& u) const {
        const long L = (long)i * so.G + so.c;
        if (L >= so.nwg + 48 + 112) return false;
        Unit v; const bool ok = so.next(L < so.nwg ? i : 0, v);
        (void)ok;
        const int q = (int)(L - so.nwg), q2 = q - 48;
        const int r1 = q / 12, k1 = q % 12, t2 = q2 >> 2, r2 = t2 / 7, k2 = t2 % 7;
        const bool lat = L < so.nwg, full = q < 48;
        u.pm = lat ? v.pm : (full ? 64 + r1 : 64 + r2);
        u.pn = lat ? v.pn : (full ? (k1 < 4 ? k1 : 10 + (k1 - 4)) : (k2 < 6 ? 4 + k2 : 18));
        u.kofs = (lat || full) ? 0 : (q2 & 3) * 512;
        u.nt = (lat || full) ? so.ntk : 8;
        u.atomic = (lat || full) ? 0 : 1;
        u.which = 0;
        return true;
    }
    __device__ __forceinline__ void a_ready(const Unit&) const {}
    __device__ __forceinline__ void done(const Unit&) const {}
};
template <class Epi, class Sched, bool ALIGN_EPI = false, bool SP2 = false>
__device__ __forceinline__ void gemm_phase(PG8_LAS unsigned char* lds, const Gemm g, const Sched& S, const Epi& E, const int tid_in) {
    const int tid = tid_in, wid = __builtin_amdgcn_readfirstlane(tid >> 6), lane = tid & 63, wr = wid >> 2, wc = wid & 3, fr = lane & 15, fq = lane >> 4;
    const int K = g.K;
    unsigned voffA[2], voffB[2];
#pragma unroll
    for (int i = 0; i < 2; ++i) { int R, C; stage_rc(tid * 16 + i * 8192, R, C); const int Rb = Epi::PERM ? ((R & ~31) + perm32(R & 31)) : R;
        voffA[i] = (unsigned)(R * K + C) * 2u; voffB[i] = (unsigned)(Rb * K + C) * 2u; }
    const size_t kstep = (size_t)(BK * 2);
    const size_t hstep = (size_t)HALF * K * 2;
    const size_t tstep = 2 * hstep;
    const unsigned ldsw = (unsigned)wid * 1024u;
    const int aoff = lds_byte(wr * 64 + fr, fq * 8), boff = lds_byte(wc * 32 + fr, fq * 8);
#define PG8_SA(b, h) (((b) * 2 + (h)) * HTB)
#define PG8_SB(b, h) ((4 + (b) * 2 + (h)) * HTB)
#define PG8_STAGE(bufoff, gbase, voff) do { _Pragma("unroll") for (int _i = 0; _i < 2; ++_i) \
        __builtin_amdgcn_global_load_lds((const unsigned*)((const char*)(gbase) + (voff)[_i]), (PG8_LAS unsigned*)(lds + (bufoff) + ldsw + _i * 8192), 16, 0, 0); } while (0)
#define PG8_LDA(dst, b, h) do { _Pragma("unroll") for (int m = 0; m < 4; ++m) _Pragma("unroll") for (int k = 0; k < 2; ++k) dst[m][k] = *(const PG8_LAS bf16x8*)(lds + PG8_SA(b, h) + aoff + m * 2048 + k * 1024); } while (0)
#define PG8_LDB(dst, b, h) do { _Pragma("unroll") for (int n = 0; n < 2; ++n) _Pragma("unroll") for (int k = 0; k < 2; ++k) dst[n][k] = *(const PG8_LAS bf16x8*)(lds + PG8_SB(b, h) + boff + n * 2048 + k * 1024); } while (0)
#define PG8_MMA(ai, bj, At, Bt) do { __builtin_amdgcn_s_setprio(1); _Pragma("unroll") for (int m = 0; m < 4; ++m) _Pragma("unroll") for (int n = 0; n < 2; ++n) _Pragma("unroll") for (int k = 0; k < 2; ++k) \
        acc[ai][bj][m][n] = __builtin_amdgcn_mfma_f32_16x16x32_bf16(Bt[n][k], At[m][k], acc[ai][bj][m][n], 0, 0, 0); __builtin_amdgcn_s_setprio(0); } while (0)
#define PG8_WAIT_V(n) asm volatile("s_waitcnt vmcnt(" #n ")" ::: "memory")
#define PG8_WAIT_L(n) asm volatile("s_waitcnt lgkmcnt(" #n ")" ::: "memory")
#define PG8_BAR __builtin_amdgcn_s_barrier()
#define PG8_SCHED __builtin_amdgcn_sched_barrier(0)
    Unit cur, nxt; int ui = 0;
    if (!S.next(0, cur)) return;
    int nt = cur.nt;
    f32x4 acc[2][2][4][2];
#pragma unroll
    for (int a = 0; a < 2; ++a)
#pragma unroll
        for (int b = 0; b < 2; ++b)
#pragma unroll
            for (int m = 0; m < 4; ++m)
#pragma unroll
                for (int n = 0; n < 2; ++n) acc[a][b][m][n] = (f32x4){0.f, 0.f, 0.f, 0.f};
    bf16x8 At[4][2], B0[2][2], B1[2][2];
    const char* cA = (const char*)(cur.which ? g.A2 : g.A) + (size_t)cur.pm * tstep + (size_t)cur.kofs * 2; const char* cB = (const char*)(cur.which ? g.Bt2 : g.Bt) + (size_t)cur.pn * tstep + (size_t)cur.kofs * 2;
    S.a_ready(cur);
    if constexpr (SP2) {
        PG8_STAGE(PG8_SB(0, 0), cB, voffB); PG8_STAGE(PG8_SB(0, 1), cB + hstep, voffB); PG8_STAGE(PG8_SA(0, 0), cA, voffA); PG8_STAGE(PG8_SA(0, 1), cA + hstep, voffA);
        if (wr == 1) PG8_BAR;
        PG8_WAIT_V(2); PG8_BAR;
        PG8_STAGE(PG8_SB(1, 0), cB + kstep, voffB); PG8_STAGE(PG8_SA(1, 0), cA + kstep, voffA); PG8_STAGE(PG8_SB(1, 1), cB + hstep + kstep, voffB);
        PG8_WAIT_V(6); PG8_BAR;
    } else {
        PG8_STAGE(PG8_SB(0, 0), cB, voffB); PG8_STAGE(PG8_SA(0, 0), cA, voffA); PG8_STAGE(PG8_SB(0, 1), cB + hstep, voffB); PG8_STAGE(PG8_SA(0, 1), cA + hstep, voffA);
        if (wr == 1) PG8_BAR;
        PG8_WAIT_V(4); PG8_BAR;
        PG8_STAGE(PG8_SB(1, 0), cB + kstep, voffB); PG8_STAGE(PG8_SA(1, 0), cA + kstep, voffA); PG8_STAGE(PG8_SB(1, 1), cB + hstep + kstep, voffB);
        PG8_WAIT_V(6); PG8_BAR;
    }
    for (;;) {
        const bool has_next = S.next(ui + 1, nxt);
        const char* nA = has_next ? (const char*)(nxt.which ? g.A2 : g.A) + (size_t)nxt.pm * tstep + (size_t)nxt.kofs * 2 : cA; const char* nB = has_next ? (const char*)(nxt.which ? g.Bt2 : g.Bt) + (size_t)nxt.pn * tstep + (size_t)nxt.kofs * 2 : cB;
        for (int t = 0; t < nt; t += 2) {
            const bool last = (t == nt - 2);
            const char* a1 = cA + (size_t)(t + 1) * kstep;
            const char* a2 = last ? nA : cA + (size_t)(t + 2) * kstep; const char* b2 = last ? nB : cB + (size_t)(t + 2) * kstep;
            const char* a3 = a2 + kstep; const char* b3 = b2 + kstep;
            if (last && has_next) S.a_ready(nxt);
            if constexpr (SP2) {
            PG8_LDB(B0, 0, 0); PG8_LDB(B1, 0, 1); PG8_SCHED; PG8_LDA(At, 0, 0); PG8_STAGE(PG8_SA(1, 1), a1 + hstep, voffA);
            PG8_WAIT_V(8); PG8_WAIT_L(0); PG8_BAR; PG8_MMA(0, 0, At, B0); PG8_MMA(0, 1, At, B1); PG8_BAR; PG8_SCHED;
            PG8_LDA(At, 0, 1); PG8_STAGE(PG8_SB(0, 0), b2, voffB); PG8_STAGE(PG8_SB(0, 1), b2 + hstep, voffB); PG8_STAGE(PG8_SA(0, 0), a2, voffA);
            PG8_WAIT_V(8); PG8_WAIT_L(0); PG8_BAR; PG8_MMA(1, 0, At, B0); PG8_MMA(1, 1, At, B1); PG8_BAR; PG8_SCHED;
            PG8_LDB(B0, 1, 0); PG8_LDB(B1, 1, 1); PG8_SCHED; PG8_LDA(At, 1, 0); PG8_STAGE(PG8_SA(0, 1), a2 + hstep, voffA);
            PG8_WAIT_V(8); PG8_WAIT_L(0); PG8_BAR; PG8_MMA(0, 0, At, B0); PG8_MMA(0, 1, At, B1); PG8_BAR; PG8_SCHED;
            PG8_LDA(At, 1, 1); PG8_STAGE(PG8_SB(1, 0), b3, voffB); PG8_STAGE(PG8_SB(1, 1), b3 + hstep, voffB); PG8_STAGE(PG8_SA(1, 0), a3, voffA);
            PG8_WAIT_V(8); PG8_WAIT_L(0); PG8_BAR; PG8_MMA(1, 0, At, B0); PG8_MMA(1, 1, At, B1); PG8_BAR; PG8_SCHED;
            } else {
            PG8_LDB(B0, 0, 0); PG8_SCHED; PG8_LDA(At, 0, 0); PG8_STAGE(PG8_SA(1, 1), a1 + hstep, voffA);
            PG8_WAIT_L(8); PG8_BAR; PG8_WAIT_L(0); PG8_MMA(0, 0, At, B0); PG8_BAR; PG8_SCHED;
            PG8_LDB(B1, 0, 1); PG8_STAGE(PG8_SB(0, 0), b2, voffB);
            PG8_BAR; PG8_WAIT_L(0); PG8_MMA(0, 1, At, B1); PG8_BAR;
            PG8_LDA(At, 0, 1); PG8_STAGE(PG8_SA(0, 0), a2, voffA);
            PG8_BAR; PG8_WAIT_L(0); PG8_MMA(1, 0, At, B0); PG8_BAR; PG8_SCHED;
            PG8_STAGE(PG8_SB(0, 1), b2 + hstep, voffB);
            PG8_WAIT_V(6); PG8_BAR; PG8_MMA(1, 1, At, B1); PG8_BAR;
            PG8_LDB(B0, 1, 0); PG8_SCHED; PG8_LDA(At, 1, 0); PG8_STAGE(PG8_SA(0, 1), a2 + hstep, voffA);
            PG8_WAIT_L(8); PG8_BAR; PG8_WAIT_L(0); PG8_MMA(0, 0, At, B0); PG8_BAR; PG8_SCHED;
            PG8_LDB(B1, 1, 1); PG8_STAGE(PG8_SB(1, 0), b3, voffB);
            PG8_BAR; PG8_WAIT_L(0); PG8_MMA(0, 1, At, B1); PG8_BAR;
            PG8_LDA(At, 1, 1); PG8_STAGE(PG8_SA(1, 0), a3, voffA);
            PG8_BAR; PG8_WAIT_L(0); PG8_MMA(1, 0, At, B0); PG8_BAR; PG8_SCHED;
            PG8_STAGE(PG8_SB(1, 1), b3 + hstep, voffB);
            PG8_WAIT_V(6); PG8_BAR; PG8_MMA(1, 1, At, B1); PG8_BAR;
            }
        }
        if constexpr (ALIGN_EPI) { if (wr == 0) PG8_BAR; }
        if constexpr (!Epi::AFTER_DRAIN) { E(acc, cur, wr, wc, fr, fq); S.done(cur); }
        if (!has_next) break;
#pragma unroll
        for (int a = 0; a < 2; ++a)
#pragma unroll
            for (int b = 0; b < 2; ++b)
#pragma unroll
                for (int m = 0; m < 4; ++m)
#pragma unroll
                    for (int n = 0; n < 2; ++n) acc[a][b][m][n] = (f32x4){0.f, 0.f, 0.f, 0.f};
        cur = nxt; cA = nA; cB = nB; ++ui; nt = cur.nt;
        if constexpr (ALIGN_EPI) { if (wr == 1) PG8_BAR; }
    }
    PG8_WAIT_V(0);
    if constexpr (!ALIGN_EPI) { if (wr == 0) PG8_BAR; }
    PG8_BAR;
    if constexpr (Epi::AFTER_DRAIN) { E.fused(acc, cur, wr, wc, fr, fq, lds, wid, lane); S.done(cur); }
#undef PG8_SA
#undef PG8_SB
#undef PG8_STAGE
#undef PG8_LDA
#undef PG8_LDB
#undef PG8_MMA
#undef PG8_WAIT_V
#undef PG8_WAIT_L
#undef PG8_BAR
#undef PG8_SCHED
}
}
#define LAS __attribute__((address_space(3)))
typedef unsigned short bf16_t;
typedef short bf16x8 __attribute__((ext_vector_type(8)));
typedef short s16x4 __attribute__((ext_vector_type(4)));
typedef float f32x4 __attribute__((ext_vector_type(4)));
typedef float f32x2 __attribute__((ext_vector_type(2)));
typedef float f32x16 __attribute__((ext_vector_type(16)));
typedef unsigned u32x4 __attribute__((ext_vector_type(4)));
typedef unsigned u32x2 __attribute__((ext_vector_type(2)));
constexpr int DM = 2048, NB = 4, SEQ = 4096, CTXL = 256;
constexpr int ML = NB * SEQ, MC = NB * CTXL, MT = ML + MC;
constexpr int NIN = 4688, NINP = 4864, FFH = 5632, NKEY = CTXL + SEQ;
constexpr float EPS = 1e-6f;
constexpr int NTHREADS = 512, NWAVES = 8;
constexpr int LDS_BYTES = 147456;
constexpr size_t MiB = 1u << 20;
constexpr size_t WS_MOD = 1 * MiB, WS_TW = 2 * MiB, WS_H2L = 3 * MiB, WS_H2C = 5 * MiB, WS_MODP = 6 * MiB, WS_KROPE = 21 * MiB, WS_GATES = 26 * MiB, WS_MLS = 28 * MiB, WS_MLN = 29 * MiB,
    WS_XC = 30 * MiB, WS_WIN = 38 * MiB, WS_WUQ = 57 * MiB, WS_WUKV = 59 * MiB, WS_WOUT = 61 * MiB, WS_W1 = 69 * MiB, WS_W2 = 113 * MiB, WS_A = 135 * MiB, WS_CQ = 203 * MiB, WS_CKV = 220 * MiB,
    WS_HYT = 237 * MiB, WS_HYTC = 333 * MiB, WS_MLQK = 339 * MiB, WS_MLQK2 = 373 * MiB, WS_MLV = 407 * MiB, WS_MLO = 424 * MiB, WS_QRAW = 441 * MiB, WS_KVRAW = 492 * MiB,
    WS_Q = 560 * MiB, WS_QC = 608 * MiB, WS_K = 611 * MiB, WS_V = 662 * MiB, WS_AO = 696 * MiB, WS_YT = 730 * MiB, WS_YTC = 762 * MiB, WS_END = 764 * MiB;
constexpr size_t WS_CST = WS_A;
constexpr size_t WS_HF = WS_QRAW, WS_HB = WS_QRAW + 34 * MiB;
constexpr size_t WS_HID = WS_CQ;

__device__ __forceinline__ unsigned cvtpk(float lo, float hi) { unsigned r; asm volatile("v_cvt_pk_bf16_f32 %0, %1, %2" : "=v"(r) : "v"(lo), "v"(hi)); return r; }
__device__ __forceinline__ float bf2f(bf16_t v) { return __uint_as_float((unsigned)v << 16); }
__device__ __forceinline__ float bf2f_s(short v) { return __uint_as_float(((unsigned)(unsigned short)v) << 16); }
__device__ __forceinline__ bf16_t f2bf(float f) { return (bf16_t)(cvtpk(f, 0.f) & 0xffffu); }
template <int K> __device__ __forceinline__ float swz_xor(float v) { return __int_as_float(__builtin_amdgcn_ds_swizzle(__float_as_int(v), (K << 10) | 0x1f)); }
__device__ __forceinline__ float wave_sum(float v) {
    v += swz_xor<1>(v); v += swz_xor<2>(v); v += swz_xor<4>(v); v += swz_xor<8>(v); v += swz_xor<16>(v);
    auto rr = __builtin_amdgcn_permlane32_swap(__float_as_uint(v), __float_as_uint(v), false, false);
    return __uint_as_float(rr[0]) + __uint_as_float(rr[1]);
}
__device__ __forceinline__ float xor32_get(float v, int hi) {
    auto rr = __builtin_amdgcn_permlane32_swap(__float_as_uint(v), __float_as_uint(v), false, false);
    return hi ? __uint_as_float(rr[0]) : __uint_as_float(rr[1]);
}
__device__ __forceinline__ float siluf(float x) { return x / (1.f + __expf(-x)); }
__device__ __forceinline__ float logsigmoidf(float x) { return fminf(x, 0.f) - log1pf(expf(-fabsf(x))); }
__device__ __forceinline__ int crow(int r, int hi) { return (r & 3) + 8 * (r >> 2) + 4 * hi; }
#define LDS_WAIT() asm volatile("s_waitcnt lgkmcnt(0)" ::: "memory")
#define SBAR() __builtin_amdgcn_sched_barrier(0)

struct MapIdent { __device__ __forceinline__ int operator()(int n) const { return n; } };
struct MapWin { __device__ __forceinline__ int operator()(int n) const {
    if (n < 1024) return n; if (n < 2560) return 1088 + (n - 1024); if (n < 3584) return 2624 + (n - 2560); if (n < 4096) return 3648 + (n - 3584);
    if (n < 4608) return 4160 + (n - 4096); if (n < 4672) return 1024 + (n - 4608); if (n < 4688) return n; return -1; } };
struct MapW1 { __device__ __forceinline__ int operator()(int n) const { const int t = n >> 8, w = n & 255; return w < 128 ? t * 128 + w : FFH + t * 128 + (w - 128); } };
template <class Map>
__device__ __forceinline__ void wt_item(const float* __restrict__ W, int Nsrc, int K, bf16_t* __restrict__ WT, const float* __restrict__ kscale, LAS float* scr, int kb, int nb, int lane, Map map) {
    const int k0 = 64 * kb, n0 = 32 * nb, oc = map(n0 + (lane & 31));
    float wv[32];
#pragma unroll
    for (int i = 0; i < 32; ++i) { const int kk = 2 * i + (lane >> 5); wv[i] = (oc >= 0) ? W[(size_t)(k0 + kk) * Nsrc + oc] : 0.f; }
#pragma unroll
    for (int i = 0; i < 32; ++i) { const int kk = 2 * i + (lane >> 5); float v = wv[i]; if (kscale) v *= kscale[k0 + kk]; scr[kk * 33 + (lane & 31)] = v; }
    LDS_WAIT();
    const int c = lane & 7;
#pragma unroll
    for (int j = 0; j < 4; ++j) { const int n = (lane >> 3) + 8 * j; const LAS float* s = scr + (8 * c) * 33 + n;
        u32x4 o; o.x = cvtpk(s[0 * 33], s[1 * 33]); o.y = cvtpk(s[2 * 33], s[3 * 33]); o.z = cvtpk(s[4 * 33], s[5 * 33]); o.w = cvtpk(s[6 * 33], s[7 * 33]);
        *(u32x4*)(WT + (size_t)(n0 + n) * K + k0 + 8 * c) = o; }
    LDS_WAIT();
}

namespace att {
constexpr int DQK = 192, DV = 128, QBLK = 32, KVBLK = 64;
constexpr float SCALE = 0.07216878364870322f;
constexpr float THR = 8.f;
constexpr int KPITCH = 400;
constexpr int SHM_V = KVBLK * DV * 2, SHM_K = KVBLK * KPITCH;
constexpr int QRP = 144;
constexpr int SHM_QR = 2 * SHM_V + 2 * SHM_K + NWAVES * 64 * 4;
constexpr int SHM_ATTN = SHM_QR + NWAVES * 32 * QRP;
__device__ __forceinline__ void partialSM(f32x16& p0, f32x16& p1, float& m_reg, float& mn, float& alpha) {
    constexpr float C = SCALE * 1.4426950408889634f;
    float pmax = p0[0];
#pragma unroll
    for (int r = 1; r < 16; ++r) pmax = fmaxf(pmax, p0[r]);
#pragma unroll
    for (int r = 0; r < 16; ++r) pmax = fmaxf(pmax, p1[r]);
    { auto rr = __builtin_amdgcn_permlane32_swap(__float_as_uint(pmax), __float_as_uint(pmax), false, false);
      pmax = fmaxf(__uint_as_float(rr[0]), __uint_as_float(rr[1])); }
    if (__builtin_expect(__all(pmax - m_reg <= THR / SCALE), 1)) { mn = m_reg; alpha = 1.f; }
    else { mn = fmaxf(m_reg, pmax); alpha = __builtin_amdgcn_exp2f((m_reg - mn) * C); m_reg = mn; }
    const float mnC = -mn * C;
#pragma unroll
    for (int r = 0; r < 16; ++r) p0[r] = fmaf(p0[r], C, mnC);
#pragma unroll
    for (int r = 0; r < 16; ++r) p1[r] = fmaf(p1[r], C, mnC);
#pragma unroll
    for (int r = 0; r < 16; ++r) p0[r] = __builtin_amdgcn_exp2f(p0[r]);
}
#define PK4(P, BASE, OUT) do { unsigned a0 = cvtpk(P[BASE + 0], P[BASE + 1]), a1 = cvtpk(P[BASE + 2], P[BASE + 3]);   \
    unsigned b0 = cvtpk(P[BASE + 4], P[BASE + 5]), b1 = cvtpk(P[BASE + 6], P[BASE + 7]);                              \
    auto r0 = __builtin_amdgcn_permlane32_swap(a0, b0, false, false); auto r1 = __builtin_amdgcn_permlane32_swap(a1, b1, false, false); \
    u32x4 w = {r0[0], r1[0], r0[1], r1[1]}; OUT = __builtin_bit_cast(bf16x8, w); } while (0)
__device__ __forceinline__ void finishSM(f32x16& p0, f32x16& p1, float alpha, float& l_reg, bf16x8& pa0, bf16x8& pa1, bf16x8& pa2, bf16x8& pa3) {
#pragma unroll
    for (int r = 0; r < 16; ++r) p1[r] = __builtin_amdgcn_exp2f(p1[r]);
    float ps = 0;
#pragma unroll
    for (int r = 0; r < 16; ++r) ps += p0[r];
#pragma unroll
    for (int r = 0; r < 16; ++r) ps += p1[r];
    { auto rr = __builtin_amdgcn_permlane32_swap(__float_as_uint(ps), __float_as_uint(ps), false, false);
      ps = __uint_as_float(rr[0]) + __uint_as_float(rr[1]); }
    l_reg = l_reg * alpha + ps;
    PK4(p0, 0, pa0); PK4(p0, 8, pa1); PK4(p1, 0, pa2); PK4(p1, 8, pa3);
}
__device__ __forceinline__ void qkt(f32x16& p0, f32x16& p1, const char* Ks, const bf16x8* qr, const char* qrl, int r32, int hi) {
    p0 = f32x16{}; p1 = f32x16{};
#pragma unroll
    for (int d0 = 0; d0 < 12; ++d0) { const int cb = (d0 * 16 + hi * 8) * 2;
        bf16x8 b0 = *reinterpret_cast<const bf16x8*>(Ks + r32 * KPITCH + cb);
        bf16x8 b1 = *reinterpret_cast<const bf16x8*>(Ks + (32 + r32) * KPITCH + cb);
        bf16x8 q; if (d0 < 8) q = qr[d0 < 8 ? d0 : 0]; else q = *reinterpret_cast<const bf16x8*>(qrl + (d0 - 8) * 32);
        p0 = __builtin_amdgcn_mfma_f32_32x32x16_bf16(b0, q, p0, 0, 0, 0);
        p1 = __builtin_amdgcn_mfma_f32_32x32x16_bf16(b1, q, p1, 0, 0, 0);
        if ((d0 & 3) == 3) asm volatile("" ::: "memory"); }
}
__device__ __forceinline__ int v_st(int k, int c) { const int kk = (k & ~0xC) | ((k & 4) << 1) | ((k & 8) >> 1); return ((kk >> 3) * 4 + (c >> 5)) * 512 + ((kk & 7) * 32 + (c & 31)) * 2; }
__device__ __forceinline__ int v_rd_base(int lane) { return ((lane & 3) << 3) | (((lane >> 2) & 3) << 6) | (((lane >> 4) & 1) << 5) | (((lane >> 5) & 1) << 8); }
constexpr int v_rd_off(int d0, int ks, int half) { return d0 * 512 + ks * 4096 + half * 2048; }
template <int OFF> __device__ __forceinline__ s16x4 tr_read(int vb) {
    s16x4 r; asm volatile("ds_read_b64_tr_b16 %0, %1 offset:%2" : "=&v"(r) : "v"(vb), "i"(OFF) : "memory"); return r;
}
template <int D0> __device__ __forceinline__ void pv_one(f32x16& od, int vb, bf16x8 pa0, bf16x8 pa1, bf16x8 pa2, bf16x8 pa3) {
    const s16x4 l0 = tr_read<v_rd_off(D0, 0, 0)>(vb), h0 = tr_read<v_rd_off(D0, 0, 1)>(vb), l1 = tr_read<v_rd_off(D0, 1, 0)>(vb), h1 = tr_read<v_rd_off(D0, 1, 1)>(vb);
    const s16x4 l2 = tr_read<v_rd_off(D0, 2, 0)>(vb), h2 = tr_read<v_rd_off(D0, 2, 1)>(vb), l3 = tr_read<v_rd_off(D0, 3, 0)>(vb), h3 = tr_read<v_rd_off(D0, 3, 1)>(vb);
    asm volatile("s_waitcnt lgkmcnt(0)" ::: "memory"); SBAR();
#define PKV(L, H) (bf16x8){L[0], L[1], L[2], L[3], H[0], H[1], H[2], H[3]}
    od = __builtin_amdgcn_mfma_f32_32x32x16_bf16(pa0, PKV(l0, h0), od, 0, 0, 0);
    od = __builtin_amdgcn_mfma_f32_32x32x16_bf16(pa1, PKV(l1, h1), od, 0, 0, 0);
    od = __builtin_amdgcn_mfma_f32_32x32x16_bf16(pa2, PKV(l2, h2), od, 0, 0, 0);
    od = __builtin_amdgcn_mfma_f32_32x32x16_bf16(pa3, PKV(l3, h3), od, 0, 0, 0);
#undef PKV
}
__device__ __forceinline__ void pv_d0(f32x16* o, int vb, bf16x8 pa0, bf16x8 pa1, bf16x8 pa2, bf16x8 pa3) {
    pv_one<0>(o[0], vb, pa0, pa1, pa2, pa3); pv_one<1>(o[1], vb, pa0, pa1, pa2, pa3); pv_one<2>(o[2], vb, pa0, pa1, pa2, pa3); pv_one<3>(o[3], vb, pa0, pa1, pa2, pa3);
}
__device__ __forceinline__ void attn_body(const bf16_t* __restrict__ Qb, const bf16_t* __restrict__ Kh, const bf16_t* __restrict__ Vh, bf16_t* __restrict__ Ob, int ldo, int seq, char* lds, const int tid) {
    const int wid = tid >> 6, lane = tid & 63, r32 = lane & 31, hi = lane >> 5;
    char* V_lds = lds; char* K_lds = lds + 2 * SHM_V;
    float* ws = (float*)(lds + 2 * SHM_V + 2 * SHM_K) + wid * 64; float* li_l = ws; float* al_l = ws + 32;
    float m_reg = -1e30f, l_reg = 0; f32x16 o[4] = {}; bf16x8 qr[8];
    char* qrl = lds + SHM_QR + wid * (32 * QRP) + r32 * QRP + hi * 16;
    const bf16_t* Qw = Qb + (long)(wid * QBLK + r32) * DQK + hi * 8;
#pragma unroll
    for (int d0 = 0; d0 < 8; ++d0) qr[d0] = *reinterpret_cast<const bf16x8*>(Qw + d0 * 16);
#pragma unroll
    for (int d0 = 8; d0 < 12; ++d0) *reinterpret_cast<bf16x8*>(qrl + (d0 - 8) * 32) = *reinterpret_cast<const bf16x8*>(Qw + d0 * 16);
    const int sr = tid >> 4, sc = (tid & 15) * 8, vst0 = v_st(sr, sc), vst1 = v_st(32 + sr, sc);
    const int ku0 = tid, ku1 = tid + 512, ku2 = tid + 1024;
    const int kst0 = (ku0 / 24) * KPITCH + (ku0 % 24) * 16, kst1 = (ku1 / 24) * KPITCH + (ku1 % 24) * 16, kst2 = (ku2 / 24) * KPITCH + (ku2 % 24) * 16;
    const int vb0 = (int)(uintptr_t)V_lds + v_rd_base(lane);
    struct { bf16x8 vs0, vs1, ks0, ks1, ks2; } sr_[1];
    const unsigned voff0 = (unsigned)(sr * DV + sc), voff1 = (unsigned)((32 + sr) * DV + sc), koff0 = (unsigned)(ku0 * 8), koff1 = (unsigned)(ku1 * 8), koff2 = (unsigned)(ku2 * 8);
#define SLOAD(i, k0) do { const bf16_t* vt_ = Vh + (long)(k0) * DV; const bf16_t* kt_ = Kh + (long)(k0) * DQK; \
    sr_[i].vs0 = *reinterpret_cast<const bf16x8*>(vt_ + voff0); sr_[i].vs1 = *reinterpret_cast<const bf16x8*>(vt_ + voff1); \
    sr_[i].ks0 = *reinterpret_cast<const bf16x8*>(kt_ + koff0); sr_[i].ks1 = *reinterpret_cast<const bf16x8*>(kt_ + koff1); sr_[i].ks2 = *reinterpret_cast<const bf16x8*>(kt_ + koff2); } while (0)
#define SWRITE(b, i) do { *(bf16x8*)(V_lds + (b) * SHM_V + vst0) = sr_[i].vs0; *(bf16x8*)(V_lds + (b) * SHM_V + vst1) = sr_[i].vs1; \
    *(bf16x8*)(K_lds + (b) * SHM_K + kst0) = sr_[i].ks0; *(bf16x8*)(K_lds + (b) * SHM_K + kst1) = sr_[i].ks1; *(bf16x8*)(K_lds + (b) * SHM_K + kst2) = sr_[i].ks2; } while (0)
#define SWAIT() asm volatile("s_waitcnt vmcnt(0)" ::: "memory")
#define RESC(a) do { if (__any((a) < 1.f)) { if (hi == 0) al_l[r32] = (a); asm volatile("s_waitcnt lgkmcnt(0)" ::: "memory"); \
    _Pragma("unroll") for (int d = 0; d < 4; ++d) _Pragma("unroll") for (int r = 0; r < 16; ++r) o[d][r] *= al_l[crow(r, hi)]; } } while (0)
    f32x16 pA0, pA1, pB0, pB1; float mnA, mnB, alA, alB; bf16x8 pa0, pa1, pa2, pa3; const int NT = seq / KVBLK;
    constexpr int SE = 0, SO = 0;
    SLOAD(SE, 0); asm volatile("s_waitcnt vmcnt(0)" ::: "memory"); SWRITE(0, SE); __syncthreads();
    qkt(pA0, pA1, K_lds, qr, qrl, r32, hi); partialSM(pA0, pA1, m_reg, mnA, alA);
    SLOAD(SO, KVBLK);
    SWAIT(); SWRITE(1, SO); __syncthreads();
    for (int j = 1; j + 1 < NT; j += 2) {
        SBAR(); qkt(pB0, pB1, K_lds + SHM_K, qr, qrl, r32, hi);
        finishSM(pA0, pA1, alA, l_reg, pa0, pa1, pa2, pa3); SBAR();
        SLOAD(SO, (j + 1) * KVBLK); SBAR();
        pv_d0(o, vb0, pa0, pa1, pa2, pa3); partialSM(pB0, pB1, m_reg, mnB, alB);
        __syncthreads(); SWAIT(); SWRITE(0, SE);
        RESC(alB); __syncthreads();
        SBAR(); qkt(pA0, pA1, K_lds, qr, qrl, r32, hi);
        finishSM(pB0, pB1, alB, l_reg, pa0, pa1, pa2, pa3); SBAR();
        SLOAD(SE, (j + 2) * KVBLK); SBAR();
        pv_d0(o, vb0 + SHM_V, pa0, pa1, pa2, pa3); partialSM(pA0, pA1, m_reg, mnA, alA);
        __syncthreads(); SWAIT(); SWRITE(1, SO);
        RESC(alA); __syncthreads();
    }
    SBAR(); qkt(pB0, pB1, K_lds + SHM_K, qr, qrl, r32, hi);
    finishSM(pA0, pA1, alA, l_reg, pa0, pa1, pa2, pa3); SBAR();
    pv_d0(o, vb0, pa0, pa1, pa2, pa3); partialSM(pB0, pB1, m_reg, mnB, alB);
    __syncthreads(); RESC(alB);
    finishSM(pB0, pB1, alB, l_reg, pa0, pa1, pa2, pa3); SBAR();
    pv_d0(o, vb0 + SHM_V, pa0, pa1, pa2, pa3);
    if (hi == 0) li_l[r32] = l_reg; asm volatile("s_waitcnt lgkmcnt(0)" ::: "memory");
    float rli[16];
#pragma unroll
    for (int r = 0; r < 16; ++r) rli[r] = __builtin_amdgcn_rcpf(li_l[crow(r, hi)]);
    bf16_t* Ow = Ob + (long)(wid * QBLK) * ldo;
#pragma unroll
    for (int r = 0; r < 16; ++r) { const int orow = crow(r, hi);
#pragma unroll
        for (int d0 = 0; d0 < 4; ++d0) Ow[(long)orow * ldo + d0 * 32 + r32] = f2bf(o[d0][r] * rli[r]); }
    __syncthreads();
#undef SLOAD
#undef SWRITE
#undef SWAIT
#undef RESC
}
}
namespace pg8 {
__device__ __forceinline__ unsigned cvt_pk_bf16(float lo, float hi) { unsigned r; asm volatile("v_cvt_pk_bf16_f32 %0, %1, %2" : "=v"(r) : "v"(lo), "v"(hi)); return r; }
typedef unsigned u32x2 __attribute__((ext_vector_type(2)));
__device__ __forceinline__ void st_bf16x4(bf16_t* p, f32x4 v) { u32x2 w; w.x = cvt_pk_bf16(v[0], v[1]); w.y = cvt_pk_bf16(v[2], v[3]); *(u32x2*)p = w; }

template <size_t OFF, int LDC> struct EpiPlain {
    static constexpr bool PERM = false, AFTER_DRAIN = false;
    unsigned char* ws;
    __device__ __forceinline__ void operator()(const f32x4 (&acc)[2][2][4][2], const Unit& u, int wr, int wc, int fr, int fq) const {
#pragma unroll
        for (int ai = 0; ai < 2; ++ai)
#pragma unroll
            for (int m = 0; m < 4; ++m) { bf16_t* rowp = (bf16_t*)(ws + OFF) + (size_t)(u.pm * BM + ai * HALF + wr * 64 + m * 16 + fr) * LDC + u.pn * BM + wc * 32 + 4 * fq;
#pragma unroll
                for (int bj = 0; bj < 2; ++bj)
#pragma unroll
                    for (int n = 0; n < 2; ++n) st_bf16x4(rowp + bj * HALF + n * 16, acc[ai][bj][m][n]); }
    }
};
struct EpiUp {
    static constexpr bool PERM = false, AFTER_DRAIN = false;
    unsigned char* ws;
    __device__ __forceinline__ void operator()(const f32x4 (&acc)[2][2][4][2], const Unit& u, int wr, int wc, int fr, int fq) const {
        bf16_t* O = (bf16_t*)(ws + (u.which ? WS_KVRAW : WS_QRAW)); const int ldc = u.which ? 2048 : 1536;
#pragma unroll
        for (int ai = 0; ai < 2; ++ai)
#pragma unroll
            for (int m = 0; m < 4; ++m) { bf16_t* rowp = O + (size_t)(u.pm * BM + ai * HALF + wr * 64 + m * 16 + fr) * ldc + u.pn * BM + wc * 32 + 4 * fq;
#pragma unroll
                for (int bj = 0; bj < 2; ++bj)
#pragma unroll
                    for (int n = 0; n < 2; ++n) st_bf16x4(rowp + bj * HALF + n * 16, acc[ai][bj][m][n]); }
    }
};
struct EpiInProj {
    static constexpr bool PERM = false, AFTER_DRAIN = false;
    unsigned char* ws;
    __device__ __forceinline__ void operator()(const f32x4 (&acc)[2][2][4][2], const Unit& u, int wr, int wc, int fr, int fq) const {
        const int pn = u.pn;
        bf16_t* cq = (bf16_t*)(ws + WS_CQ); bf16_t* ckv = (bf16_t*)(ws + WS_CKV); bf16_t* mlqk = (bf16_t*)(ws + WS_MLQK); bf16_t* mlv = (bf16_t*)(ws + WS_MLV); bf16_t* mlo = (bf16_t*)(ws + WS_MLO);
        bf16_t* hyt = (bf16_t*)(ws + WS_HYT); bf16_t* hytc = (bf16_t*)(ws + WS_HYTC); float* krope = (float*)(ws + WS_KROPE); float* gates = (float*)(ws + WS_GATES);
#pragma unroll
        for (int ai = 0; ai < 2; ++ai)
#pragma unroll
            for (int m = 0; m < 4; ++m) {
                const int row = u.pm * BM + ai * HALF + wr * 64 + m * 16 + fr;
#pragma unroll
                for (int bj = 0; bj < 2; ++bj)
#pragma unroll
                    for (int n = 0; n < 2; ++n) {
                        const int colt = bj * HALF + wc * 32 + n * 16 + 4 * fq; const f32x4 v = acc[ai][bj][m][n];
                        if (pn < 2) st_bf16x4(cq + (size_t)row * 512 + pn * 256 + colt, v);
                        else if (pn < 4) st_bf16x4(ckv + (size_t)row * 512 + (pn - 2) * 256 + colt, v);
                        else if (pn < 10) { const int ch = (pn - 4) * 256 + colt; const unsigned w0 = cvt_pk_bf16(v[0], v[1]), w1 = cvt_pk_bf16(v[2], v[3]);
                            if (row < 16384) { const int b = row >> 12, t = row & 4095; bf16_t* o = hyt + ((size_t)(b * 1536 + ch)) * 4096 + t;
                                o[0] = (bf16_t)(w0 & 0xffffu); o[4096] = (bf16_t)(w0 >> 16); o[8192] = (bf16_t)(w1 & 0xffffu); o[12288] = (bf16_t)(w1 >> 16); }
                            else { const int rc = row - 16384, b = rc >> 8, t = rc & 255; bf16_t* o = hytc + ((size_t)(b * 1536 + ch)) * 256 + t;
                                o[0] = (bf16_t)(w0 & 0xffffu); o[256] = (bf16_t)(w0 >> 16); o[512] = (bf16_t)(w1 & 0xffffu); o[768] = (bf16_t)(w1 >> 16); } }
                        else if (pn < 14) st_bf16x4(mlqk + (size_t)row * 1024 + (pn - 10) * 256 + colt, v);
                        else if (pn < 16) st_bf16x4(mlv + (size_t)row * 512 + (pn - 14) * 256 + colt, v);
                        else if (pn < 18) st_bf16x4(mlo + (size_t)row * 512 + (pn - 16) * 256 + colt, v);
                        else { float* o = colt < 64 ? krope + (size_t)row * 64 + colt : gates + (size_t)row * 16 + (colt - 64);
                            if (colt < 80) { if (u.atomic) { unsafeAtomicAdd(o, v[0]); unsafeAtomicAdd(o + 1, v[1]); unsafeAtomicAdd(o + 2, v[2]); unsafeAtomicAdd(o + 3, v[3]); } else *(f32x4*)o = v; } }
                    }
            }
    }
};
template <int LAYER, int GIDX> struct EpiResid {
    static constexpr bool PERM = false, AFTER_DRAIN = false;
    const float* xin; float* xl; unsigned char* ws;
    __device__ __forceinline__ void operator()(const f32x4 (&acc)[2][2][4][2], const Unit& u, int wr, int wc, int fr, int fq) const {
        float* xc = (float*)(ws + WS_XC); const float* mod = (const float*)(ws + WS_MOD) + (size_t)LAYER * 5 * 12288; constexpr int gidx = GIDX;
        float* base = u.pm < 64 ? xl + (size_t)u.pm * BM * 2048 : xc + (size_t)(u.pm - 64) * BM * 2048;
        const float* rbase = u.pm < 64 ? xin + (size_t)u.pm * BM * 2048 : base;
        const float* mrow = mod + (size_t)(u.pm < 64 ? (u.pm >> 4) : 4) * 12288 + gidx * 2048;
        const int col0 = u.pn * BM + wc * 32 + 4 * fq;
        f32x4 mv[2][2];
#pragma unroll
        for (int bj = 0; bj < 2; ++bj)
#pragma unroll
            for (int n = 0; n < 2; ++n) mv[bj][n] = *(const f32x4*)(mrow + col0 + bj * HALF + n * 16);
#pragma unroll
        for (int ai = 0; ai < 2; ++ai)
#pragma unroll
            for (int m = 0; m < 4; ++m) { float* rowp = base + (size_t)(ai * HALF + wr * 64 + m * 16 + fr) * 2048 + col0; const float* rrow = rbase + (size_t)(ai * HALF + wr * 64 + m * 16 + fr) * 2048 + col0;
#pragma unroll
                for (int bj = 0; bj < 2; ++bj)
#pragma unroll
                    for (int n = 0; n < 2; ++n) { f32x4* p = (f32x4*)(rowp + bj * HALF + n * 16); const f32x4 d = mv[bj][n] * acc[ai][bj][m][n];
                        if (u.atomic) { float* pf = (float*)p; unsafeAtomicAdd(pf, d[0]); unsafeAtomicAdd(pf + 1, d[1]); unsafeAtomicAdd(pf + 2, d[2]); unsafeAtomicAdd(pf + 3, d[3]); }
                        else { f32x4 x = *(const f32x4*)(rrow + bj * HALF + n * 16); x = x + d; *p = x; } } }
    }
};
struct EpiSwiglu {
    static constexpr bool PERM = false, AFTER_DRAIN = false;
    unsigned char* ws;
    __device__ __forceinline__ void operator()(const f32x4 (&acc)[2][2][4][2], const Unit& u, int wr, int wc, int fr, int fq) const {
#pragma unroll
        for (int ai = 0; ai < 2; ++ai)
#pragma unroll
            for (int m = 0; m < 4; ++m) { bf16_t* rowp = (bf16_t*)(ws + WS_HID) + (size_t)(u.pm * BM + ai * HALF + wr * 64 + m * 16 + fr) * FFH + u.pn * HALF + wc * 32 + 4 * fq;
#pragma unroll
                for (int n = 0; n < 2; ++n) { const f32x4 g = acc[ai][0][m][n], up = acc[ai][1][m][n]; f32x4 o;
#pragma unroll
                    for (int j = 0; j < 4; ++j) o[j] = g[j] / (1.f + __expf(-g[j])) * up[j];
                    st_bf16x4(rowp + n * 16, o); } }
    }
};
}
constexpr int TP = 136;
constexpr int TILE_B = 128 * TP * 2;
__device__ __forceinline__ void mma128(f32x16& acc, const LAS bf16_t* A, int m0, const LAS bf16_t* B, int n0, int r32, int hi) {
    const LAS bf16_t* pa = A + (m0 + r32) * TP + hi * 8; const LAS bf16_t* pb = B + (n0 + r32) * TP + hi * 8;
#pragma unroll
    for (int ks = 0; ks < 8; ++ks) { const bf16x8 a = *(const LAS bf16x8*)(pa + ks * 16), b = *(const LAS bf16x8*)(pb + ks * 16);
        acc = __builtin_amdgcn_mfma_f32_32x32x16_bf16(a, b, acc, 0, 0, 0); }
}


__device__ __forceinline__ float scan16_sum(const LAS float* v, int t) { const int g16 = t & ~15, r = t & 15; float s = 0.f;
#pragma unroll
    for (int i = 0; i < 16; ++i) { const float x = v[g16 + i]; s += (i <= r) ? x : 0.f; } return s; }
__device__ __forceinline__ float scan16_max(const LAS float* v, int t) { const int g16 = t & ~15, r = t & 15; float s = -INFINITY;
#pragma unroll
    for (int i = 0; i < 16; ++i) { const float x = v[g16 + i]; s = (i <= r) ? fmaxf(s, x) : s; } return s; }
__device__ __forceinline__ float group_off_sum(const LAS float* gt, int t) { const int g = t >> 4; float s = 0.f;
#pragma unroll
    for (int h = 0; h < 8; ++h) { const float x = gt[h]; s += (h < g) ? x : 0.f; } return s; }
__device__ __forceinline__ float group_off_max(const LAS float* gt, int t) { const int g = t >> 4; float s = -INFINITY;
#pragma unroll
    for (int h = 0; h < 8; ++h) { const float x = gt[h]; s = (h < g) ? fmaxf(s, x) : s; } return s; }

__device__ __forceinline__ int ml_rowbase(int dir, int b, int j) {
    if (j < 2) { const int oc = dir ? 1 - j : j; return ML + b * CTXL + oc * 128; }
    const int oc = dir ? 33 - j : j - 2; return b * SEQ + oc * 128;
}

struct Args { const float* in[31]; float* out; unsigned char* ws; int ph_lo, ph_hi; };
enum { I_X = 0, I_C, I_CTX, I_CCTX, I_ADAW, I_ADAB, I_N1G, I_N2G, I_WIN, I_QAN, I_KVAN, I_WUQ, I_WUKV, I_QN, I_KN, I_HCW, I_HCB, I_HW1, I_HB1, I_HW2, I_HB2, I_HW3, I_HDEC, I_HSKIP,
       I_MCW, I_MCB, I_MGB, I_MIXG, I_WOUT, I_FW1, I_FW2 };

constexpr int FFT_SLOTS = 8192 + 512;
__device__ __forceinline__ int fphys(int i) { return i + 2 * (i >> 5); }
__device__ __forceinline__ f32x2 cmul(f32x2 a, f32x2 b) { return (f32x2){a.x * b.x - a.y * b.y, a.x * b.y + a.y * b.x}; }
__device__ __forceinline__ f32x2 cmulc(f32x2 a, f32x2 b) { return (f32x2){a.x * b.x + a.y * b.y, a.y * b.x - a.x * b.y}; }
#define FC1 0.9238795325112867f
#define FS1 0.3826834323650898f
#define FR2 0.7071067811865476f
template <bool INV> __device__ __forceinline__ void radix16(f32x2 (&x)[16], f32x2 t0, f32x2 t1, f32x2 t2, f32x2 t3) {
    const f32x2 W16[8] = {{1.f, 0.f}, {FC1, -FS1}, {FR2, -FR2}, {FS1, -FC1}, {0.f, -1.f}, {-FS1, -FC1}, {-FR2, -FR2}, {-FC1, -FS1}};
    if (!INV) {
#pragma unroll
        for (int j = 0; j < 8; ++j) { const f32x2 u = x[j], v = x[j + 8]; x[j] = u + v; x[j + 8] = cmul(u - v, cmul(t0, W16[j])); }
#pragma unroll
        for (int g = 0; g < 2; ++g)
#pragma unroll
            for (int j = 0; j < 4; ++j) { const f32x2 u = x[8 * g + j], v = x[8 * g + j + 4]; x[8 * g + j] = u + v; x[8 * g + j + 4] = cmul(u - v, cmul(t1, W16[2 * j])); }
#pragma unroll
        for (int g = 0; g < 4; ++g)
#pragma unroll
            for (int j = 0; j < 2; ++j) { const f32x2 u = x[4 * g + j], v = x[4 * g + j + 2]; x[4 * g + j] = u + v; x[4 * g + j + 2] = cmul(u - v, cmul(t2, W16[4 * j])); }
#pragma unroll
        for (int g = 0; g < 8; ++g) { const f32x2 u = x[2 * g], v = x[2 * g + 1]; x[2 * g] = u + v; x[2 * g + 1] = cmul(u - v, t3); }
    } else {
#pragma unroll
        for (int g = 0; g < 8; ++g) { const f32x2 u = x[2 * g], t = cmulc(x[2 * g + 1], t3); x[2 * g] = u + t; x[2 * g + 1] = u - t; }
#pragma unroll
        for (int g = 0; g < 4; ++g)
#pragma unroll
            for (int j = 0; j < 2; ++j) { const f32x2 u = x[4 * g + j], t = cmulc(x[4 * g + j + 2], cmul(t2, W16[4 * j])); x[4 * g + j] = u + t; x[4 * g + j + 2] = u - t; }
#pragma unroll
        for (int g = 0; g < 2; ++g)
#pragma unroll
            for (int j = 0; j < 4; ++j) { const f32x2 u = x[8 * g + j], t = cmulc(x[8 * g + j + 4], cmul(t1, W16[2 * j])); x[8 * g + j] = u + t; x[8 * g + j + 4] = u - t; }
#pragma unroll
        for (int j = 0; j < 8; ++j) { const f32x2 u = x[j], t = cmulc(x[j + 8], cmul(t0, W16[j])); x[j] = u + t; x[j + 8] = u - t; }
    }
}
struct FftTw { f32x2 t[3][4]; };
__device__ __forceinline__ void fft_load_tw(FftTw& w, const f32x2* __restrict__ TW, int tid) {
#pragma unroll
    for (int p = 0; p < 3; ++p) { const int r = p == 0 ? tid : p == 1 ? (tid & 31) : (tid & 1);
#pragma unroll
        for (int k = 0; k < 4; ++k) w.t[p][k] = TW[(8192 - (8192 >> (4 * p + k))) + r]; }
}
template <int PASS, bool INV, bool SYNC> __device__ __forceinline__ void fft_pass(LAS f32x2* X, const FftTw& w, int tid) {
    asm volatile("" : "+v"(tid));
    constexpr int stride = PASS == 0 ? 512 : PASS == 1 ? 32 : 2;
    const int r = PASS == 0 ? tid : PASS == 1 ? (tid & 31) : (tid & 1);
    const int base = PASS == 0 ? tid : PASS == 1 ? ((tid >> 5) * 512 + r) : ((tid >> 1) * 32 + r);
    f32x2 x[16];
#pragma unroll
    for (int j = 0; j < 16; ++j) x[j] = X[fphys(base + j * stride)];
    f32x2 t0 = w.t[PASS][0], t1 = w.t[PASS][1], t2 = w.t[PASS][2], t3 = w.t[PASS][3];
    asm volatile("" : "+v"(t0.x), "+v"(t0.y), "+v"(t1.x), "+v"(t1.y), "+v"(t2.x), "+v"(t2.y), "+v"(t3.x), "+v"(t3.y));
    radix16<INV>(x, t0, t1, t2, t3);
#pragma unroll
    for (int j = 0; j < 16; ++j) X[fphys(base + j * stride)] = x[j];
    if (SYNC) __syncthreads(); else asm volatile("s_waitcnt lgkmcnt(0)" ::: "memory");
}
__device__ __forceinline__ int fft_pair(int tid, int q) { return (tid >> 1) * 16 + (tid & 1) * 8 + q; }
__device__ __forceinline__ void fft_fwd_full(LAS f32x2* X, const FftTw& TW, int tid) {
    fft_pass<0, false, true>(X, TW, tid); fft_pass<1, false, false>(X, TW, tid); fft_pass<2, false, false>(X, TW, tid);
    asm volatile("" : "+v"(tid));
#pragma unroll
    for (int q = 0; q < 8; ++q) { const int m = fft_pair(tid, q); LAS f32x4* p = (LAS f32x4*)(X + fphys(2 * m)); const f32x4 v = *p; *p = (f32x4){v.x + v.z, v.y + v.w, v.x - v.z, v.y - v.w}; }
    __syncthreads();
}
__device__ __forceinline__ void fft_conv(LAS f32x2* X, const LAS f32x2* Gs, const FftTw& TW, int tid) {
    fft_pass<0, false, true>(X, TW, tid); fft_pass<1, false, false>(X, TW, tid); fft_pass<2, false, false>(X, TW, tid);
    asm volatile("" : "+v"(tid));
#pragma unroll 2
    for (int q = 0; q < 8; ++q) { const int m = fft_pair(tid, q); LAS f32x4* p = (LAS f32x4*)(X + fphys(2 * m)); const f32x4 v = *p; const f32x4 g = *(const LAS f32x4*)(Gs + fphys(2 * m));
        const f32x2 a = cmul((f32x2){v.x + v.z, v.y + v.w}, (f32x2){g.x, g.y}), b = cmul((f32x2){v.x - v.z, v.y - v.w}, (f32x2){g.z, g.w});
        *p = (f32x4){a.x + b.x, a.y + b.y, a.x - b.x, a.y - b.y}; }
    asm volatile("s_waitcnt lgkmcnt(0)" ::: "memory");
    fft_pass<2, true, false>(X, TW, tid); fft_pass<1, true, true>(X, TW, tid); fft_pass<0, true, true>(X, TW, tid);
}

__device__ __forceinline__ float conv3(const bf16_t* __restrict__ p, int t, int L, float w0, float w1, float w2, float bias) {
    float r = bias + w1 * bf2f(p[t]); if (t > 0) r += w0 * bf2f(p[t - 1]); if (t < L - 1) r += w2 * bf2f(p[t + 1]); return r;
}


#define XB_TMO      128
#define XB_XCNT(j)  (256  + 64 * (j))
#define XB_XSUB(j)  (1280 + 64 * (j))
#define XB_XGEN(j)  (2304 + 64 * (j))
#define XB_TOP      3328
#define XB_TOPGEN   3392
#define XCD_BAR_WORDS 3456
#define XB_SPIN_CAP (1u << 22)
__device__ __forceinline__ unsigned xb_ld(unsigned* p)              { return __hip_atomic_load(p, __ATOMIC_RELAXED, __HIP_MEMORY_SCOPE_AGENT); }
__device__ __forceinline__ unsigned xb_add(unsigned* p, unsigned v) { return __hip_atomic_fetch_add(p, v, __ATOMIC_RELAXED, __HIP_MEMORY_SCOPE_AGENT); }
__device__ __forceinline__ unsigned xb_xcc_id() { return (unsigned)__builtin_amdgcn_s_getreg((3 << 11) | 20) & 0xFu; }
#define XB_SPIN(cond, bar) do { unsigned _sp = 0; while (cond) { __builtin_amdgcn_s_sleep(1); \
    if ((++_sp & 255u) == 0u) { if (xb_ld(&(bar)[XB_TMO])) break; if (_sp > XB_SPIN_CAP) { atomicAdd(&(bar)[XB_TMO], 1u); break; } } } } while (0)
__device__ __forceinline__ void xcd_barrier_complete(unsigned* bar, unsigned x, unsigned& nloc, unsigned& nx) {
    const unsigned G = gridDim.x;
    unsigned sum, cnt, mine, sp = 0u;
    for (;;) {
        sum = 0u; cnt = 0u; mine = 0u;
#pragma unroll
        for (unsigned j = 0; j < 16; ++j) { const unsigned c = xb_ld(&bar[XB_XCNT(j)]); sum += c; cnt += (c > 0u) ? 1u : 0u; mine = (j == x) ? c : mine; }
        if (sum == G) break;
        __builtin_amdgcn_s_sleep(1);
        if ((++sp & 255u) == 0u) { if (xb_ld(&bar[XB_TMO])) break; if (sp > XB_SPIN_CAP) { atomicAdd(&bar[XB_TMO], 1u); break; } }
    }
    nloc = mine > 0u ? mine : 1u; nx = cnt > 0u ? cnt : 1u;
}
__device__ __forceinline__ void xcd_barrier(unsigned* bar, volatile LAS unsigned* st, bool first) {
    asm volatile("s_waitcnt vmcnt(0)" ::: "memory");
    __syncthreads();
    if (first) {
        const unsigned x = xb_xcc_id();
        __builtin_amdgcn_s_waitcnt(0);
        unsigned nloc = st[0], nx = st[1];
        if (nloc == 0u) { xcd_barrier_complete(bar, x, nloc, nx); st[0] = nloc; st[1] = nx; }
        const unsigned old = xb_add(&bar[XB_XSUB(x)], 1u);
        const unsigned gen = old / nloc;
        if (old + 1u == (gen + 1u) * nloc) {
            __builtin_amdgcn_fence(__ATOMIC_RELEASE, "agent");
            asm volatile("s_waitcnt vmcnt(0)" ::: "memory");
            const unsigned og = xb_add(&bar[XB_TOP], 1u);
            const unsigned tg = og / nx;
            if (og + 1u == (tg + 1u) * nx) xb_add(&bar[XB_TOPGEN], 1u);
            else XB_SPIN(xb_ld(&bar[XB_TOPGEN]) == tg, bar);
            __builtin_amdgcn_fence(__ATOMIC_ACQUIRE, "agent");
            xb_add(&bar[XB_XGEN(x)], 1u);
            asm volatile("s_waitcnt vmcnt(0)" ::: "memory");
        } else {
            XB_SPIN(xb_ld(&bar[XB_XGEN(x)]) == gen, bar);
            __builtin_amdgcn_fence(__ATOMIC_ACQUIRE, "agent");
            asm volatile("s_waitcnt vmcnt(0)" ::: "memory");
        }
    }
    __syncthreads();
}
template <int OFF> __device__ __forceinline__ unsigned long long karg() {
    unsigned long long v;
    asm volatile("s_load_dwordx2 %0, %1, %2\n\ts_waitcnt lgkmcnt(0)" : "=s"(v) : "s"(__builtin_amdgcn_kernarg_segment_ptr()), "n"(OFF) : "memory");
    return v;
}
__global__ void __launch_bounds__(NTHREADS, 2) fwd_kernel(Args args) {
    extern __shared__ __attribute__((aligned(16))) unsigned char lds_raw[];
    LAS unsigned char* lds = (LAS unsigned char*)lds_raw;
    const int WAVE_S = __builtin_amdgcn_readfirstlane((int)threadIdx.x >> 6);
#define XB_ST ((volatile LAS unsigned*)(lds + LDS_BYTES - 16))
#define XB_BAR ((unsigned*)ws + 4096)
#define XB_FIRST(res) do { int l_; asm volatile("v_mbcnt_lo_u32_b32 %0, -1, 0\n\tv_mbcnt_hi_u32_b32 %0, -1, %0" : "=v"(l_)); res = (WAVE_S == 0) && (l_ == 0); } while (0)
    typedef __attribute__((address_space(1))) unsigned char gbyte_t; typedef __attribute__((address_space(1))) const float gcfloat_t; typedef __attribute__((address_space(1))) float gfloat_t;
    unsigned char* const ws = (unsigned char*)(gbyte_t*)karg<256>();
    { bool f_; XB_FIRST(f_); if (f_) { XB_ST[0] = 0u; XB_ST[1] = 0u; (void)xb_add(&XB_BAR[XB_XCNT(xb_xcc_id())], 1u); } __syncthreads(); }
#define GRID_BAR() do { bool f_; XB_FIRST(f_); xcd_barrier(XB_BAR, XB_ST, f_); } while (0)
#define INP(i) ((const float*)(gcfloat_t*)karg<(i) * 8>())
#define OUT ((float*)(gfloat_t*)karg<248>())
#define MOD ((float*)(ws + WS_MOD))
#define TW ((const f32x2*)(ws + WS_TW))
#define TWW ((f32x2*)(ws + WS_TW))
#define H2L ((float*)(ws + WS_H2L))
#define H2C ((float*)(ws + WS_H2C))
#define MODP ((float*)(ws + WS_MODP))
#define KROPE ((float*)(ws + WS_KROPE))
#define GATES ((float*)(ws + WS_GATES))
#define MLN ((float*)(ws + WS_MLN))
#define XC ((float*)(ws + WS_XC))
#define WIN ((bf16_t*)(ws + WS_WIN))
#define WUQ ((bf16_t*)(ws + WS_WUQ))
#define WUKV ((bf16_t*)(ws + WS_WUKV))
#define WOUT ((bf16_t*)(ws + WS_WOUT))
#define W1 ((bf16_t*)(ws + WS_W1))
#define W2 ((bf16_t*)(ws + WS_W2))
#define ABUF ((bf16_t*)(ws + WS_A))
#define CQ ((bf16_t*)(ws + WS_CQ))
#define CKV ((bf16_t*)(ws + WS_CKV))
#define HYT ((const bf16_t*)(ws + WS_HYT))
#define HYTC ((const bf16_t*)(ws + WS_HYTC))
#define MLQK ((bf16_t*)(ws + WS_MLQK))
#define MLQK2 ((bf16_t*)(ws + WS_MLQK2))
#define MLV ((bf16_t*)(ws + WS_MLV))
#define MLO ((bf16_t*)(ws + WS_MLO))
#define QRAW ((bf16_t*)(ws + WS_QRAW))
#define KVRAW ((bf16_t*)(ws + WS_KVRAW))
#define QB ((bf16_t*)(ws + WS_Q))
#define QCB ((bf16_t*)(ws + WS_QC))
#define KB ((bf16_t*)(ws + WS_K))
#define VB ((bf16_t*)(ws + WS_V))
#define AO ((bf16_t*)(ws + WS_AO))
#define FILT ((float*)(ws + WS_Q))
#define YT ((float*)(ws + WS_YT))
#define YTC ((float*)(ws + WS_YTC))
#define CST ((float*)(ws + WS_CST))
#define HF ((float*)(ws + WS_HF))
#define HB ((float*)(ws + WS_HB))
#define HID ((bf16_t*)(ws + WS_HID))
#define MLOC ((float*)(ws + WS_MLS))
#define BLAST ((float*)(ws + WS_MLS) + 1088)
#define MIN_ ((float*)(ws + WS_MLS) + 2176)
#ifndef PMASK
#define PMASK 0xFFFFu
#endif
#define PH_BEGIN(n) { if constexpr ((PMASK >> (n)) & 1u) { int tid; asm volatile("v_mbcnt_lo_u32_b32 %0, -1, 0\n\tv_mbcnt_hi_u32_b32 %0, -1, %0" : "=v"(tid)); tid += WAVE_S * 64; \
    const int lane = tid & 63, wave = __builtin_amdgcn_readfirstlane(tid >> 6); const int G = gridDim.x, bid = blockIdx.x, gw = bid * NWAVES + wave, NGW = G * NWAVES; \
    const long gtid = (long)bid * NTHREADS + tid, GT = (long)G * NTHREADS; const int r32 = lane & 31, hi = lane >> 5; (void)gw; (void)NGW; (void)gtid; (void)GT; (void)r32; (void)hi;
#define PH_END } } GRID_BAR(); for (int ds_ = 0; ds_ < DUP_SYNC; ++ds_) GRID_BAR();

#define CONVERT_WEIGHTS(l) do { LAS float* scr = (LAS float*)(lds + wave * 8448); \
        constexpr int I0 = 32 * 152, I1 = 8 * 48, I2 = 8 * 64, I3 = 32 * 64, I4 = 32 * 352, I5 = 88 * 64; \
        for (int it = gw; it < I0 + I1 + I2 + I3 + I4 + I5; it += NGW) { int r = it; \
            if (r < I0) { wt_item(INP(I_WIN) + (size_t)(l) * DM * NIN, NIN, DM, WIN, nullptr, scr, r / 152, r % 152, lane, MapWin()); continue; } r -= I0; \
            if (r < I1) { wt_item(INP(I_WUQ) + (size_t)(l) * 512 * 1536, 1536, 512, WUQ, INP(I_QAN) + (l) * 512, scr, r / 48, r % 48, lane, MapIdent()); continue; } r -= I1; \
            if (r < I2) { wt_item(INP(I_WUKV) + (size_t)(l) * 512 * 2048, 2048, 512, WUKV, INP(I_KVAN) + (l) * 512, scr, r / 64, r % 64, lane, MapIdent()); continue; } r -= I2; \
            if (r < I3) { wt_item(INP(I_WOUT) + (size_t)(l) * DM * DM, DM, DM, WOUT, nullptr, scr, r / 64, r % 64, lane, MapIdent()); continue; } r -= I3; \
            if (r < I4) { wt_item(INP(I_FW1) + (size_t)(l) * DM * 2 * FFH, 2 * FFH, DM, W1, nullptr, scr, r / 352, r % 352, lane, MapW1()); continue; } r -= I4; \
            wt_item(INP(I_FW2) + (size_t)(l) * FFH * DM, DM, FFH, W2, nullptr, scr, r / 64, r % 64, lane, MapIdent()); } } while (0)


#define BUILD_FILTERS(l) do { LAS float* w3t = (LAS float*)lds; LAS float* h2t = (LAS float*)(lds + 16384 + 256); \
        const float* w3g = INP(I_HW3) + (size_t)(l) * 64 * 2048; const float* decg = INP(I_HDEC) + (size_t)(l) * 2048; const float* h2g = H2L + (size_t)(l) * SEQ * 64; \
        for (int it = bid; it < 1024; it += G) { const int ob_ = (it & 31) * 64, tb_ = (it >> 5) * 128; \
            __syncthreads(); \
            _Pragma("unroll") for (int q = 0; q < 8; ++q) { const int e = tid + NTHREADS * q; w3t[(e >> 6) * 65 + (e & 63)] = w3g[(size_t)(e >> 6) * 2048 + ob_ + (e & 63)]; } \
            _Pragma("unroll") for (int q = 0; q < 4; ++q) { const int e = tid + NTHREADS * q; *(LAS f32x4*)(h2t + 4 * e) = *(const f32x4*)(h2g + (size_t)tb_ * 64 + 4 * e); } \
            __syncthreads(); \
            const int to = tid & 63, tq = tid >> 6; float acc[16]; \
            _Pragma("unroll") for (int k = 0; k < 16; ++k) acc[k] = 0.f; \
            _Pragma("unroll 2") for (int i4 = 0; i4 < 16; ++i4) { const float w0 = w3t[(4 * i4) * 65 + to], w1 = w3t[(4 * i4 + 1) * 65 + to], w2 = w3t[(4 * i4 + 2) * 65 + to], w3v = w3t[(4 * i4 + 3) * 65 + to]; \
                _Pragma("unroll") for (int k = 0; k < 16; ++k) { const f32x4 hv = *(const LAS f32x4*)(h2t + (tq * 16 + k) * 64 + 4 * i4); acc[k] += hv.x * w0 + hv.y * w1 + hv.z * w2 + hv.w * w3v; } } \
            const float dc = decg[ob_ + to]; float* dst = FILT + (size_t)(ob_ + to) * 4096 + tb_ + tq * 16; \
            _Pragma("unroll") for (int k4 = 0; k4 < 4; ++k4) { f32x4 o; \
                _Pragma("unroll") for (int k = 0; k < 4; ++k) { const float tn = (float)(tb_ + tq * 16 + 4 * k4 + k) * (1.f / 4096.f); o[k] = acc[4 * k4 + k] * (expf(-tn * dc) + 0.05f); } \
                *(f32x4*)(dst + 4 * k4) = o; } } \
        __syncthreads(); } while (0)

#define NORM_ROWS(l, gptr, si, nrows, xsrc) do { const float* gp_ = (gptr); const float* const xo_ = (xsrc); for (int rp_ = 0; rp_ <= DUP_NORM; ++rp_) for (int r = gw; r < (nrows); r += NGW) { \
        const float* xr = r < ML ? xo_ + (size_t)r * DM : XC + (size_t)(r - ML) * DM; const float* mrow = MOD + ((size_t)(l) * 5 + (r < ML ? (r >> 12) : 4)) * 12288; \
        f32x4 v[8]; float ss = 0.f; \
        _Pragma("unroll") for (int j = 0; j < 8; ++j) { v[j] = *(const f32x4*)(xr + 4 * lane + 256 * j); ss += v[j].x * v[j].x + v[j].y * v[j].y + v[j].z * v[j].z + v[j].w * v[j].w; } \
        const float rs = rsqrtf(wave_sum(ss) * (1.f / DM) + EPS); \
        _Pragma("unroll") for (int j = 0; j < 8; ++j) { const int c = 4 * lane + 256 * j; const f32x4 g = *(const f32x4*)(gp_ + c), sh = *(const f32x4*)(mrow + (si) * DM + c), sc = *(const f32x4*)(mrow + ((si) + 1) * DM + c); \
            const f32x4 y = (v[j] * rs * g) * (sc + 1.f) + sh; pg8::st_bf16x4(ABUF + (size_t)r * DM + c, y); } } } while (0)

    PH_BEGIN(0)
    for (int rg_ = 0; rg_ <= DUP_G0; ++rg_) {
        { const f32x4* s2 = (const f32x4*)INP(I_CTX); f32x4* d2 = (f32x4*)XC; for (long i = gtid; i < (long)MC * DM / 4; i += GT) d2[i] = s2[i]; }
        { LAS float* sc = (LAS float*)lds;
          for (int it = bid; it < 2 * 32 * 12; it += G) { const int nc = it % 12, kc = (it / 12) % 32, l = it / 384;
            __syncthreads();
            if (tid < 320) { const float* cp = INP(I_C); const float* ccp = INP(I_CCTX); const int i = tid >> 6, k = kc * 64 + (tid & 63); const float cv = i < 4 ? cp[i * DM + k] : ccp[k]; sc[tid] = siluf(cv); }
            __syncthreads();
            const int n = nc * 1024 + tid * 2; const float* wp = INP(I_ADAW) + ((size_t)l * DM + kc * 64) * 12288 + n;
            f32x2 a0 = {0.f, 0.f}, a1 = a0, a2 = a0, a3 = a0, a4 = a0;
#pragma unroll 8
            for (int k = 0; k < 64; ++k) { const f32x2 w = *(const f32x2*)(wp + (size_t)k * 12288); a0 += w * sc[k]; a1 += w * sc[64 + k]; a2 += w * sc[128 + k]; a3 += w * sc[192 + k]; a4 += w * sc[256 + k]; }
            float* o = MODP + (((size_t)kc * 2 + l) * 5) * 12288 + n;
            *(f32x2*)(o) = a0; *(f32x2*)(o + 12288) = a1; *(f32x2*)(o + 2 * 12288) = a2; *(f32x2*)(o + 3 * 12288) = a3; *(f32x2*)(o + 4 * 12288) = a4; }
          __syncthreads(); }
        for (long e = gtid; e < 8191; e += GT) { int s = 0; while (e >= 8192 - (8192 >> (s + 1))) ++s; const int pos = (int)e - (8192 - (8192 >> s));
            float sn, cs; sincospif((float)(pos << s) * (1.f / 4096.f), &sn, &cs); TWW[e] = (f32x2){cs, -sn}; }
        for (int it = gw; it < 2 * (SEQ + CTXL); it += NGW) { const int l = it / (SEQ + CTXL), rr = it % (SEQ + CTXL); const bool isc = rr >= SEQ; const int t = isc ? rr - SEQ : rr; const float Lf = isc ? 256.f : 4096.f;
            float feat = 0.f;
            if (lane == 0) feat = (float)t / Lf; else if (lane <= 16) feat = cospif(2.f * (float)(t * lane) / Lf); else if (lane <= 32) feat = sinpif(2.f * (float)(t * (lane - 16)) / Lf);
            const float* w1 = INP(I_HW1) + (size_t)l * 33 * 64; float a = INP(I_HB1)[l * 64 + lane];
            for (int i = 0; i < 33; ++i) a += __int_as_float(__builtin_amdgcn_readlane(__float_as_int(feat), i)) * w1[i * 64 + lane];
            const float h1 = sinf(a);
            const float* w2 = INP(I_HW2) + (size_t)l * 64 * 64; float a2 = INP(I_HB2)[l * 64 + lane];
            for (int i = 0; i < 64; ++i) a2 += __int_as_float(__builtin_amdgcn_readlane(__float_as_int(h1), i)) * w2[i * 64 + lane];
            (isc ? H2C + ((size_t)l * CTXL + t) * 64 : H2L + ((size_t)l * SEQ + t) * 64)[lane] = sinf(a2); }
        __syncthreads();
        CONVERT_WEIGHTS(0);
    }
    PH_END
    cg::this_grid().sync();
    PH_BEGIN(1)
    for (int rg_ = 0; rg_ <= DUP_G1; ++rg_) {
        for (long e = gtid; e < 2 * 5 * 12288; e += GT) { const int n = (int)(e % 12288), l = (int)(e / (5 * 12288)); float a = INP(I_ADAB)[l * 12288 + n];
            for (int kc = 0; kc < 32; ++kc) a += MODP[(size_t)kc * 2 * 5 * 12288 + e]; MOD[e] = a; }
        BUILD_FILTERS(0);
    }
    PH_END

    { constexpr int l = 0; constexpr bool need_ctx = (l == 0);
        PH_BEGIN(2)
            NORM_ROWS(l, INP(I_N1G) + l * DM, 0, MT, (l == 0 ? (float*)INP(I_X) : OUT));
            if (l == 1) { __syncthreads(); CONVERT_WEIGHTS(1); __syncthreads(); BUILD_FILTERS(1); }
        PH_END
        PH_BEGIN(3)
            pg8::Gemm g{ABUF, WIN, MT, NINP, DM}; pg8::EpiInProj E{ws};
            if constexpr (l == 0) { pg8::StaticOrder S; S.init(MT, NINP, G, bid, DM); for (int rp_ = 0; rp_ <= DUP_INPROJ; ++rp_) pg8::gemm_phase<pg8::EpiInProj, pg8::StaticOrder, true, true>(lds, g, S, E, tid); }
            else { pg8::InProjL1Order S; S.init(G, bid, DM); for (int rp_ = 0; rp_ <= DUP_INPROJ; ++rp_) pg8::gemm_phase<pg8::EpiInProj, pg8::InProjL1Order, true, true>(lds, g, S, E, tid); }
        PH_END
        PH_BEGIN(4)
            { pg8::Gemm g{CQ, WUQ, MT, 1536, 512, CKV, WUKV}; pg8::DualUpOrder S; S.init(G, bid); pg8::EpiUp E{ws};
              for (int rp_ = 0; rp_ <= DUP_UP; ++rp_) pg8::gemm_phase<pg8::EpiUp, pg8::DualUpOrder, true, true>(lds, g, S, E, tid); }
            { const float* cw = INP(I_MCW) + (size_t)l * 3 * 1024; const float* cb = INP(I_MCB) + (size_t)l * 1024;
              for (int rp_ = 0; rp_ <= DUP_M0; ++rp_)
              for (long e = gtid; e < (long)MT * 128; e += GT) { const int r = (int)(e >> 7), c8 = (int)(e & 127) * 8;
                int t, L; if (r < ML) { t = r & 4095; L = SEQ; } else { t = (r - ML) & 255; L = CTXL; }
                const bf16x8 z = {0, 0, 0, 0, 0, 0, 0, 0};
                const bf16x8 xm = *(const bf16x8*)(MLQK + (size_t)r * 1024 + c8), xp = t > 0 ? *(const bf16x8*)(MLQK + (size_t)(r - 1) * 1024 + c8) : z, xn = t < L - 1 ? *(const bf16x8*)(MLQK + (size_t)(r + 1) * 1024 + c8) : z;
                float y[8]; const float qs = c8 < 512 ? 0.08838834764831845f : 1.f;
#pragma unroll
                for (int i = 0; i < 8; ++i) { const int c = c8 + i; y[i] = siluf(cb[c] + cw[c] * bf2f_s(xp[i]) + cw[1024 + c] * bf2f_s(xm[i]) + cw[2048 + c] * bf2f_s(xn[i])) * qs; }
                u32x4 o; o.x = cvtpk(y[0], y[1]); o.y = cvtpk(y[2], y[3]); o.z = cvtpk(y[4], y[5]); o.w = cvtpk(y[6], y[7]); *(u32x4*)(MLQK2 + (size_t)r * 1024 + c8) = o; } }
            { LAS f32x2* X = (LAS f32x2*)lds; LAS f32x2* Gs = (LAS f32x2*)(lds + FFT_SLOTS * 8); LAS float* w3s = (LAS float*)(lds + 2 * FFT_SLOTS * 8);
              const float* hcw = INP(I_HCW) + (size_t)l * 3 * 1536; const float* hcb = INP(I_HCB) + (size_t)l * 1536;
              const float* w3 = INP(I_HW3) + (size_t)l * 64 * 2048; const float* dec = INP(I_HDEC) + (size_t)l * 2048; const float* skip = INP(I_HSKIP) + (size_t)l * 1024;
              const float* H2 = H2L + (size_t)l * SEQ * 64;
              FftTw ftw; fft_load_tw(ftw, TW, tid);
              for (int rep_ = 0; rep_ <= DUP_HY; ++rep_)
              for (int c0 = bid; c0 < 512; c0 += G) { int c = c0; asm volatile("" : "+s"(c));
                const float vw0 = hcw[c], vw1 = hcw[1536 + c], vw2 = hcw[3072 + c], vbb = hcb[c];
                for (int n = 0; n < 2; ++n) {
                    const int of = n * 1024 + c, ob = n * 1024 + 512 + c;
                    __syncthreads();
                    { const float* ff = FILT + (size_t)of * 4096; const float* fb = FILT + (size_t)ob * 4096;
#pragma unroll 2
                      for (int q = 0; q < 8; ++q) { const int t = tid + 512 * q; Gs[fphys(t)] = (f32x2){ff[t], 0.f};
                        if (t == 0) Gs[fphys(4096)] = (f32x2){0.f, 0.f}; else Gs[fphys(8192 - t)] = (f32x2){fb[t], 0.f}; } }
                    __syncthreads();
                    fft_fwd_full(Gs, ftw, tid);
                    const float sk = skip[n * 512 + c];
                    const int gch = (n + 1) * 512 + c;
                    const float gw0 = hcw[gch], gw1 = hcw[1536 + gch], gw2 = hcw[3072 + gch], gbb = hcb[gch];
#pragma unroll 1
                    for (int bp = 0; bp < 2; ++bp) {
                        const bf16_t* u0 = HYT + ((size_t)((2 * bp) * 1536 + c)) * 4096; const bf16_t* u1 = HYT + ((size_t)((2 * bp + 1) * 1536 + c)) * 4096;
                        float* y0p = YT + ((size_t)((2 * bp) * 512 + c)) * 4096; float* y1p = YT + ((size_t)((2 * bp + 1) * 512 + c)) * 4096;
                        const bf16_t* g0p = HYT + ((size_t)((2 * bp) * 1536 + gch)) * 4096; const bf16_t* g1p = HYT + ((size_t)((2 * bp + 1) * 1536 + gch)) * 4096;
                        f32x2 zq[8], gq[8];
#pragma unroll
                        for (int q = 0; q < 8; ++q) { const int t = tid + 512 * q;
                            if (n == 0) { zq[q].x = conv3(u0, t, SEQ, vw0, vw1, vw2, vbb); zq[q].y = conv3(u1, t, SEQ, vw0, vw1, vw2, vbb); } else { zq[q].x = y0p[t]; zq[q].y = y1p[t]; }
                            gq[q].x = conv3(g0p, t, SEQ, gw0, gw1, gw2, gbb); gq[q].y = conv3(g1p, t, SEQ, gw0, gw1, gw2, gbb); }
#pragma unroll
                        for (int q = 0; q < 8; ++q) { const int t = tid + 512 * q; X[fphys(t)] = zq[q]; X[fphys(4096 + t)] = (f32x2){0.f, 0.f}; }
                        __syncthreads();
                        fft_conv(X, Gs, ftw, tid);
#pragma unroll
                        for (int q = 0; q < 8; ++q) { const int t = tid + 512 * q; const f32x2 y = X[fphys(t)] * (1.f / 8192.f);
                            y0p[t] = gq[q].x * (y.x + sk * zq[q].x); y1p[t] = gq[q].y * (y.y + sk * zq[q].y); }
                        __syncthreads();
                    }
                }
              }
              if (need_ctx) {
                LAS float* hf = (LAS float*)lds;
                LAS float* zs = (LAS float*)(lds + 4096);
                LAS float* w3c = (LAS float*)(lds + 8192);
                const float* H2c = H2C + (size_t)l * CTXL * 64;
                for (int c = bid; c < 512; c += G) {
                    __syncthreads();
                    if (tid < 256) { const int f = tid >> 6, i = tid & 63; w3c[tid] = w3[i * 2048 + (f >> 1) * 1024 + (f & 1) * 512 + c]; }
                    __syncthreads();
                    for (int e = tid; e < 1024; e += NTHREADS) { const int f = e >> 8, t = e & 255; const int o = (f >> 1) * 1024 + (f & 1) * 512 + c; float a = 0.f;
                        for (int i = 0; i < 64; ++i) a += H2c[t * 64 + i] * w3c[f * 64 + i];
                        hf[e] = a * (expf(-((float)t * (1.f / 256.f)) * dec[o]) + 0.05f); }
                    const int b = tid >> 7; float zv[2], zc[2];
#pragma unroll
                    for (int q = 0; q < 2; ++q) { const int t = (tid & 127) + 128 * q; zv[q] = conv3(HYTC + ((size_t)(b * 1536 + c)) * 256, t, CTXL, hcw[c], hcw[1536 + c], hcw[3072 + c], hcb[c]); zs[b * 256 + t] = zv[q]; }
                    __syncthreads();
                    for (int n = 0; n < 2; ++n) { const LAS float* gf = hf + n * 512; const LAS float* gb = hf + n * 512 + 256; const int gch = (n + 1) * 512 + c;
#pragma unroll
                        for (int q = 0; q < 2; ++q) { const int t = (tid & 127) + 128 * q; float y = 0.f;
                            for (int s = 0; s <= t; ++s) y += zs[b * 256 + s] * gf[t - s];
                            for (int s = t + 1; s < 256; ++s) y += zs[b * 256 + s] * gb[s - t];
                            const float gate = conv3(HYTC + ((size_t)(b * 1536 + gch)) * 256, t, CTXL, hcw[gch], hcw[1536 + gch], hcw[3072 + gch], hcb[gch]);
                            zc[q] = gate * (y + skip[n * 512 + c] * zv[q]); }
                        __syncthreads();
#pragma unroll
                        for (int q = 0; q < 2; ++q) { const int t = (tid & 127) + 128 * q; zv[q] = zc[q]; if (n == 0) zs[b * 256 + t] = zc[q]; else YTC[((size_t)(b * 512 + c)) * 256 + t] = zc[q]; }
                        __syncthreads(); }
                }
              }
            }
        PH_END
        PH_BEGIN(5)
            { LAS f32x2* rtab = (LAS f32x2*)lds;
              __syncthreads();
              for (int e = tid; e < 1024; e += NTHREADS) { const float ang = (float)(e >> 4) * powf(10000.f, -(float)(e & 15) * (1.f / 16.f)); rtab[e] = (f32x2){cosf(ang), sinf(ang)}; }
              __syncthreads();
              const int l16 = lane & 15, ts = lane >> 4; const bool xhi = l16 >= 8, rowax = (l16 & 7) < 4; const int f0 = 4 * (l16 & 3);
              const float* qg = INP(I_QN) + l * 192; const float* kg = INP(I_KN) + l * 192;
              float qgn[8], kgn[8], qgr[4], kgr[4];
#pragma unroll
              for (int i = 0; i < 8; ++i) { qgn[i] = qg[8 * l16 + i]; kgn[i] = kg[8 * l16 + i]; }
#pragma unroll
              for (int i = 0; i < 4; ++i) { qgr[i] = qg[128 + 4 * l16 + i]; kgr[i] = kg[128 + 4 * l16 + i]; }
#define RED16(v) do { v += swz_xor<1>(v); v += swz_xor<2>(v); v += swz_xor<4>(v); v += swz_xor<8>(v); } while (0)
              for (int rp_ = 0; rp_ <= DUP_POST; ++rp_)
              for (int r0 = gw * 4; r0 < MT; r0 += NGW * 4) { const int r = r0 + ts;
                int b, t, key; const bool isl = r < ML; if (isl) { b = r >> 12; t = r & 4095; key = CTXL + t; } else { b = (r - ML) >> 8; t = (r - ML) & 255; key = t; }
                const bf16_t* qrow = QRAW + (size_t)r * 1536; const bf16_t* kvrow = KVRAW + (size_t)r * 2048;
                bf16x8 cqv[4], ckv4[4], qn_[8], kn_[8], vn_[8]; u32x2 qr_[8];
#pragma unroll
                for (int i = 0; i < 4; ++i) { cqv[i] = *(const bf16x8*)(CQ + (size_t)r * 512 + 32 * l16 + 8 * i); ckv4[i] = *(const bf16x8*)(CKV + (size_t)r * 512 + 32 * l16 + 8 * i); }
                const f32x4 krv = *(const f32x4*)(KROPE + (size_t)r * 64 + 4 * l16);
#pragma unroll
                for (int h = 0; h < 8; ++h) { qn_[h] = *(const bf16x8*)(qrow + h * 192 + 8 * l16); qr_[h] = *(const u32x2*)(qrow + h * 192 + 128 + 4 * l16);
                    kn_[h] = *(const bf16x8*)(kvrow + h * 256 + 8 * l16); vn_[h] = *(const bf16x8*)(kvrow + h * 256 + 128 + 8 * l16); }
                float ssq = 0.f, sskv = 0.f;
#pragma unroll
                for (int i = 0; i < 4; ++i)
#pragma unroll
                    for (int e = 0; e < 8; ++e) { const float x = bf2f_s(cqv[i][e]), y = bf2f_s(ckv4[i][e]); ssq += x * x; sskv += y * y; }
                RED16(ssq); RED16(sskv);
                const float rsq = rsqrtf(ssq * (1.f / 512.f) + EPS), rskv = rsqrtf(sskv * (1.f / 512.f) + EPS);
                float cs[4], sn[4];
#pragma unroll
                for (int i = 0; i < 4; ++i) { cs[i] = 1.f; sn[i] = 0.f; }
                if (isl) { const int pos = rowax ? (t >> 6) : (t & 63);
#pragma unroll
                    for (int i = 0; i < 4; ++i) { const f32x2 e = rtab[pos * 16 + f0 + i]; cs[i] = e.x; sn[i] = e.y; } }
                float krss = krv.x * krv.x + krv.y * krv.y + krv.z * krv.z + krv.w * krv.w;
#pragma unroll
                for (int h = 0; h < 8; ++h) {
                    float xn[8], xr[4]; float ss = 0.f;
#pragma unroll
                    for (int i = 0; i < 8; ++i) { xn[i] = bf2f_s(qn_[h][i]) * rsq; ss += xn[i] * xn[i]; }
                    xr[0] = __uint_as_float(qr_[h].x << 16) * rsq; xr[1] = __uint_as_float(qr_[h].x & 0xffff0000u) * rsq; xr[2] = __uint_as_float(qr_[h].y << 16) * rsq; xr[3] = __uint_as_float(qr_[h].y & 0xffff0000u) * rsq;
#pragma unroll
                    for (int i = 0; i < 4; ++i) ss += xr[i] * xr[i];
                    RED16(ss);
                    float rn = rsqrtf(ss * (1.f / 192.f) + EPS);
                    if (isl || need_ctx) {
                        bf16_t* qo = isl ? QB + ((size_t)((b * 8 + h) * SEQ + t)) * 192 : QCB + ((size_t)((b * 8 + h) * CTXL + t)) * 192;
                        u32x4 w; w.x = cvtpk(xn[0] * rn * qgn[0], xn[1] * rn * qgn[1]); w.y = cvtpk(xn[2] * rn * qgn[2], xn[3] * rn * qgn[3]); w.z = cvtpk(xn[4] * rn * qgn[4], xn[5] * rn * qgn[5]); w.w = cvtpk(xn[6] * rn * qgn[6], xn[7] * rn * qgn[7]);
                        *(u32x4*)(qo + 8 * l16) = w;
                        float yo[4];
#pragma unroll
                        for (int i = 0; i < 4; ++i) { const float v = xr[i] * rn * qgr[i]; const float pr = swz_xor<8>(v); yo[i] = xhi ? v * cs[i] + pr * sn[i] : v * cs[i] - pr * sn[i]; }
                        u32x2 w2; w2.x = cvtpk(yo[0], yo[1]); w2.y = cvtpk(yo[2], yo[3]); *(u32x2*)(qo + 128 + 4 * l16) = w2; }
                    float yn[8]; ss = krss;
#pragma unroll
                    for (int i = 0; i < 8; ++i) { yn[i] = bf2f_s(kn_[h][i]) * rskv; ss += yn[i] * yn[i]; }
                    RED16(ss);
                    rn = rsqrtf(ss * (1.f / 192.f) + EPS);
                    { bf16_t* ko = KB + ((size_t)((b * 8 + h) * NKEY + key)) * 192;
                      u32x4 w; w.x = cvtpk(yn[0] * rn * kgn[0], yn[1] * rn * kgn[1]); w.y = cvtpk(yn[2] * rn * kgn[2], yn[3] * rn * kgn[3]); w.z = cvtpk(yn[4] * rn * kgn[4], yn[5] * rn * kgn[5]); w.w = cvtpk(yn[6] * rn * kgn[6], yn[7] * rn * kgn[7]);
                      *(u32x4*)(ko + 8 * l16) = w;
                      const float kr4[4] = {krv.x, krv.y, krv.z, krv.w}; float yo[4];
#pragma unroll
                      for (int i = 0; i < 4; ++i) { const float v = kr4[i] * rn * kgr[i]; const float pr = swz_xor<8>(v); yo[i] = xhi ? v * cs[i] + pr * sn[i] : v * cs[i] - pr * sn[i]; }
                      u32x2 w2; w2.x = cvtpk(yo[0], yo[1]); w2.y = cvtpk(yo[2], yo[3]); *(u32x2*)(ko + 128 + 4 * l16) = w2;
                      bf16_t* vo = VB + ((size_t)((b * 8 + h) * NKEY + key)) * 128;
                      u32x4 wv; wv.x = cvtpk(bf2f_s(vn_[h][0]) * rskv, bf2f_s(vn_[h][1]) * rskv); wv.y = cvtpk(bf2f_s(vn_[h][2]) * rskv, bf2f_s(vn_[h][3]) * rskv);
                      wv.z = cvtpk(bf2f_s(vn_[h][4]) * rskv, bf2f_s(vn_[h][5]) * rskv); wv.w = cvtpk(bf2f_s(vn_[h][6]) * rskv, bf2f_s(vn_[h][7]) * rskv);
                      *(u32x4*)(vo + 8 * l16) = wv; }
                }
              }
#undef RED16
              __syncthreads(); }
            { LAS bf16_t* kwT = (LAS bf16_t*)lds; LAS bf16_t* vT = (LAS bf16_t*)(lds + TILE_B); LAS float* ar = (LAS float*)(lds + 4 * TILE_B);
              LAS float* a_li = ar, *a_lf = ar + 128, *a_b = ar + 256, *a_g = ar + 384, *a_w = ar + 512, *a_gt = ar + 640;
              const float* gb = INP(I_MGB) + l * 16;
              for (int rep_ = 0; rep_ <= DUP_ML; ++rep_)
              for (int u = bid; u < 1088; u += G) { const int j = u % 34, h = (u / 34) & 3, b = (u / 136) & 3, dir = u / 544, sc = (dir * 4 + b) * 4 + h; const int rowbase = ml_rowbase(dir, b, j);
                __syncthreads();
                bf16x8 kk[4], vv[4];
#pragma unroll
                for (int i = 0; i < 4; ++i) { const int idx = tid + NTHREADS * i, s = idx & 127, c8 = (idx >> 7) * 8; const int row = rowbase + (dir ? 127 - s : s);
                    kk[i] = *(const bf16x8*)(MLQK2 + (size_t)row * 1024 + 512 + h * 128 + c8); vv[i] = *(const bf16x8*)(MLV + (size_t)row * 512 + h * 128 + c8); }
                if (tid < 128) { const int row = rowbase + (dir ? 127 - tid : tid); const float* g = GATES + (size_t)row * 16;
                    a_li[tid] = g[dir * 4 + h] + gb[dir * 4 + h]; a_lf[tid] = logsigmoidf(g[(2 + dir) * 4 + h] + gb[(2 + dir) * 4 + h]); }
                __syncthreads();
                { float loc = 0.f; if (tid < 128) { loc = scan16_sum(a_lf, tid); if ((tid & 15) == 15) a_gt[tid >> 4] = loc; }
                  __syncthreads();
                  if (tid < 128) a_b[tid] = group_off_sum(a_gt, tid) + loc; }
                __syncthreads();
                if (tid < 128) a_g[tid] = a_b[127] - a_b[tid] + a_li[tid];
                __syncthreads();
                if (tid < 128) { float mx = a_g[0]; for (int i = 1; i < 128; ++i) mx = fmaxf(mx, a_g[i]); a_w[tid] = expf(a_g[tid] - mx); if (tid == 0) { MLOC[sc * 34 + j] = mx; BLAST[sc * 34 + j] = a_b[127]; } }
                __syncthreads();
#pragma unroll
                for (int q = 0; q < 4; ++q) { const int idx = tid + NTHREADS * q, s = idx & 127, c8 = (idx >> 7) * 8; const float wsv = a_w[s];
#pragma unroll
                    for (int i = 0; i < 8; ++i) { kwT[(c8 + i) * TP + s] = f2bf(bf2f_s(kk[q][i]) * wsv); vT[(c8 + i) * TP + s] = (bf16_t)vv[q][i]; } }
                __syncthreads();
                { const int nb = wave & 3, mh = wave >> 2; float* dst = CST + ((size_t)(sc * 34 + j)) * 16384;
#pragma unroll
                  for (int mt = 0; mt < 2; ++mt) { f32x16 acc = {}; mma128(acc, vT, 64 * mh + 32 * mt, kwT, 32 * nb, r32, hi);
#pragma unroll
                    for (int r = 0; r < 16; ++r) dst[(64 * mh + 32 * mt + crow(r, hi)) * 128 + 32 * nb + r32] = acc[r]; } }
                if (tid < 128) { float s = 0.f;
#pragma unroll
                    for (int i = 0; i < 16; ++i) { const bf16x8 kv = *(const LAS bf16x8*)(kwT + tid * TP + 8 * i);
#pragma unroll
                        for (int e = 0; e < 8; ++e) s += bf2f_s(kv[e]); }
                    MLN[((size_t)(sc * 34 + j)) * 128 + tid] = s; }
              }
              __syncthreads(); }
        PH_END
        PH_BEGIN(6)
            { const int nlat = NB * 8 * 16, nunits = nlat + (need_ctx ? NB * 8 : 0);
              for (int rp_ = 0; rp_ <= DUP_ATT; ++rp_)
              for (int u = bid; u < nunits; u += G) {
                const bf16_t* qp; bf16_t* op; int seq, bh;
                if (u < nlat) { const int xcd = u & 7, idx = ((u & 255) >> 3) + 32 * (u >> 8), qb = idx & 15; bh = xcd * 4 + (idx >> 4); const int h = bh & 7, b = bh >> 3;     qp = QB + ((size_t)(bh * SEQ + qb * 256)) * 192; op = AO + ((size_t)(b * SEQ + qb * 256)) * 1024 + h * 128; seq = NKEY; }
                else { const int v = u - nlat, h = v & 7, b = v >> 3; bh = b * 8 + h; qp = QCB + ((size_t)(bh * CTXL)) * 192; op = AO + ((size_t)(ML + b * CTXL)) * 1024 + h * 128; seq = CTXL; }
                att::attn_body(qp, KB + (size_t)bh * NKEY * 192, VB + (size_t)bh * NKEY * 128, op, 1024, seq, (char*)lds_raw, tid);
              } }
            for (long e = gtid; e < 131072 + 1024; e += GT) {
                int sc; float* base; int stride; bool lead = false;
                if (e < 131072) { sc = (int)(e >> 12); base = CST + (size_t)sc * 34 * 16384 + (e & 4095) * 4; stride = 16384; lead = (e & 4095) == 0; }
                else { const int e2 = (int)(e - 131072); sc = e2 >> 5; base = MLN + (size_t)sc * 34 * 128 + (e2 & 31) * 4; stride = 128; }
                float m = 0.f; f32x4 st = {0.f, 0.f, 0.f, 0.f};
#pragma unroll 1
                for (int jb = 0; jb < 34; jb += 17) { f32x4 tmp[17];
#pragma unroll
                    for (int k = 0; k < 17; ++k) tmp[k] = *(const f32x4*)(base + (size_t)(jb + k) * stride);
#pragma unroll
                    for (int k = 0; k < 17; ++k) { const int j = jb + k; const float ml = MLOC[sc * 34 + j], bl = BLAST[sc * 34 + j]; *(f32x4*)(base + (size_t)j * stride) = st;
                        const float mnew = fmaxf(bl + m, ml), a = expf(bl + m - mnew), wg = expf(ml - mnew); st = st * a + tmp[k] * wg; if (lead) MIN_[sc * 34 + j] = m; m = mnew; } }
            }
        PH_END
        PH_BEGIN(7)
            { LAS bf16_t* qs = (LAS bf16_t*)lds; LAS bf16_t* ks = (LAS bf16_t*)(lds + TILE_B); LAS bf16_t* vT = (LAS bf16_t*)(lds + 2 * TILE_B); LAS bf16_t* CT = (LAS bf16_t*)(lds + 3 * TILE_B);
              LAS float* ar = (LAS float*)(lds + 4 * TILE_B);
              LAS float* a_li = ar, *a_lf = ar + 128, *a_b = ar + 256, *a_u = ar + 384, *a_M = ar + 512, *a_iw = ar + 640, *a_rs = ar + 768, *a_dn = ar + 896, *a_n = ar + 1024, *a_gt = ar + 1152;
              const float* gb = INP(I_MGB) + l * 16;
              for (int rep_ = 0; rep_ <= DUP_ML; ++rep_)
              for (int u = bid; u < 1088; u += G) { const int j = u % 34, h = (u / 34) & 3, b = (u / 136) & 3, dir = u / 544, sc = (dir * 4 + b) * 4 + h; const int rowbase = ml_rowbase(dir, b, j);
                if (j < 2 && !need_ctx) continue;
                __syncthreads();
                bf16x8 rq[4], rk[4], rv[4]; f32x4 rc[8];
#pragma unroll
                for (int i = 0; i < 4; ++i) { const int idx = tid + NTHREADS * i; { const int s = idx >> 4, c8 = (idx & 15) * 8; const int row = rowbase + (dir ? 127 - s : s);
                        rq[i] = *(const bf16x8*)(MLQK2 + (size_t)row * 1024 + h * 128 + c8); rk[i] = *(const bf16x8*)(MLQK2 + (size_t)row * 1024 + 512 + h * 128 + c8); }
                    { const int s = idx & 127, c8 = (idx >> 7) * 8; const int row = rowbase + (dir ? 127 - s : s); rv[i] = *(const bf16x8*)(MLV + (size_t)row * 512 + h * 128 + c8); } }
                { const float* src = CST + ((size_t)(sc * 34 + j)) * 16384;
#pragma unroll
                  for (int i = 0; i < 8; ++i) rc[i] = *(const f32x4*)(src + (tid + NTHREADS * i) * 4); }
                const float m_in = MIN_[sc * 34 + j];
                if (tid < 128) { const int row = rowbase + (dir ? 127 - tid : tid); const float* g = GATES + (size_t)row * 16;
                    a_li[tid] = g[dir * 4 + h] + gb[dir * 4 + h]; a_lf[tid] = logsigmoidf(g[(2 + dir) * 4 + h] + gb[(2 + dir) * 4 + h]);
                    a_n[tid] = MLN[((size_t)(sc * 34 + j)) * 128 + tid]; }
                __syncthreads();
                { float loc = 0.f; if (tid < 128) { loc = scan16_sum(a_lf, tid); if ((tid & 15) == 15) a_gt[tid >> 4] = loc; }
                  __syncthreads();
                  if (tid < 128) { const float sb = group_off_sum(a_gt, tid) + loc; a_b[tid] = sb; a_u[tid] = a_li[tid] - sb; } }
                __syncthreads();
                { float loc = 0.f; if (tid < 128) { loc = scan16_max(a_u, tid); if ((tid & 15) == 15) a_gt[8 + (tid >> 4)] = loc; }
                  __syncthreads();
                  if (tid < 128) { const float mx = fmaxf(m_in, fmaxf(group_off_max(a_gt + 8, tid), loc)); a_M[tid] = mx; a_iw[tid] = expf(m_in - mx); } }
#pragma unroll
                for (int i = 0; i < 4; ++i) { const int idx = tid + NTHREADS * i; { const int s = idx >> 4, c8 = (idx & 15) * 8; *(LAS bf16x8*)(qs + s * TP + c8) = rq[i]; *(LAS bf16x8*)(ks + s * TP + c8) = rk[i]; }
                    { const int s = idx & 127, c8 = (idx >> 7) * 8;
#pragma unroll
                      for (int e = 0; e < 8; ++e) vT[(c8 + e) * TP + s] = (bf16_t)rv[i][e]; } }
#pragma unroll
                for (int i = 0; i < 8; ++i) { const int idx = tid + NTHREADS * i, e = idx >> 5, d = (idx & 31) * 4; u32x2 w; w.x = cvtpk(rc[i].x, rc[i].y); w.y = cvtpk(rc[i].z, rc[i].w); *(LAS u32x2*)(CT + e * TP + d) = w; }
                __syncthreads();
                const int tb = wave & 3, eh = wave >> 2;
                float rsum = 0.f; f32x16 o[2];
#pragma unroll
                for (int et = 0; et < 2; ++et) { o[et] = f32x16{}; mma128(o[et], qs, 32 * tb, CT, 64 * eh + 32 * et, r32, hi);
#pragma unroll
                    for (int r = 0; r < 16; ++r) o[et][r] *= a_iw[32 * tb + crow(r, hi)]; }
                { const float Mt = a_M[32 * tb + r32];
#pragma unroll 1
                  for (int st = 0; st <= tb; ++st) { f32x16 p = {}; mma128(p, ks, 32 * st, qs, 32 * tb, r32, hi);
#pragma unroll
                    for (int r = 0; r < 16; ++r) { const int s = 32 * st + crow(r, hi); const float v = (s <= 32 * tb + r32) ? p[r] * expf(a_u[s] - Mt) : 0.f; p[r] = v; rsum += v; }
                    bf16x8 pa0, pa1; PK4(p, 0, pa0); PK4(p, 8, pa1);
#pragma unroll
                    for (int et = 0; et < 2; ++et) { const LAS bf16_t* vp = vT + (64 * eh + 32 * et + r32) * TP + 32 * st + 8 * hi;
                        o[et] = __builtin_amdgcn_mfma_f32_32x32x16_bf16(pa0, *(const LAS bf16x8*)(vp), o[et], 0, 0, 0);
                        o[et] = __builtin_amdgcn_mfma_f32_32x32x16_bf16(pa1, *(const LAS bf16x8*)(vp + 16), o[et], 0, 0, 0); } } }
                rsum += xor32_get(rsum, hi);
                if (eh == 0 && hi == 0) a_rs[32 * tb + r32] = rsum;
                __syncthreads();
                if (tid < 128) { float qn = 0.f;
#pragma unroll
                    for (int i = 0; i < 16; ++i) { const bf16x8 qv = *(const LAS bf16x8*)(qs + tid * TP + 8 * i); const f32x4 n0 = *(const LAS f32x4*)(a_n + 8 * i), n1 = *(const LAS f32x4*)(a_n + 8 * i + 4);
                        qn += bf2f_s(qv[0]) * n0.x + bf2f_s(qv[1]) * n0.y + bf2f_s(qv[2]) * n0.z + bf2f_s(qv[3]) * n0.w + bf2f_s(qv[4]) * n1.x + bf2f_s(qv[5]) * n1.y + bf2f_s(qv[6]) * n1.z + bf2f_s(qv[7]) * n1.w; }
                    const float den = a_iw[tid] * qn + a_rs[tid]; a_dn[tid] = 1.f / fmaxf(fabsf(den), expf(-(a_b[tid] + a_M[tid]))); }
                __syncthreads();
                { float* Hd = dir ? HB : HF;
#pragma unroll
                  for (int et = 0; et < 2; ++et)
#pragma unroll
                    for (int r = 0; r < 16; ++r) { const int t = 32 * tb + crow(r, hi); const int row = rowbase + (dir ? 127 - t : t);
                        Hd[(size_t)row * 512 + h * 128 + 64 * eh + 32 * et + r32] = o[et][r] * a_dn[t]; } }
              }
              __syncthreads(); }
        PH_END
        PH_BEGIN(8)
            { LAS float* ysm = (LAS float*)lds;
              const float* mg = INP(I_MIXG) + (size_t)l * 2048;
              const int ntile = need_ctx ? MT / 32 : ML / 32;
              for (int rp_ = 0; rp_ <= DUP_COMB; ++rp_)
              for (int tile = bid; tile < ntile; tile += G) { const int r0 = tile * 32;
                __syncthreads();
                { const bool isl = r0 < ML; const int b = isl ? r0 >> 12 : (r0 - ML) >> 8, t0 = isl ? r0 & 4095 : (r0 - ML) & 255; const float* src = isl ? YT + (size_t)b * 512 * 4096 + t0 : YTC + (size_t)b * 512 * 256 + t0; const int Ls = isl ? 4096 : 256;
                  for (int idx = tid; idx < 512 * 32; idx += NTHREADS) { const int c = idx >> 5, tt = idx & 31; ysm[c * 33 + tt] = src[(size_t)c * Ls + tt]; } }
                __syncthreads();
#pragma unroll 2
                for (int q = 0; q < 4; ++q) { const int tt = wave * 4 + q, r = r0 + tt; bf16_t* orow = ABUF + (size_t)r * DM;
                    { const bf16x8 a0 = *(const bf16x8*)(AO + (size_t)r * 1024 + lane * 8), a1 = *(const bf16x8*)(AO + (size_t)r * 1024 + 512 + lane * 8); float x[16], ss = 0.f;
#pragma unroll
                      for (int i = 0; i < 8; ++i) { x[i] = bf2f_s(a0[i]); x[8 + i] = bf2f_s(a1[i]); ss += x[i] * x[i] + x[8 + i] * x[8 + i]; }
                      const float rs = rsqrtf(wave_sum(ss) * (1.f / 1024.f) + EPS);
#pragma unroll
                      for (int hh = 0; hh < 2; ++hh) { const float* gp = mg + hh * 512 + lane * 8; u32x4 o;
                        o.x = cvtpk(x[hh * 8 + 0] * rs * gp[0], x[hh * 8 + 1] * rs * gp[1]); o.y = cvtpk(x[hh * 8 + 2] * rs * gp[2], x[hh * 8 + 3] * rs * gp[3]);
                        o.z = cvtpk(x[hh * 8 + 4] * rs * gp[4], x[hh * 8 + 5] * rs * gp[5]); o.w = cvtpk(x[hh * 8 + 6] * rs * gp[6], x[hh * 8 + 7] * rs * gp[7]);
                        *(u32x4*)(orow + hh * 512 + lane * 8) = o; } }
                    { float y[8], ss = 0.f;
#pragma unroll
                      for (int i = 0; i < 8; ++i) { y[i] = ysm[(lane + 64 * i) * 33 + tt]; ss += y[i] * y[i]; }
                      const float rs = rsqrtf(wave_sum(ss) * (1.f / 512.f) + EPS);
#pragma unroll
                      for (int i = 0; i < 8; ++i) orow[1024 + lane + 64 * i] = f2bf(y[i] * rs * mg[1024 + lane + 64 * i]); }
                    {
#pragma unroll
                      for (int hh = 0; hh < 4; ++hh) { const int c = hh * 128 + 2 * lane; const f32x2 f = *(const f32x2*)(HF + (size_t)r * 512 + c), bk = *(const f32x2*)(HB + (size_t)r * 512 + c);
                        const float v0 = f.x + bk.x, v1 = f.y + bk.y; const float rs = rsqrtf(wave_sum(v0 * v0 + v1 * v1) * (1.f / 128.f) + EPS);
                        const unsigned ow = *(const unsigned*)(MLO + (size_t)r * 512 + c); const float o0 = __uint_as_float(ow << 16), o1 = __uint_as_float(ow & 0xffff0000u);
                        const float g0 = mg[1536 + c], g1 = mg[1536 + c + 1];
                        *(unsigned*)(orow + 1536 + c) = cvtpk(v0 * rs * g0 / (1.f + __expf(-o0)), v1 * rs * g1 / (1.f + __expf(-o1))); } }
                }
              }
              __syncthreads(); }
        PH_END
        constexpr int Mrows = need_ctx ? MT : ML;
        PH_BEGIN(9)
            pg8::Gemm g{ABUF, WOUT, Mrows, DM, DM}; pg8::EpiResid<l, 2> E{(l == 0 ? INP(I_X) : (const float*)OUT), OUT, ws};
            if constexpr (need_ctx) { pg8::SplitCtxOrder S; S.init(G, bid, DM); pg8::gemm_phase<pg8::EpiResid<l, 2>, pg8::SplitCtxOrder, true, true>(lds, g, S, E, tid); }
            else { pg8::StaticOrder S; S.init(Mrows, DM, G, bid, DM); pg8::gemm_phase<pg8::EpiResid<l, 2>, pg8::StaticOrder, true, true>(lds, g, S, E, tid); }
        PH_END
        PH_BEGIN(10)
            NORM_ROWS(l, INP(I_N2G) + l * DM, 3, Mrows, OUT);
        PH_END
        PH_BEGIN(11)
            pg8::Gemm g{ABUF, W1, Mrows, 2 * FFH, DM}; pg8::StaticOrder S; S.init(Mrows, 2 * FFH, G, bid, DM); pg8::EpiSwiglu E{ws};
            for (int rp_ = 0; rp_ <= DUP_W1; ++rp_) pg8::gemm_phase<pg8::EpiSwiglu, pg8::StaticOrder, true, true>(lds, g, S, E, tid);
        PH_END
        PH_BEGIN(12)
            pg8::Gemm g{HID, W2, Mrows, DM, FFH}; pg8::EpiResid<l, 5> E{(const float*)OUT, OUT, ws};
            if constexpr (need_ctx) { pg8::SplitCtxOrder S; S.init(G, bid, FFH); pg8::gemm_phase<pg8::EpiResid<l, 5>, pg8::SplitCtxOrder, true, true>(lds, g, S, E, tid); }
            else { pg8::StaticOrder S; S.init(Mrows, DM, G, bid, FFH); pg8::gemm_phase<pg8::EpiResid<l, 5>, pg8::StaticOrder, true, true>(lds, g, S, E, tid); }
        PH_END


    }
    { constexpr int l = 1; constexpr bool need_ctx = (l == 0);
        PH_BEGIN(2)
            NORM_ROWS(l, INP(I_N1G) + l * DM, 0, MT, (l == 0 ? (float*)INP(I_X) : OUT));
            if (l == 1) { __syncthreads(); CONVERT_WEIGHTS(1); __syncthreads(); BUILD_FILTERS(1); }
        PH_END
        PH_BEGIN(3)
            pg8::Gemm g{ABUF, WIN, MT, NINP, DM}; pg8::EpiInProj E{ws};
            if constexpr (l == 0) { pg8::StaticOrder S; S.init(MT, NINP, G, bid, DM); for (int rp_ = 0; rp_ <= DUP_INPROJ; ++rp_) pg8::gemm_phase<pg8::EpiInProj, pg8::StaticOrder, true, true>(lds, g, S, E, tid); }
            else { pg8::InProjL1Order S; S.init(G, bid, DM); for (int rp_ = 0; rp_ <= DUP_INPROJ; ++rp_) pg8::gemm_phase<pg8::EpiInProj, pg8::InProjL1Order, true, true>(lds, g, S, E, tid); }
        PH_END
        PH_BEGIN(4)
            { pg8::Gemm g{CQ, WUQ, MT, 1536, 512, CKV, WUKV}; pg8::DualUpOrder S; S.init(G, bid); pg8::EpiUp E{ws};
              for (int rp_ = 0; rp_ <= DUP_UP; ++rp_) pg8::gemm_phase<pg8::EpiUp, pg8::DualUpOrder, true, true>(lds, g, S, E, tid); }
            { const float* cw = INP(I_MCW) + (size_t)l * 3 * 1024; const float* cb = INP(I_MCB) + (size_t)l * 1024;
              for (int rp_ = 0; rp_ <= DUP_M0; ++rp_)
              for (long e = gtid; e < (long)MT * 128; e += GT) { const int r = (int)(e >> 7), c8 = (int)(e & 127) * 8;
                int t, L; if (r < ML) { t = r & 4095; L = SEQ; } else { t = (r - ML) & 255; L = CTXL; }
                const bf16x8 z = {0, 0, 0, 0, 0, 0, 0, 0};
                const bf16x8 xm = *(const bf16x8*)(MLQK + (size_t)r * 1024 + c8), xp = t > 0 ? *(const bf16x8*)(MLQK + (size_t)(r - 1) * 1024 + c8) : z, xn = t < L - 1 ? *(const bf16x8*)(MLQK + (size_t)(r + 1) * 1024 + c8) : z;
                float y[8]; const float qs = c8 < 512 ? 0.08838834764831845f : 1.f;
#pragma unroll
                for (int i = 0; i < 8; ++i) { const int c = c8 + i; y[i] = siluf(cb[c] + cw[c] * bf2f_s(xp[i]) + cw[1024 + c] * bf2f_s(xm[i]) + cw[2048 + c] * bf2f_s(xn[i])) * qs; }
                u32x4 o; o.x = cvtpk(y[0], y[1]); o.y = cvtpk(y[2], y[3]); o.z = cvtpk(y[4], y[5]); o.w = cvtpk(y[6], y[7]); *(u32x4*)(MLQK2 + (size_t)r * 1024 + c8) = o; } }
            { LAS f32x2* X = (LAS f32x2*)lds; LAS f32x2* Gs = (LAS f32x2*)(lds + FFT_SLOTS * 8); LAS float* w3s = (LAS float*)(lds + 2 * FFT_SLOTS * 8);
              const float* hcw = INP(I_HCW) + (size_t)l * 3 * 1536; const float* hcb = INP(I_HCB) + (size_t)l * 1536;
              const float* w3 = INP(I_HW3) + (size_t)l * 64 * 2048; const float* dec = INP(I_HDEC) + (size_t)l * 2048; const float* skip = INP(I_HSKIP) + (size_t)l * 1024;
              const float* H2 = H2L + (size_t)l * SEQ * 64;
              FftTw ftw; fft_load_tw(ftw, TW, tid);
              for (int rep_ = 0; rep_ <= DUP_HY; ++rep_)
              for (int c0 = bid; c0 < 512; c0 += G) { int c = c0; asm volatile("" : "+s"(c));
                const float vw0 = hcw[c], vw1 = hcw[1536 + c], vw2 = hcw[3072 + c], vbb = hcb[c];
                for (int n = 0; n < 2; ++n) {
                    const int of = n * 1024 + c, ob = n * 1024 + 512 + c;
                    __syncthreads();
                    { const float* ff = FILT + (size_t)of * 4096; const float* fb = FILT + (size_t)ob * 4096;
#pragma unroll 2
                      for (int q = 0; q < 8; ++q) { const int t = tid + 512 * q; Gs[fphys(t)] = (f32x2){ff[t], 0.f};
                        if (t == 0) Gs[fphys(4096)] = (f32x2){0.f, 0.f}; else Gs[fphys(8192 - t)] = (f32x2){fb[t], 0.f}; } }
                    __syncthreads();
                    fft_fwd_full(Gs, ftw, tid);
                    const float sk = skip[n * 512 + c];
                    const int gch = (n + 1) * 512 + c;
                    const float gw0 = hcw[gch], gw1 = hcw[1536 + gch], gw2 = hcw[3072 + gch], gbb = hcb[gch];
#pragma unroll 1
                    for (int bp = 0; bp < 2; ++bp) {
                        const bf16_t* u0 = HYT + ((size_t)((2 * bp) * 1536 + c)) * 4096; const bf16_t* u1 = HYT + ((size_t)((2 * bp + 1) * 1536 + c)) * 4096;
                        float* y0p = YT + ((size_t)((2 * bp) * 512 + c)) * 4096; float* y1p = YT + ((size_t)((2 * bp + 1) * 512 + c)) * 4096;
                        const bf16_t* g0p = HYT + ((size_t)((2 * bp) * 1536 + gch)) * 4096; const bf16_t* g1p = HYT + ((size_t)((2 * bp + 1) * 1536 + gch)) * 4096;
                        f32x2 zq[8], gq[8];
#pragma unroll
                        for (int q = 0; q < 8; ++q) { const int t = tid + 512 * q;
                            if (n == 0) { zq[q].x = conv3(u0, t, SEQ, vw0, vw1, vw2, vbb); zq[q].y = conv3(u1, t, SEQ, vw0, vw1, vw2, vbb); } else { zq[q].x = y0p[t]; zq[q].y = y1p[t]; }
                            gq[q].x = conv3(g0p, t, SEQ, gw0, gw1, gw2, gbb); gq[q].y = conv3(g1p, t, SEQ, gw0, gw1, gw2, gbb); }
#pragma unroll
                        for (int q = 0; q < 8; ++q) { const int t = tid + 512 * q; X[fphys(t)] = zq[q]; X[fphys(4096 + t)] = (f32x2){0.f, 0.f}; }
                        __syncthreads();
                        fft_conv(X, Gs, ftw, tid);
#pragma unroll
                        for (int q = 0; q < 8; ++q) { const int t = tid + 512 * q; const f32x2 y = X[fphys(t)] * (1.f / 8192.f);
                            y0p[t] = gq[q].x * (y.x + sk * zq[q].x); y1p[t] = gq[q].y * (y.y + sk * zq[q].y); }
                        __syncthreads();
                    }
                }
              }
              if (need_ctx) {
                LAS float* hf = (LAS float*)lds;
                LAS float* zs = (LAS float*)(lds + 4096);
                LAS float* w3c = (LAS float*)(lds + 8192);
                const float* H2c = H2C + (size_t)l * CTXL * 64;
                for (int c = bid; c < 512; c += G) {
                    __syncthreads();
                    if (tid < 256) { const int f = tid >> 6, i = tid & 63; w3c[tid] = w3[i * 2048 + (f >> 1) * 1024 + (f & 1) * 512 + c]; }
                    __syncthreads();
                    for (int e = tid; e < 1024; e += NTHREADS) { const int f = e >> 8, t = e & 255; const int o = (f >> 1) * 1024 + (f & 1) * 512 + c; float a = 0.f;
                        for (int i = 0; i < 64; ++i) a += H2c[t * 64 + i] * w3c[f * 64 + i];
                        hf[e] = a * (expf(-((float)t * (1.f / 256.f)) * dec[o]) + 0.05f); }
                    const int b = tid >> 7; float zv[2], zc[2];
#pragma unroll
                    for (int q = 0; q < 2; ++q) { const int t = (tid & 127) + 128 * q; zv[q] = conv3(HYTC + ((size_t)(b * 1536 + c)) * 256, t, CTXL, hcw[c], hcw[1536 + c], hcw[3072 + c], hcb[c]); zs[b * 256 + t] = zv[q]; }
                    __syncthreads();
                    for (int n = 0; n < 2; ++n) { const LAS float* gf = hf + n * 512; const LAS float* gb = hf + n * 512 + 256; const int gch = (n + 1) * 512 + c;
#pragma unroll
                        for (int q = 0; q < 2; ++q) { const int t = (tid & 127) + 128 * q; float y = 0.f;
                            for (int s = 0; s <= t; ++s) y += zs[b * 256 + s] * gf[t - s];
                            for (int s = t + 1; s < 256; ++s) y += zs[b * 256 + s] * gb[s - t];
                            const float gate = conv3(HYTC + ((size_t)(b * 1536 + gch)) * 256, t, CTXL, hcw[gch], hcw[1536 + gch], hcw[3072 + gch], hcb[gch]);
                            zc[q] = gate * (y + skip[n * 512 + c] * zv[q]); }
                        __syncthreads();
#pragma unroll
                        for (int q = 0; q < 2; ++q) { const int t = (tid & 127) + 128 * q; zv[q] = zc[q]; if (n == 0) zs[b * 256 + t] = zc[q]; else YTC[((size_t)(b * 512 + c)) * 256 + t] = zc[q]; }
                        __syncthreads(); }
                }
              }
            }
        PH_END
        PH_BEGIN(5)
            { LAS f32x2* rtab = (LAS f32x2*)lds;
              __syncthreads();
              for (int e = tid; e < 1024; e += NTHREADS) { const float ang = (float)(e >> 4) * powf(10000.f, -(float)(e & 15) * (1.f / 16.f)); rtab[e] = (f32x2){cosf(ang), sinf(ang)}; }
              __syncthreads();
              const int l16 = lane & 15, ts = lane >> 4; const bool xhi = l16 >= 8, rowax = (l16 & 7) < 4; const int f0 = 4 * (l16 & 3);
              const float* qg = INP(I_QN) + l * 192; const float* kg = INP(I_KN) + l * 192;
              float qgn[8], kgn[8], qgr[4], kgr[4];
#pragma unroll
              for (int i = 0; i < 8; ++i) { qgn[i] = qg[8 * l16 + i]; kgn[i] = kg[8 * l16 + i]; }
#pragma unroll
              for (int i = 0; i < 4; ++i) { qgr[i] = qg[128 + 4 * l16 + i]; kgr[i] = kg[128 + 4 * l16 + i]; }
#define RED16(v) do { v += swz_xor<1>(v); v += swz_xor<2>(v); v += swz_xor<4>(v); v += swz_xor<8>(v); } while (0)
              for (int rp_ = 0; rp_ <= DUP_POST; ++rp_)
              for (int r0 = gw * 4; r0 < MT; r0 += NGW * 4) { const int r = r0 + ts;
                int b, t, key; const bool isl = r < ML; if (isl) { b = r >> 12; t = r & 4095; key = CTXL + t; } else { b = (r - ML) >> 8; t = (r - ML) & 255; key = t; }
                const bf16_t* qrow = QRAW + (size_t)r * 1536; const bf16_t* kvrow = KVRAW + (size_t)r * 2048;
                bf16x8 cqv[4], ckv4[4], qn_[8], kn_[8], vn_[8]; u32x2 qr_[8];
#pragma unroll
                for (int i = 0; i < 4; ++i) { cqv[i] = *(const bf16x8*)(CQ + (size_t)r * 512 + 32 * l16 + 8 * i); ckv4[i] = *(const bf16x8*)(CKV + (size_t)r * 512 + 32 * l16 + 8 * i); }
                const f32x4 krv = *(const f32x4*)(KROPE + (size_t)r * 64 + 4 * l16);
#pragma unroll
                for (int h = 0; h < 8; ++h) { qn_[h] = *(const bf16x8*)(qrow + h * 192 + 8 * l16); qr_[h] = *(const u32x2*)(qrow + h * 192 + 128 + 4 * l16);
                    kn_[h] = *(const bf16x8*)(kvrow + h * 256 + 8 * l16); vn_[h] = *(const bf16x8*)(kvrow + h * 256 + 128 + 8 * l16); }
                float ssq = 0.f, sskv = 0.f;
#pragma unroll
                for (int i = 0; i < 4; ++i)
#pragma unroll
                    for (int e = 0; e < 8; ++e) { const float x = bf2f_s(cqv[i][e]), y = bf2f_s(ckv4[i][e]); ssq += x * x; sskv += y * y; }
                RED16(ssq); RED16(sskv);
                const float rsq = rsqrtf(ssq * (1.f / 512.f) + EPS), rskv = rsqrtf(sskv * (1.f / 512.f) + EPS);
                float cs[4], sn[4];
#pragma unroll
                for (int i = 0; i < 4; ++i) { cs[i] = 1.f; sn[i] = 0.f; }
                if (isl) { const int pos = rowax ? (t >> 6) : (t & 63);
#pragma unroll
                    for (int i = 0; i < 4; ++i) { const f32x2 e = rtab[pos * 16 + f0 + i]; cs[i] = e.x; sn[i] = e.y; } }
                float krss = krv.x * krv.x + krv.y * krv.y + krv.z * krv.z + krv.w * krv.w;
#pragma unroll
                for (int h = 0; h < 8; ++h) {
                    float xn[8], xr[4]; float ss = 0.f;
#pragma unroll
                    for (int i = 0; i < 8; ++i) { xn[i] = bf2f_s(qn_[h][i]) * rsq; ss += xn[i] * xn[i]; }
                    xr[0] = __uint_as_float(qr_[h].x << 16) * rsq; xr[1] = __uint_as_float(qr_[h].x & 0xffff0000u) * rsq; xr[2] = __uint_as_float(qr_[h].y << 16) * rsq; xr[3] = __uint_as_float(qr_[h].y & 0xffff0000u) * rsq;
#pragma unroll
                    for (int i = 0; i < 4; ++i) ss += xr[i] * xr[i];
                    RED16(ss);
                    float rn = rsqrtf(ss * (1.f / 192.f) + EPS);
                    if (isl || need_ctx) {
                        bf16_t* qo = isl ? QB + ((size_t)((b * 8 + h) * SEQ + t)) * 192 : QCB + ((size_t)((b * 8 + h) * CTXL + t)) * 192;
                        u32x4 w; w.x = cvtpk(xn[0] * rn * qgn[0], xn[1] * rn * qgn[1]); w.y = cvtpk(xn[2] * rn * qgn[2], xn[3] * rn * qgn[3]); w.z = cvtpk(xn[4] * rn * qgn[4], xn[5] * rn * qgn[5]); w.w = cvtpk(xn[6] * rn * qgn[6], xn[7] * rn * qgn[7]);
                        *(u32x4*)(qo + 8 * l16) = w;
                        float yo[4];
#pragma unroll
                        for (int i = 0; i < 4; ++i) { const float v = xr[i] * rn * qgr[i]; const float pr = swz_xor<8>(v); yo[i] = xhi ? v * cs[i] + pr * sn[i] : v * cs[i] - pr * sn[i]; }
                        u32x2 w2; w2.x = cvtpk(yo[0], yo[1]); w2.y = cvtpk(yo[2], yo[3]); *(u32x2*)(qo + 128 + 4 * l16) = w2; }
                    float yn[8]; ss = krss;
#pragma unroll
                    for (int i = 0; i < 8; ++i) { yn[i] = bf2f_s(kn_[h][i]) * rskv; ss += yn[i] * yn[i]; }
                    RED16(ss);
                    rn = rsqrtf(ss * (1.f / 192.f) + EPS);
                    { bf16_t* ko = KB + ((size_t)((b * 8 + h) * NKEY + key)) * 192;
                      u32x4 w; w.x = cvtpk(yn[0] * rn * kgn[0], yn[1] * rn * kgn[1]); w.y = cvtpk(yn[2] * rn * kgn[2], yn[3] * rn * kgn[3]); w.z = cvtpk(yn[4] * rn * kgn[4], yn[5] * rn * kgn[5]); w.w = cvtpk(yn[6] * rn * kgn[6], yn[7] * rn * kgn[7]);
                      *(u32x4*)(ko + 8 * l16) = w;
                      const float kr4[4] = {krv.x, krv.y, krv.z, krv.w}; float yo[4];
#pragma unroll
                      for (int i = 0; i < 4; ++i) { const float v = kr4[i] * rn * kgr[i]; const float pr = swz_xor<8>(v); yo[i] = xhi ? v * cs[i] + pr * sn[i] : v * cs[i] - pr * sn[i]; }
                      u32x2 w2; w2.x = cvtpk(yo[0], yo[1]); w2.y = cvtpk(yo[2], yo[3]); *(u32x2*)(ko + 128 + 4 * l16) = w2;
                      bf16_t* vo = VB + ((size_t)((b * 8 + h) * NKEY + key)) * 128;
                      u32x4 wv; wv.x = cvtpk(bf2f_s(vn_[h][0]) * rskv, bf2f_s(vn_[h][1]) * rskv); wv.y = cvtpk(bf2f_s(vn_[h][2]) * rskv, bf2f_s(vn_[h][3]) * rskv);
                      wv.z = cvtpk(bf2f_s(vn_[h][4]) * rskv, bf2f_s(vn_[h][5]) * rskv); wv.w = cvtpk(bf2f_s(vn_[h][6]) * rskv, bf2f_s(vn_[h][7]) * rskv);
                      *(u32x4*)(vo + 8 * l16) = wv; }
                }
              }
#undef RED16
              __syncthreads(); }
            { LAS bf16_t* kwT = (LAS bf16_t*)lds; LAS bf16_t* vT = (LAS bf16_t*)(lds + TILE_B); LAS float* ar = (LAS float*)(lds + 4 * TILE_B);
              LAS float* a_li = ar, *a_lf = ar + 128, *a_b = ar + 256, *a_g = ar + 384, *a_w = ar + 512, *a_gt = ar + 640;
              const float* gb = INP(I_MGB) + l * 16;
              for (int rep_ = 0; rep_ <= DUP_ML; ++rep_)
              for (int u = bid; u < 1088; u += G) { const int j = u % 34, h = (u / 34) & 3, b = (u / 136) & 3, dir = u / 544, sc = (dir * 4 + b) * 4 + h; const int rowbase = ml_rowbase(dir, b, j);
                __syncthreads();
                bf16x8 kk[4], vv[4];
#pragma unroll
                for (int i = 0; i < 4; ++i) { const int idx = tid + NTHREADS * i, s = idx & 127, c8 = (idx >> 7) * 8; const int row = rowbase + (dir ? 127 - s : s);
                    kk[i] = *(const bf16x8*)(MLQK2 + (size_t)row * 1024 + 512 + h * 128 + c8); vv[i] = *(const bf16x8*)(MLV + (size_t)row * 512 + h * 128 + c8); }
                if (tid < 128) { const int row = rowbase + (dir ? 127 - tid : tid); const float* g = GATES + (size_t)row * 16;
                    a_li[tid] = g[dir * 4 + h] + gb[dir * 4 + h]; a_lf[tid] = logsigmoidf(g[(2 + dir) * 4 + h] + gb[(2 + dir) * 4 + h]); }
                __syncthreads();
                { float loc = 0.f; if (tid < 128) { loc = scan16_sum(a_lf, tid); if ((tid & 15) == 15) a_gt[tid >> 4] = loc; }
                  __syncthreads();
                  if (tid < 128) a_b[tid] = group_off_sum(a_gt, tid) + loc; }
                __syncthreads();
                if (tid < 128) a_g[tid] = a_b[127] - a_b[tid] + a_li[tid];
                __syncthreads();
                if (tid < 128) { float mx = a_g[0]; for (int i = 1; i < 128; ++i) mx = fmaxf(mx, a_g[i]); a_w[tid] = expf(a_g[tid] - mx); if (tid == 0) { MLOC[sc * 34 + j] = mx; BLAST[sc * 34 + j] = a_b[127]; } }
                __syncthreads();
#pragma unroll
                for (int q = 0; q < 4; ++q) { const int idx = tid + NTHREADS * q, s = idx & 127, c8 = (idx >> 7) * 8; const float wsv = a_w[s];
#pragma unroll
                    for (int i = 0; i < 8; ++i) { kwT[(c8 + i) * TP + s] = f2bf(bf2f_s(kk[q][i]) * wsv); vT[(c8 + i) * TP + s] = (bf16_t)vv[q][i]; } }
                __syncthreads();
                { const int nb = wave & 3, mh = wave >> 2; float* dst = CST + ((size_t)(sc * 34 + j)) * 16384;
#pragma unroll
                  for (int mt = 0; mt < 2; ++mt) { f32x16 acc = {}; mma128(acc, vT, 64 * mh + 32 * mt, kwT, 32 * nb, r32, hi);
#pragma unroll
                    for (int r = 0; r < 16; ++r) dst[(64 * mh + 32 * mt + crow(r, hi)) * 128 + 32 * nb + r32] = acc[r]; } }
                if (tid < 128) { float s = 0.f;
#pragma unroll
                    for (int i = 0; i < 16; ++i) { const bf16x8 kv = *(const LAS bf16x8*)(kwT + tid * TP + 8 * i);
#pragma unroll
                        for (int e = 0; e < 8; ++e) s += bf2f_s(kv[e]); }
                    MLN[((size_t)(sc * 34 + j)) * 128 + tid] = s; }
              }
              __syncthreads(); }
        PH_END
        PH_BEGIN(6)
            { const int nlat = NB * 8 * 16, nunits = nlat + (need_ctx ? NB * 8 : 0);
              for (int rp_ = 0; rp_ <= DUP_ATT; ++rp_)
              for (int u = bid; u < nunits; u += G) {
                const bf16_t* qp; bf16_t* op; int seq, bh;
                if (u < nlat) { const int xcd = u & 7, idx = ((u & 255) >> 3) + 32 * (u >> 8), qb = idx & 15; bh = xcd * 4 + (idx >> 4); const int h = bh & 7, b = bh >> 3;     qp = QB + ((size_t)(bh * SEQ + qb * 256)) * 192; op = AO + ((size_t)(b * SEQ + qb * 256)) * 1024 + h * 128; seq = NKEY; }
                else { const int v = u - nlat, h = v & 7, b = v >> 3; bh = b * 8 + h; qp = QCB + ((size_t)(bh * CTXL)) * 192; op = AO + ((size_t)(ML + b * CTXL)) * 1024 + h * 128; seq = CTXL; }
                att::attn_body(qp, KB + (size_t)bh * NKEY * 192, VB + (size_t)bh * NKEY * 128, op, 1024, seq, (char*)lds_raw, tid);
              } }
            for (long e = gtid; e < 131072 + 1024; e += GT) {
                int sc; float* base; int stride; bool lead = false;
                if (e < 131072) { sc = (int)(e >> 12); base = CST + (size_t)sc * 34 * 16384 + (e & 4095) * 4; stride = 16384; lead = (e & 4095) == 0; }
                else { const int e2 = (int)(e - 131072); sc = e2 >> 5; base = MLN + (size_t)sc * 34 * 128 + (e2 & 31) * 4; stride = 128; }
                float m = 0.f; f32x4 st = {0.f, 0.f, 0.f, 0.f};
#pragma unroll 1
                for (int jb = 0; jb < 34; jb += 17) { f32x4 tmp[17];
#pragma unroll
                    for (int k = 0; k < 17; ++k) tmp[k] = *(const f32x4*)(base + (size_t)(jb + k) * stride);
#pragma unroll
                    for (int k = 0; k < 17; ++k) { const int j = jb + k; const float ml = MLOC[sc * 34 + j], bl = BLAST[sc * 34 + j]; *(f32x4*)(base + (size_t)j * stride) = st;
                        const float mnew = fmaxf(bl + m, ml), a = expf(bl + m - mnew), wg = expf(ml - mnew); st = st * a + tmp[k] * wg; if (lead) MIN_[sc * 34 + j] = m; m = mnew; } }
            }
        PH_END
        PH_BEGIN(7)
            { LAS bf16_t* qs = (LAS bf16_t*)lds; LAS bf16_t* ks = (LAS bf16_t*)(lds + TILE_B); LAS bf16_t* vT = (LAS bf16_t*)(lds + 2 * TILE_B); LAS bf16_t* CT = (LAS bf16_t*)(lds + 3 * TILE_B);
              LAS float* ar = (LAS float*)(lds + 4 * TILE_B);
              LAS float* a_li = ar, *a_lf = ar + 128, *a_b = ar + 256, *a_u = ar + 384, *a_M = ar + 512, *a_iw = ar + 640, *a_rs = ar + 768, *a_dn = ar + 896, *a_n = ar + 1024, *a_gt = ar + 1152;
              const float* gb = INP(I_MGB) + l * 16;
              for (int rep_ = 0; rep_ <= DUP_ML; ++rep_)
              for (int u = bid; u < 1088; u += G) { const int j = u % 34, h = (u / 34) & 3, b = (u / 136) & 3, dir = u / 544, sc = (dir * 4 + b) * 4 + h; const int rowbase = ml_rowbase(dir, b, j);
                if (j < 2 && !need_ctx) continue;
                __syncthreads();
                bf16x8 rq[4], rk[4], rv[4]; f32x4 rc[8];
#pragma unroll
                for (int i = 0; i < 4; ++i) { const int idx = tid + NTHREADS * i; { const int s = idx >> 4, c8 = (idx & 15) * 8; const int row = rowbase + (dir ? 127 - s : s);
                        rq[i] = *(const bf16x8*)(MLQK2 + (size_t)row * 1024 + h * 128 + c8); rk[i] = *(const bf16x8*)(MLQK2 + (size_t)row * 1024 + 512 + h * 128 + c8); }
                    { const int s = idx & 127, c8 = (idx >> 7) * 8; const int row = rowbase + (dir ? 127 - s : s); rv[i] = *(const bf16x8*)(MLV + (size_t)row * 512 + h * 128 + c8); } }
                { const float* src = CST + ((size_t)(sc * 34 + j)) * 16384;
#pragma unroll
                  for (int i = 0; i < 8; ++i) rc[i] = *(const f32x4*)(src + (tid + NTHREADS * i) * 4); }
                const float m_in = MIN_[sc * 34 + j];
                if (tid < 128) { const int row = rowbase + (dir ? 127 - tid : tid); const float* g = GATES + (size_t)row * 16;
                    a_li[tid] = g[dir * 4 + h] + gb[dir * 4 + h]; a_lf[tid] = logsigmoidf(g[(2 + dir) * 4 + h] + gb[(2 + dir) * 4 + h]);
                    a_n[tid] = MLN[((size_t)(sc * 34 + j)) * 128 + tid]; }
                __syncthreads();
                { float loc = 0.f; if (tid < 128) { loc = scan16_sum(a_lf, tid); if ((tid & 15) == 15) a_gt[tid >> 4] = loc; }
                  __syncthreads();
                  if (tid < 128) { const float sb = group_off_sum(a_gt, tid) + loc; a_b[tid] = sb; a_u[tid] = a_li[tid] - sb; } }
                __syncthreads();
                { float loc = 0.f; if (tid < 128) { loc = scan16_max(a_u, tid); if ((tid & 15) == 15) a_gt[8 + (tid >> 4)] = loc; }
                  __syncthreads();
                  if (tid < 128) { const float mx = fmaxf(m_in, fmaxf(group_off_max(a_gt + 8, tid), loc)); a_M[tid] = mx; a_iw[tid] = expf(m_in - mx); } }
#pragma unroll
                for (int i = 0; i < 4; ++i) { const int idx = tid + NTHREADS * i; { const int s = idx >> 4, c8 = (idx & 15) * 8; *(LAS bf16x8*)(qs + s * TP + c8) = rq[i]; *(LAS bf16x8*)(ks + s * TP + c8) = rk[i]; }
                    { const int s = idx & 127, c8 = (idx >> 7) * 8;
#pragma unroll
                      for (int e = 0; e < 8; ++e) vT[(c8 + e) * TP + s] = (bf16_t)rv[i][e]; } }
#pragma unroll
                for (int i = 0; i < 8; ++i) { const int idx = tid + NTHREADS * i, e = idx >> 5, d = (idx & 31) * 4; u32x2 w; w.x = cvtpk(rc[i].x, rc[i].y); w.y = cvtpk(rc[i].z, rc[i].w); *(LAS u32x2*)(CT + e * TP + d) = w; }
                __syncthreads();
                const int tb = wave & 3, eh = wave >> 2;
                float rsum = 0.f; f32x16 o[2];
#pragma unroll
                for (int et = 0; et < 2; ++et) { o[et] = f32x16{}; mma128(o[et], qs, 32 * tb, CT, 64 * eh + 32 * et, r32, hi);
#pragma unroll
                    for (int r = 0; r < 16; ++r) o[et][r] *= a_iw[32 * tb + crow(r, hi)]; }
                { const float Mt = a_M[32 * tb + r32];
#pragma unroll 1
                  for (int st = 0; st <= tb; ++st) { f32x16 p = {}; mma128(p, ks, 32 * st, qs, 32 * tb, r32, hi);
#pragma unroll
                    for (int r = 0; r < 16; ++r) { const int s = 32 * st + crow(r, hi); const float v = (s <= 32 * tb + r32) ? p[r] * expf(a_u[s] - Mt) : 0.f; p[r] = v; rsum += v; }
                    bf16x8 pa0, pa1; PK4(p, 0, pa0); PK4(p, 8, pa1);
#pragma unroll
                    for (int et = 0; et < 2; ++et) { const LAS bf16_t* vp = vT + (64 * eh + 32 * et + r32) * TP + 32 * st + 8 * hi;
                        o[et] = __builtin_amdgcn_mfma_f32_32x32x16_bf16(pa0, *(const LAS bf16x8*)(vp), o[et], 0, 0, 0);
                        o[et] = __builtin_amdgcn_mfma_f32_32x32x16_bf16(pa1, *(const LAS bf16x8*)(vp + 16), o[et], 0, 0, 0); } } }
                rsum += xor32_get(rsum, hi);
                if (eh == 0 && hi == 0) a_rs[32 * tb + r32] = rsum;
                __syncthreads();
                if (tid < 128) { float qn = 0.f;
#pragma unroll
                    for (int i = 0; i < 16; ++i) { const bf16x8 qv = *(const LAS bf16x8*)(qs + tid * TP + 8 * i); const f32x4 n0 = *(const LAS f32x4*)(a_n + 8 * i), n1 = *(const LAS f32x4*)(a_n + 8 * i + 4);
                        qn += bf2f_s(qv[0]) * n0.x + bf2f_s(qv[1]) * n0.y + bf2f_s(qv[2]) * n0.z + bf2f_s(qv[3]) * n0.w + bf2f_s(qv[4]) * n1.x + bf2f_s(qv[5]) * n1.y + bf2f_s(qv[6]) * n1.z + bf2f_s(qv[7]) * n1.w; }
                    const float den = a_iw[tid] * qn + a_rs[tid]; a_dn[tid] = 1.f / fmaxf(fabsf(den), expf(-(a_b[tid] + a_M[tid]))); }
                __syncthreads();
                { float* Hd = dir ? HB : HF;
#pragma unroll
                  for (int et = 0; et < 2; ++et)
#pragma unroll
                    for (int r = 0; r < 16; ++r) { const int t = 32 * tb + crow(r, hi); const int row = rowbase + (dir ? 127 - t : t);
                        Hd[(size_t)row * 512 + h * 128 + 64 * eh + 32 * et + r32] = o[et][r] * a_dn[t]; } }
              }
              __syncthreads(); }
        PH_END
        PH_BEGIN(8)
            { LAS float* ysm = (LAS float*)lds;
              const float* mg = INP(I_MIXG) + (size_t)l * 2048;
              const int ntile = need_ctx ? MT / 32 : ML / 32;
              for (int rp_ = 0; rp_ <= DUP_COMB; ++rp_)
              for (int tile = bid; tile < ntile; tile += G) { const int r0 = tile * 32;
                __syncthreads();
                { const bool isl = r0 < ML; const int b = isl ? r0 >> 12 : (r0 - ML) >> 8, t0 = isl ? r0 & 4095 : (r0 - ML) & 255; const float* src = isl ? YT + (size_t)b * 512 * 4096 + t0 : YTC + (size_t)b * 512 * 256 + t0; const int Ls = isl ? 4096 : 256;
                  for (int idx = tid; idx < 512 * 32; idx += NTHREADS) { const int c = idx >> 5, tt = idx & 31; ysm[c * 33 + tt] = src[(size_t)c * Ls + tt]; } }
                __syncthreads();
#pragma unroll 2
                for (int q = 0; q < 4; ++q) { const int tt = wave * 4 + q, r = r0 + tt; bf16_t* orow = ABUF + (size_t)r * DM;
                    { const bf16x8 a0 = *(const bf16x8*)(AO + (size_t)r * 1024 + lane * 8), a1 = *(const bf16x8*)(AO + (size_t)r * 1024 + 512 + lane * 8); float x[16], ss = 0.f;
#pragma unroll
                      for (int i = 0; i < 8; ++i) { x[i] = bf2f_s(a0[i]); x[8 + i] = bf2f_s(a1[i]); ss += x[i] * x[i] + x[8 + i] * x[8 + i]; }
                      const float rs = rsqrtf(wave_sum(ss) * (1.f / 1024.f) + EPS);
#pragma unroll
                      for (int hh = 0; hh < 2; ++hh) { const float* gp = mg + hh * 512 + lane * 8; u32x4 o;
                        o.x = cvtpk(x[hh * 8 + 0] * rs * gp[0], x[hh * 8 + 1] * rs * gp[1]); o.y = cvtpk(x[hh * 8 + 2] * rs * gp[2], x[hh * 8 + 3] * rs * gp[3]);
                        o.z = cvtpk(x[hh * 8 + 4] * rs * gp[4], x[hh * 8 + 5] * rs * gp[5]); o.w = cvtpk(x[hh * 8 + 6] * rs * gp[6], x[hh * 8 + 7] * rs * gp[7]);
                        *(u32x4*)(orow + hh * 512 + lane * 8) = o; } }
                    { float y[8], ss = 0.f;
#pragma unroll
                      for (int i = 0; i < 8; ++i) { y[i] = ysm[(lane + 64 * i) * 33 + tt]; ss += y[i] * y[i]; }
                      const float rs = rsqrtf(wave_sum(ss) * (1.f / 512.f) + EPS);
#pragma unroll
                      for (int i = 0; i < 8; ++i) orow[1024 + lane + 64 * i] = f2bf(y[i] * rs * mg[1024 + lane + 64 * i]); }
                    {
#pragma unroll
                      for (int hh = 0; hh < 4; ++hh) { const int c = hh * 128 + 2 * lane; const f32x2 f = *(const f32x2*)(HF + (size_t)r * 512 + c), bk = *(const f32x2*)(HB + (size_t)r * 512 + c);
                        const float v0 = f.x + bk.x, v1 = f.y + bk.y; const float rs = rsqrtf(wave_sum(v0 * v0 + v1 * v1) * (1.f / 128.f) + EPS);
                        const unsigned ow = *(const unsigned*)(MLO + (size_t)r * 512 + c); const float o0 = __uint_as_float(ow << 16), o1 = __uint_as_float(ow & 0xffff0000u);
                        const float g0 = mg[1536 + c], g1 = mg[1536 + c + 1];
                        *(unsigned*)(orow + 1536 + c) = cvtpk(v0 * rs * g0 / (1.f + __expf(-o0)), v1 * rs * g1 / (1.f + __expf(-o1))); } }
                }
              }
              __syncthreads(); }
        PH_END
        constexpr int Mrows = need_ctx ? MT : ML;
        PH_BEGIN(9)
            pg8::Gemm g{ABUF, WOUT, Mrows, DM, DM}; pg8::EpiResid<l, 2> E{(l == 0 ? INP(I_X) : (const float*)OUT), OUT, ws};
            if constexpr (need_ctx) { pg8::SplitCtxOrder S; S.init(G, bid, DM); pg8::gemm_phase<pg8::EpiResid<l, 2>, pg8::SplitCtxOrder, true, true>(lds, g, S, E, tid); }
            else { pg8::StaticOrder S; S.init(Mrows, DM, G, bid, DM); pg8::gemm_phase<pg8::EpiResid<l, 2>, pg8::StaticOrder, true, true>(lds, g, S, E, tid); }
        PH_END
        PH_BEGIN(10)
            NORM_ROWS(l, INP(I_N2G) + l * DM, 3, Mrows, OUT);
        PH_END
        PH_BEGIN(11)
            pg8::Gemm g{ABUF, W1, Mrows, 2 * FFH, DM}; pg8::StaticOrder S; S.init(Mrows, 2 * FFH, G, bid, DM); pg8::EpiSwiglu E{ws};
            for (int rp_ = 0; rp_ <= DUP_W1; ++rp_) pg8::gemm_phase<pg8::EpiSwiglu, pg8::StaticOrder, true, true>(lds, g, S, E, tid);
        PH_END
        PH_BEGIN(12)
            pg8::Gemm g{HID, W2, Mrows, DM, FFH}; pg8::EpiResid<l, 5> E{(const float*)OUT, OUT, ws};
            if constexpr (need_ctx) { pg8::SplitCtxOrder S; S.init(G, bid, FFH); pg8::gemm_phase<pg8::EpiResid<l, 5>, pg8::SplitCtxOrder, true, true>(lds, g, S, E, tid); }
            else { pg8::StaticOrder S; S.init(Mrows, DM, G, bid, FFH); pg8::gemm_phase<pg8::EpiResid<l, 5>, pg8::StaticOrder, true, true>(lds, g, S, E, tid); }
        PH_END


    }
#undef PH_BEGIN
#undef PH_END
}

extern "C" void kernel_launch(void* const* d_in, const int* in_sizes, int n_in, void* d_out, int out_size, void* d_ws, size_t ws_size, hipStream_t stream) {
    static int grid = 0;
    if (grid == 0) {
        if (n_in != 31 || out_size != ML * DM || ws_size < WS_END) { fprintf(stderr, "kernel_launch: unexpected shapes n_in %d out %d ws %zu (need %zu)\n", n_in, out_size, ws_size, (size_t)WS_END); grid = -1; return; }
        int dev = 0, cus = 0, per_cu = 0;
        hipGetDevice(&dev); hipDeviceGetAttribute(&cus, hipDeviceAttributeMultiprocessorCount, dev);
        if (hipFuncSetAttribute((const void*)fwd_kernel, hipFuncAttributeMaxDynamicSharedMemorySize, LDS_BYTES) != hipSuccess) { fprintf(stderr, "kernel_launch: hipFuncSetAttribute failed\n"); grid = -1; return; }
        if (hipOccupancyMaxActiveBlocksPerMultiprocessor(&per_cu, (const void*)fwd_kernel, NTHREADS, LDS_BYTES) != hipSuccess || per_cu < 1) { fprintf(stderr, "kernel_launch: occupancy query gave %d\n", per_cu); per_cu = 1; }
        (void)hipGetLastError();
        grid = cus * 1;
        fprintf(stderr, "kernel_launch: grid %d (cus %d, per_cu %d)\n", grid, cus, per_cu);
    }
    if (grid < 0) return;
    if (hipMemsetAsync(d_ws, 0, 65536, stream) != hipSuccess) { fprintf(stderr, "kernel_launch: memset failed\n"); return; }
    Args a{};
    for (int i = 0; i < 31; ++i) a.in[i] = (const float*)d_in[i];
    a.out = (float*)d_out; a.ws = (unsigned char*)d_ws; a.ph_lo = 0; a.ph_hi = 0;
    void* kargs[] = {&a};
    hipError_t e = hipLaunchCooperativeKernel((const void*)fwd_kernel, dim3(grid), dim3(NTHREADS), kargs, LDS_BYTES, stream);
    if (e != hipSuccess) fprintf(stderr, "kernel_launch: cooperative launch failed: %s (grid %d)\n", hipGetErrorString(e), grid);
}
```

```cpp
#include <hip/hip_runtime.h>
#include <hip/hip_cooperative_groups.h>
#include <cstdio>
#include <cstdint>
#include <cmath>
namespace cg = cooperative_groups;
#ifndef DUP_HY
#define DUP_HY 0
#endif
#ifndef DUP_ML
#define DUP_ML 0
#endif
#ifndef DUP_SYNC
#define DUP_SYNC 0
#endif
#ifndef DUP_INPROJ
#define DUP_INPROJ 0
#endif
#ifndef DUP_UP
#define DUP_UP 0
#endif
#ifndef DUP_W1
#define DUP_W1 0
#endif
#ifndef DUP_ATT
#define DUP_ATT 0
#endif
#ifndef DUP_POST
#define DUP_POST 0
#endif
#ifndef DUP_COMB
#define DUP_COMB 0
#endif
#ifndef DUP_NORM
#define DUP_NORM 0
#endif
#ifndef DUP_M0
#define DUP_M0 0
#endif
#ifndef DUP_G0
#define DUP_G0 0
#endif
#ifndef DUP_G1
#define DUP_G1 0
#endif
namespace pg8 {
#define PG8_LAS __attribute__((address_space(3)))
typedef unsigned short bf16_t;
typedef short bf16x8 __attribute__((ext_vector_type(8)));
typedef float f32x4 __attribute__((ext_vector_type(4)));
typedef unsigned u32x4 __attribute__((ext_vector_type(4)));
constexpr int BM = 256, BK = 64, HALF = 128, HTB = HALF * BK * 2  , STAGE_BYTES = 8 * HTB, NXCD = 8, WGM = 8;

__host__ __device__ __forceinline__ int lds_byte(int r, int c) { const int st = (r >> 4) * 2 + (c >> 5), rr = r & 15, cc = c & 31, ob = rr * 64 + cc * 2; return st * 1024 + (ob ^ (((ob >> 9) & 1) << 5)); }
__host__ __device__ __forceinline__ void stage_rc(int b, int& R, int& C) { const int st = b / 1024, sb = b % 1024, swz = sb ^ (((sb >> 9) & 1) << 5); R = (st >> 1) * 16 + swz / 64; C = (st & 1) * 32 + (swz % 64) / 2; }
__host__ __device__ __forceinline__ int perm32(int rho) { const int n = rho >> 4, i = rho & 15; return 8 * (i >> 2) + 4 * n + (i & 3); }

struct Unit { int pm, pn, kofs, nt, atomic, which; };
struct Gemm { const bf16_t* A; const bf16_t* Bt; int M, N, K; const bf16_t* A2; const bf16_t* Bt2; };

struct StaticOrder {
    int nM, nN, nwg, G, c, ntk;
    __host__ __device__ void init(int M, int N, int G_, int c_, int K_) { nM = M / BM; nN = N / BM; nwg = nM * nN; G = G_; c = c_; ntk = K_ / BK; }
    __host__ __device__ bool next(int i, Unit& u) const {
        const long L = (long)i * G + c; if (L >= nwg) return false;
        int wgid = (int)L; { const int q = nwg / NXCD, r = nwg % NXCD, xcd = wgid % NXCD, off = wgid / NXCD; wgid = (xcd < r ? xcd * (q + 1) : r * (q + 1) + (xcd - r) * q) + off; }
        const int nig = WGM * nN, gid = wgid / nig, fm = gid * WGM, gsz = (nM - fm) < WGM ? (nM - fm) : WGM;
        u.pm = fm + ((wgid % nig) % gsz); u.pn = (wgid % nig) / gsz; u.kofs = 0; u.nt = ntk; u.atomic = 0; u.which = 0; return true;
    }
    __device__ __forceinline__ void a_ready(const Unit&) const {}
    __device__ __forceinline__ void done(const Unit&) const {}
};
struct SplitCtxOrder {
    StaticOrder so; int K;
    __host__ __device__ void init(int G_, int c_, int K_) { so.init(16384, 2048, G_, c_, K_); K = K_; }
    __host__ __device__ bool next(int i, Unit& u) const {
        const long L = (long)i * so.G + so.c;
        if (L < so.nwg) return so.next(i, u);
        const int q = (int)(L - so.nwg); if (q >= 128) return false;
        const int cu = q >> 2, kq = q & 3; u.pm = 64 + (cu >> 3); u.pn = cu & 7; u.kofs = kq * (K / 4); u.nt = K / 4 / BK; u.atomic = 1; u.which = 0; return true;
    }
    __device__ __forceinline__ void a_ready(const Unit&) const {}
    __device__ __forceinline__ void done(const Unit&) const {}
};
struct InProjL1Order {
    StaticOrder so;
    __host__ __device__ void init(int G_, int c_, int K_) { so.init(16384, 4864, G_, c_, K_); }
    __host__ __device__ bool next(int i, Unit& u) const {
        const long L = (long)i * so.G + so.c;
        if (L < so.nwg) return so.next(i, u);
        const int q = (int)(L - so.nwg); if (q >= 36) return false;
        const int r = q / 9, k = q % 9; u.pm = 64 + r; u.pn = k < 2 ? 2 + k : (k < 8 ? 10 + (k - 2) : 18); u.kofs = 0; u.nt = so.ntk; u.atomic = 0; u.which = 0; return true;
    }
    __device__ __forceinline__ void a_ready(const Unit&) const {}
    __device__ __forceinline__ void done(const Unit&) const {}
};

struct DualUpOrder {
    int G, c;
    __host__ __device__ void init(int G_, int c_) { G = G_; c = c_; }
    __host__ __device__ bool next(int i, Unit& u) const {
        const long L = (long)i * G + c; if (L >= 952) return false;
        u.kofs = 0; u.nt = 8; u.atomic = 0;
        if (L < 408) { u.which = 0; u.pm = (int)L / 6; u.pn = (int)L % 6; } else { const int q = (int)L - 408; u.which = 1; u.pm = q >> 3; u.pn = q & 7; }
        return true;
    }
    __device__ __forceinline__ void a_ready(const Unit&) const {}
    __device__ __forceinline__ void done(const Unit&) const {}
};

struct InProjL0Order {
    StaticOrder so;
    __host__ __device__ void init(int G_, int c_, int K_) { so.init(16384, 4864, G_, c_, K_); }
    __host__ __device__ bool next(int i, Unit& u) const {
        const long L = (long)i * so.G + so.c;
        if (L >= so.nwg + 48 + 112) return false;
        Unit v; const bool ok = so.next(L < so.nwg ? i : 0, v);
        (void)ok;
        const int q = (int)(L - so.nwg), q2 = q - 48;
        const int r1 = q / 12, k1 = q % 12, t2 = q2 >> 2, r2 = t2 / 7, k2 = t2 % 7;
        const bool lat = L < so.nwg, full = q < 48;
        u.pm = lat ? v.pm : (full ? 64 + r1 : 64 + r2);
        u.pn = lat ? v.pn : (full ? (k1 < 4 ? k1 : 10 + (k1 - 4)) : (k2 < 6 ? 4 + k2 : 18));
        u.kofs = (lat || full) ? 0 : (q2 & 3) * 512;
        u.nt = (lat || full) ? so.ntk : 8;
        u.atomic = (lat || full) ? 0 : 1;
        u.which = 0;
        return true;
    }
    __device__ __forceinline__ void a_ready(const Unit&) const {}
    __device__ __forceinline__ void done(const Unit&) const {}
};
template <class Epi, class Sched, bool ALIGN_EPI = false, bool SP2 = false>
__device__ __forceinline__ void gemm_phase(PG8_LAS unsigned char* lds, const Gemm g, const Sched& S, const Epi& E, const int tid_in) {
    const int tid = tid_in, wid = __builtin_amdgcn_readfirstlane(tid >> 6), lane = tid & 63, wr = wid >> 2, wc = wid & 3, fr = lane & 15, fq = lane >> 4;
    const int K = g.K;
    unsigned voffA[2], voffB[2];
#pragma unroll
    for (int i = 0; i < 2; ++i) { int R, C; stage_rc(tid * 16 + i * 8192, R, C); const int Rb = Epi::PERM ? ((R & ~31) + perm32(R & 31)) : R;
        voffA[i] = (unsigned)(R * K + C) * 2u; voffB[i] = (unsigned)(Rb * K + C) * 2u; }
    const size_t kstep = (size_t)(BK * 2);
    const size_t hstep = (size_t)HALF * K * 2;
    const size_t tstep = 2 * hstep;
    const unsigned ldsw = (unsigned)wid * 1024u;
    const int aoff = lds_byte(wr * 64 + fr, fq * 8), boff = lds_byte(wc * 32 + fr, fq * 8);
#define PG8_SA(b, h) (((b) * 2 + (h)) * HTB)
#define PG8_SB(b, h) ((4 + (b) * 2 + (h)) * HTB)
#define PG8_STAGE(bufoff, gbase, voff) do { _Pragma("unroll") for (int _i = 0; _i < 2; ++_i) \
        __builtin_amdgcn_global_load_lds((const unsigned*)((const char*)(gbase) + (voff)[_i]), (PG8_LAS unsigned*)(lds + (bufoff) + ldsw + _i * 8192), 16, 0, 0); } while (0)
#define PG8_LDA(dst, b, h) do { _Pragma("unroll") for (int m = 0; m < 4; ++m) _Pragma("unroll") for (int k = 0; k < 2; ++k) dst[m][k] = *(const PG8_LAS bf16x8*)(lds + PG8_SA(b, h) + aoff + m * 2048 + k * 1024); } while (0)
#define PG8_LDB(dst, b, h) do { _Pragma("unroll") for (int n = 0; n < 2; ++n) _Pragma("unroll") for (int k = 0; k < 2; ++k) dst[n][k] = *(const PG8_LAS bf16x8*)(lds + PG8_SB(b, h) + boff + n * 2048 + k * 1024); } while (0)
#define PG8_MMA(ai, bj, At, Bt) do { __builtin_amdgcn_s_setprio(1); _Pragma("unroll") for (int m = 0; m < 4; ++m) _Pragma("unroll") for (int n = 0; n < 2; ++n) _Pragma("unroll") for (int k = 0; k < 2; ++k) \
        acc[ai][bj][m][n] = __builtin_amdgcn_mfma_f32_16x16x32_bf16(Bt[n][k], At[m][k], acc[ai][bj][m][n], 0, 0, 0); __builtin_amdgcn_s_setprio(0); } while (0)
#define PG8_WAIT_V(n) asm volatile("s_waitcnt vmcnt(" #n ")" ::: "memory")
#define PG8_WAIT_L(n) asm volatile("s_waitcnt lgkmcnt(" #n ")" ::: "memory")
#define PG8_BAR __builtin_amdgcn_s_barrier()
#define PG8_SCHED __builtin_amdgcn_sched_barrier(0)
    Unit cur, nxt; int ui = 0;
    if (!S.next(0, cur)) return;
    int nt = cur.nt;
    f32x4 acc[2][2][4][2];
#pragma unroll
    for (int a = 0; a < 2; ++a)
#pragma unroll
        for (int b = 0; b < 2; ++b)
#pragma unroll
            for (int m = 0; m < 4; ++m)
#pragma unroll
                for (int n = 0; n < 2; ++n) acc[a][b][m][n] = (f32x4){0.f, 0.f, 0.f, 0.f};
    bf16x8 At[4][2], B0[2][2], B1[2][2];
    const char* cA = (const char*)(cur.which ? g.A2 : g.A) + (size_t)cur.pm * tstep + (size_t)cur.kofs * 2; const char* cB = (const char*)(cur.which ? g.Bt2 : g.Bt) + (size_t)cur.pn * tstep + (size_t)cur.kofs * 2;
    S.a_ready(cur);
    if constexpr (SP2) {
        PG8_STAGE(PG8_SB(0, 0), cB, voffB); PG8_STAGE(PG8_SB(0, 1), cB + hstep, voffB); PG8_STAGE(PG8_SA(0, 0), cA, voffA); PG8_STAGE(PG8_SA(0, 1), cA + hstep, voffA);
        if (wr == 1) PG8_BAR;
        PG8_WAIT_V(2); PG8_BAR;
        PG8_STAGE(PG8_SB(1, 0), cB + kstep, voffB); PG8_STAGE(PG8_SA(1, 0), cA + kstep, voffA); PG8_STAGE(PG8_SB(1, 1), cB + hstep + kstep, voffB);
        PG8_WAIT_V(6); PG8_BAR;
    } else {
        PG8_STAGE(PG8_SB(0, 0), cB, voffB); PG8_STAGE(PG8_SA(0, 0), cA, voffA); PG8_STAGE(PG8_SB(0, 1), cB + hstep, voffB); PG8_STAGE(PG8_SA(0, 1), cA + hstep, voffA);
        if (wr == 1) PG8_BAR;
        PG8_WAIT_V(4); PG8_BAR;
        PG8_STAGE(PG8_SB(1, 0), cB + kstep, voffB); PG8_STAGE(PG8_SA(1, 0), cA + kstep, voffA); PG8_STAGE(PG8_SB(1, 1), cB + hstep + kstep, voffB);
        PG8_WAIT_V(6); PG8_BAR;
    }
    for (;;) {
        const bool has_next = S.next(ui + 1, nxt);
        const char* nA = has_next ? (const char*)(nxt.which ? g.A2 : g.A) + (size_t)nxt.pm * tstep + (size_t)nxt.kofs * 2 : cA; const char* nB = has_next ? (const char*)(nxt.which ? g.Bt2 : g.Bt) + (size_t)nxt.pn * tstep + (size_t)nxt.kofs * 2 : cB;
        for (int t = 0; t < nt; t += 2) {
            const bool last = (t == nt - 2);
            const char* a1 = cA + (size_t)(t + 1) * kstep;
            const char* a2 = last ? nA : cA + (size_t)(t + 2) * kstep; const char* b2 = last ? nB : cB + (size_t)(t + 2) * kstep;
            const char* a3 = a2 + kstep; const char* b3 = b2 + kstep;
            if (last && has_next) S.a_ready(nxt);
            if constexpr (SP2) {
            PG8_LDB(B0, 0, 0); PG8_LDB(B1, 0, 1); PG8_SCHED; PG8_LDA(At, 0, 0); PG8_STAGE(PG8_SA(1, 1), a1 + hstep, voffA);
            PG8_WAIT_V(8); PG8_WAIT_L(0); PG8_BAR; PG8_MMA(0, 0, At, B0); PG8_MMA(0, 1, At, B1); PG8_BAR; PG8_SCHED;
            PG8_LDA(At, 0, 1); PG8_STAGE(PG8_SB(0, 0), b2, voffB); PG8_STAGE(PG8_SB(0, 1), b2 + hstep, voffB); PG8_STAGE(PG8_SA(0, 0), a2, voffA);
            PG8_WAIT_V(8); PG8_WAIT_L(0); PG8_BAR; PG8_MMA(1, 0, At, B0); PG8_MMA(1, 1, At, B1); PG8_BAR; PG8_SCHED;
            PG8_LDB(B0, 1, 0); PG8_LDB(B1, 1, 1); PG8_SCHED; PG8_LDA(At, 1, 0); PG8_STAGE(PG8_SA(0, 1), a2 + hstep, voffA);
            PG8_WAIT_V(8); PG8_WAIT_L(0); PG8_BAR; PG8_MMA(0, 0, At, B0); PG8_MMA(0, 1, At, B1); PG8_BAR; PG8_SCHED;
            PG8_LDA(At, 1, 1); PG8_STAGE(PG8_SB(1, 0), b3, voffB); PG8_STAGE(PG8_SB(1, 1), b3 + hstep, voffB); PG8_STAGE(PG8_SA(1, 0), a3, voffA);
            PG8_WAIT_V(8); PG8_WAIT_L(0); PG8_BAR; PG8_MMA(1, 0, At, B0); PG8_MMA(1, 1, At, B1); PG8_BAR; PG8_SCHED;
            } else {
            PG8_LDB(B0, 0, 0); PG8_SCHED; PG8_LDA(At, 0, 0); PG8_STAGE(PG8_SA(1, 1), a1 + hstep, voffA);
            PG8_WAIT_L(8); PG8_BAR; PG8_WAIT_L(0); PG8_MMA(0, 0, At, B0); PG8_BAR; PG8_SCHED;
            PG8_LDB(B1, 0, 1); PG8_STAGE(PG8_SB(0, 0), b2, voffB);
            PG8_BAR; PG8_WAIT_L(0); PG8_MMA(0, 1, At, B1); PG8_BAR;
            PG8_LDA(At, 0, 1); PG8_STAGE(PG8_SA(0, 0), a2, voffA);
            PG8_BAR; PG8_WAIT_L(0); PG8_MMA(1, 0, At, B0); PG8_BAR; PG8_SCHED;
            PG8_STAGE(PG8_SB(0, 1), b2 + hstep, voffB);
            PG8_WAIT_V(6); PG8_BAR; PG8_MMA(1, 1, At, B1); PG8_BAR;
            PG8_LDB(B0, 1, 0); PG8_SCHED; PG8_LDA(At, 1, 0); PG8_STAGE(PG8_SA(0, 1), a2 + hstep, voffA);
            PG8_WAIT_L(8); PG8_BAR; PG8_WAIT_L(0); PG8_MMA(0, 0, At, B0); PG8_BAR; PG8_SCHED;
            PG8_LDB(B1, 1, 1); PG8_STAGE(PG8_SB(1, 0), b3, voffB);
            PG8_BAR; PG8_WAIT_L(0); PG8_MMA(0, 1, At, B1); PG8_BAR;
            PG8_LDA(At, 1, 1); PG8_STAGE(PG8_SA(1, 0), a3, voffA);
            PG8_BAR; PG8_WAIT_L(0); PG8_MMA(1, 0, At, B0); PG8_BAR; PG8_SCHED;
            PG8_STAGE(PG8_SB(1, 1), b3 + hstep, voffB);
            PG8_WAIT_V(6); PG8_BAR; PG8_MMA(1, 1, At, B1); PG8_BAR;
            }
        }
        if constexpr (ALIGN_EPI) { if (wr == 0) PG8_BAR; }
        if constexpr (!Epi::AFTER_DRAIN) { E(acc, cur, wr, wc, fr, fq); S.done(cur); }
        if (!has_next) break;
#pragma unroll
        for (int a = 0; a < 2; ++a)
#pragma unroll
            for (int b = 0; b < 2; ++b)
#pragma unroll
                for (int m = 0; m < 4; ++m)
#pragma unroll
                    for (int n = 0; n < 2; ++n) acc[a][b][m][n] = (f32x4){0.f, 0.f, 0.f, 0.f};
        cur = nxt; cA = nA; cB = nB; ++ui; nt = cur.nt;
        if constexpr (ALIGN_EPI) { if (wr == 1) PG8_BAR; }
    }
    PG8_WAIT_V(0);
    if constexpr (!ALIGN_EPI) { if (wr == 0) PG8_BAR; }
    PG8_BAR;
    if constexpr (Epi::AFTER_DRAIN) { E.fused(acc, cur, wr, wc, fr, fq, lds, wid, lane); S.done(cur); }
#undef PG8_SA
#undef PG8_SB
#undef PG8_STAGE
#undef PG8_LDA
#undef PG8_LDB
#undef PG8_MMA
#undef PG8_WAIT_V
#undef PG8_WAIT_L
#undef PG8_BAR
#undef PG8_SCHED
}
}
#define LAS __attribute__((address_space(3)))
typedef unsigned short bf16_t;
typedef short bf16x8 __attribute__((ext_vector_type(8)));
typedef short s16x4 __attribute__((ext_vector_type(4)));
typedef float f32x4 __attribute__((ext_vector_type(4)));
typedef float f32x2 __attribute__((ext_vector_type(2)));
typedef float f32x16 __attribute__((ext_vector_type(16)));
typedef unsigned u32x4 __attribute__((ext_vector_type(4)));
typedef unsigned u32x2 __attribute__((ext_vector_type(2)));
constexpr int DM = 2048, NB = 4, SEQ = 4096, CTXL = 256;
constexpr int ML = NB * SEQ, MC = NB * CTXL, MT = ML + MC;
constexpr int NIN = 4688, NINP = 4864, FFH = 5632, NKEY = CTXL + SEQ;
constexpr float EPS = 1e-6f;
constexpr int NTHREADS = 512, NWAVES = 8;
constexpr int LDS_BYTES = 147456;
constexpr size_t MiB = 1u << 20;
constexpr size_t WS_MOD = 1 * MiB, WS_TW = 2 * MiB, WS_H2L = 3 * MiB, WS_H2C = 5 * MiB, WS_MODP = 6 * MiB, WS_KROPE = 21 * MiB, WS_GATES = 26 * MiB, WS_MLS = 28 * MiB, WS_MLN = 29 * MiB,
    WS_XC = 30 * MiB, WS_WIN = 38 * MiB, WS_WUQ = 57 * MiB, WS_WUKV = 59 * MiB, WS_WOUT = 61 * MiB, WS_W1 = 69 * MiB, WS_W2 = 113 * MiB, WS_A = 135 * MiB, WS_CQ = 203 * MiB, WS_CKV = 220 * MiB,
    WS_HYT = 237 * MiB, WS_HYTC = 333 * MiB, WS_MLQK = 339 * MiB, WS_MLQK2 = 373 * MiB, WS_MLV = 407 * MiB, WS_MLO = 424 * MiB, WS_QRAW = 441 * MiB, WS_KVRAW = 492 * MiB,
    WS_Q = 560 * MiB, WS_QC = 608 * MiB, WS_K = 611 * MiB, WS_V = 662 * MiB, WS_AO = 696 * MiB, WS_YT = 730 * MiB, WS_YTC = 762 * MiB, WS_END = 764 * MiB;
constexpr size_t WS_CST = WS_A;
constexpr size_t WS_HF = WS_QRAW, WS_HB = WS_QRAW + 34 * MiB;
constexpr size_t WS_HID = WS_CQ;

__device__ __forceinline__ unsigned cvtpk(float lo, float hi) { unsigned r; asm volatile("v_cvt_pk_bf16_f32 %0, %1, %2" : "=v"(r) : "v"(lo), "v"(hi)); return r; }
__device__ __forceinline__ float bf2f(bf16_t v) { return __uint_as_float((unsigned)v << 16); }
__device__ __forceinline__ float bf2f_s(short v) { return __uint_as_float(((unsigned)(unsigned short)v) << 16); }
__device__ __forceinline__ bf16_t f2bf(float f) { return (bf16_t)(cvtpk(f, 0.f) & 0xffffu); }
template <int K> __device__ __forceinline__ float swz_xor(float v) { return __int_as_float(__builtin_amdgcn_ds_swizzle(__float_as_int(v), (K << 10) | 0x1f)); }
__device__ __forceinline__ float wave_sum(float v) {
    v += swz_xor<1>(v); v += swz_xor<2>(v); v += swz_xor<4>(v); v += swz_xor<8>(v); v += swz_xor<16>(v);
    auto rr = __builtin_amdgcn_permlane32_swap(__float_as_uint(v), __float_as_uint(v), false, false);
    return __uint_as_float(rr[0]) + __uint_as_float(rr[1]);
}
__device__ __forceinline__ float xor32_get(float v, int hi) {
    auto rr = __builtin_amdgcn_permlane32_swap(__float_as_uint(v), __float_as_uint(v), false, false);
    return hi ? __uint_as_float(rr[0]) : __uint_as_float(rr[1]);
}
__device__ __forceinline__ float siluf(float x) { return x / (1.f + __expf(-x)); }
__device__ __forceinline__ float logsigmoidf(float x) { return fminf(x, 0.f) - log1pf(expf(-fabsf(x))); }
__device__ __forceinline__ int crow(int r, int hi) { return (r & 3) + 8 * (r >> 2) + 4 * hi; }
#define LDS_WAIT() asm volatile("s_waitcnt lgkmcnt(0)" ::: "memory")
#define SBAR() __builtin_amdgcn_sched_barrier(0)

struct MapIdent { __device__ __forceinline__ int operator()(int n) const { return n; } };
struct MapWin { __device__ __forceinline__ int operator()(int n) const {
    if (n < 1024) return n; if (n < 2560) return 1088 + (n - 1024); if (n < 3584) return 2624 + (n - 2560); if (n < 4096) return 3648 + (n - 3584);
    if (n < 4608) return 4160 + (n - 4096); if (n < 4672) return 1024 + (n - 4608); if (n < 4688) return n; return -1; } };
struct MapW1 { __device__ __forceinline__ int operator()(int n) const { const int t = n >> 8, w = n & 255; return w < 128 ? t * 128 + w : FFH + t * 128 + (w - 128); } };
template <class Map>
__device__ __forceinline__ void wt_item(const float* __restrict__ W, int Nsrc, int K, bf16_t* __restrict__ WT, const float* __restrict__ kscale, LAS float* scr, int kb, int nb, int lane, Map map) {
    const int k0 = 64 * kb, n0 = 32 * nb, oc = map(n0 + (lane & 31));
    float wv[32];
#pragma unroll
    for (int i = 0; i < 32; ++i) { const int kk = 2 * i + (lane >> 5); wv[i] = (oc >= 0) ? W[(size_t)(k0 + kk) * Nsrc + oc] : 0.f; }
#pragma unroll
    for (int i = 0; i < 32; ++i) { const int kk = 2 * i + (lane >> 5); float v = wv[i]; if (kscale) v *= kscale[k0 + kk]; scr[kk * 33 + (lane & 31)] = v; }
    LDS_WAIT();
    const int c = lane & 7;
#pragma unroll
    for (int j = 0; j < 4; ++j) { const int n = (lane >> 3) + 8 * j; const LAS float* s = scr + (8 * c) * 33 + n;
        u32x4 o; o.x = cvtpk(s[0 * 33], s[1 * 33]); o.y = cvtpk(s[2 * 33], s[3 * 33]); o.z = cvtpk(s[4 * 33], s[5 * 33]); o.w = cvtpk(s[6 * 33], s[7 * 33]);
        *(u32x4*)(WT + (size_t)(n0 + n) * K + k0 + 8 * c) = o; }
    LDS_WAIT();
}

namespace att {
constexpr int DQK = 192, DV = 128, QBLK = 32, KVBLK = 64;
constexpr float SCALE = 0.07216878364870322f;
constexpr float THR = 8.f;
constexpr int KPITCH = 400;
constexpr int SHM_V = KVBLK * DV * 2, SHM_K = KVBLK * KPITCH;
constexpr int QRP = 144;
constexpr int SHM_QR = 2 * SHM_V + 2 * SHM_K + NWAVES * 64 * 4;
constexpr int SHM_ATTN = SHM_QR + NWAVES * 32 * QRP;
__device__ __forceinline__ void partialSM(f32x16& p0, f32x16& p1, float& m_reg, float& mn, float& alpha) {
    constexpr float C = SCALE * 1.4426950408889634f;
    float pmax = p0[0];
#pragma unroll
    for (int r = 1; r < 16; ++r) pmax = fmaxf(pmax, p0[r]);
#pragma unroll
    for (int r = 0; r < 16; ++r) pmax = fmaxf(pmax, p1[r]);
    { auto rr = __builtin_amdgcn_permlane32_swap(__float_as_uint(pmax), __float_as_uint(pmax), false, false);
      pmax = fmaxf(__uint_as_float(rr[0]), __uint_as_float(rr[1])); }
    if (__builtin_expect(__all(pmax - m_reg <= THR / SCALE), 1)) { mn = m_reg; alpha = 1.f; }
    else { mn = fmaxf(m_reg, pmax); alpha = __builtin_amdgcn_exp2f((m_reg - mn) * C); m_reg = mn; }
    const float mnC = -mn * C;
#pragma unroll
    for (int r = 0; r < 16; ++r) p0[r] = fmaf(p0[r], C, mnC);
#pragma unroll
    for (int r = 0; r < 16; ++r) p1[r] = fmaf(p1[r], C, mnC);
#pragma unroll
    for (int r = 0; r < 16; ++r) p0[r] = __builtin_amdgcn_exp2f(p0[r]);
}
#define PK4(P, BASE, OUT) do { unsigned a0 = cvtpk(P[BASE + 0], P[BASE + 1]), a1 = cvtpk(P[BASE + 2], P[BASE + 3]);   \
    unsigned b0 = cvtpk(P[BASE + 4], P[BASE + 5]), b1 = cvtpk(P[BASE + 6], P[BASE + 7]);                              \
    auto r0 = __builtin_amdgcn_permlane32_swap(a0, b0, false, false); auto r1 = __builtin_amdgcn_permlane32_swap(a1, b1, false, false); \
    u32x4 w = {r0[0], r1[0], r0[1], r1[1]}; OUT = __builtin_bit_cast(bf16x8, w); } while (0)
__device__ __forceinline__ void finishSM(f32x16& p0, f32x16& p1, float alpha, float& l_reg, bf16x8& pa0, bf16x8& pa1, bf16x8& pa2, bf16x8& pa3) {
#pragma unroll
    for (int r = 0; r < 16; ++r) p1[r] = __builtin_amdgcn_exp2f(p1[r]);
    float ps = 0;
#pragma unroll
    for (int r = 0; r < 16; ++r) ps += p0[r];
#pragma unroll
    for (int r = 0; r < 16; ++r) ps += p1[r];
    { auto rr = __builtin_amdgcn_permlane32_swap(__float_as_uint(ps), __float_as_uint(ps), false, false);
      ps = __uint_as_float(rr[0]) + __uint_as_float(rr[1]); }
    l_reg = l_reg * alpha + ps;
    PK4(p0, 0, pa0); PK4(p0, 8, pa1); PK4(p1, 0, pa2); PK4(p1, 8, pa3);
}
__device__ __forceinline__ void qkt(f32x16& p0, f32x16& p1, const char* Ks, const bf16x8* qr, const char* qrl, int r32, int hi) {
    p0 = f32x16{}; p1 = f32x16{};
#pragma unroll
    for (int d0 = 0; d0 < 12; ++d0) { const int cb = (d0 * 16 + hi * 8) * 2;
        bf16x8 b0 = *reinterpret_cast<const bf16x8*>(Ks + r32 * KPITCH + cb);
        bf16x8 b1 = *reinterpret_cast<const bf16x8*>(Ks + (32 + r32) * KPITCH + cb);
        bf16x8 q; if (d0 < 8) q = qr[d0 < 8 ? d0 : 0]; else q = *reinterpret_cast<const bf16x8*>(qrl + (d0 - 8) * 32);
        p0 = __builtin_amdgcn_mfma_f32_32x32x16_bf16(b0, q, p0, 0, 0, 0);
        p1 = __builtin_amdgcn_mfma_f32_32x32x16_bf16(b1, q, p1, 0, 0, 0);
        if ((d0 & 3) == 3) asm volatile("" ::: "memory"); }
}
__device__ __forceinline__ int v_st(int k, int c) { const int kk = (k & ~0xC) | ((k & 4) << 1) | ((k & 8) >> 1); return ((kk >> 3) * 4 + (c >> 5)) * 512 + ((kk & 7) * 32 + (c & 31)) * 2; }
__device__ __forceinline__ int v_rd_base(int lane) { return ((lane & 3) << 3) | (((lane >> 2) & 3) << 6) | (((lane >> 4) & 1) << 5) | (((lane >> 5) & 1) << 8); }
constexpr int v_rd_off(int d0, int ks, int half) { return d0 * 512 + ks * 4096 + half * 2048; }
template <int OFF> __device__ __forceinline__ s16x4 tr_read(int vb) {
    s16x4 r; asm volatile("ds_read_b64_tr_b16 %0, %1 offset:%2" : "=&v"(r) : "v"(vb), "i"(OFF) : "memory"); return r;
}
template <int D0> __device__ __forceinline__ void pv_one(f32x16& od, int vb, bf16x8 pa0, bf16x8 pa1, bf16x8 pa2, bf16x8 pa3) {
    const s16x4 l0 = tr_read<v_rd_off(D0, 0, 0)>(vb), h0 = tr_read<v_rd_off(D0, 0, 1)>(vb), l1 = tr_read<v_rd_off(D0, 1, 0)>(vb), h1 = tr_read<v_rd_off(D0, 1, 1)>(vb);
    const s16x4 l2 = tr_read<v_rd_off(D0, 2, 0)>(vb), h2 = tr_read<v_rd_off(D0, 2, 1)>(vb), l3 = tr_read<v_rd_off(D0, 3, 0)>(vb), h3 = tr_read<v_rd_off(D0, 3, 1)>(vb);
    asm volatile("s_waitcnt lgkmcnt(0)" ::: "memory"); SBAR();
#define PKV(L, H) (bf16x8){L[0], L[1], L[2], L[3], H[0], H[1], H[2], H[3]}
    od = __builtin_amdgcn_mfma_f32_32x32x16_bf16(pa0, PKV(l0, h0), od, 0, 0, 0);
    od = __builtin_amdgcn_mfma_f32_32x32x16_bf16(pa1, PKV(l1, h1), od, 0, 0, 0);
    od = __builtin_amdgcn_mfma_f32_32x32x16_bf16(pa2, PKV(l2, h2), od, 0, 0, 0);
    od = __builtin_amdgcn_mfma_f32_32x32x16_bf16(pa3, PKV(l3, h3), od, 0, 0, 0);
#undef PKV
}
__device__ __forceinline__ void pv_d0(f32x16* o, int vb, bf16x8 pa0, bf16x8 pa1, bf16x8 pa2, bf16x8 pa3) {
    pv_one<0>(o[0], vb, pa0, pa1, pa2, pa3); pv_one<1>(o[1], vb, pa0, pa1, pa2, pa3); pv_one<2>(o[2], vb, pa0, pa1, pa2, pa3); pv_one<3>(o[3], vb, pa0, pa1, pa2, pa3);
}
__device__ __forceinline__ void attn_body(const bf16_t* __restrict__ Qb, const bf16_t* __restrict__ Kh, const bf16_t* __restrict__ Vh, bf16_t* __restrict__ Ob, int ldo, int seq, char* lds, const int tid) {
    const int wid = tid >> 6, lane = tid & 63, r32 = lane & 31, hi = lane >> 5;
    char* V_lds = lds; char* K_lds = lds + 2 * SHM_V;
    float* ws = (float*)(lds + 2 * SHM_V + 2 * SHM_K) + wid * 64; float* li_l = ws; float* al_l = ws + 32;
    float m_reg = -1e30f, l_reg = 0; f32x16 o[4] = {}; bf16x8 qr[8];
    char* qrl = lds + SHM_QR + wid * (32 * QRP) + r32 * QRP + hi * 16;
    const bf16_t* Qw = Qb + (long)(wid * QBLK + r32) * DQK + hi * 8;
#pragma unroll
    for (int d0 = 0; d0 < 8; ++d0) qr[d0] = *reinterpret_cast<const bf16x8*>(Qw + d0 * 16);
#pragma unroll
    for (int d0 = 8; d0 < 12; ++d0) *reinterpret_cast<bf16x8*>(qrl + (d0 - 8) * 32) = *reinterpret_cast<const bf16x8*>(Qw + d0 * 16);
    const int sr = tid >> 4, sc = (tid & 15) * 8, vst0 = v_st(sr, sc), vst1 = v_st(32 + sr, sc);
    const int ku0 = tid, ku1 = tid + 512, ku2 = tid + 1024;
    const int kst0 = (ku0 / 24) * KPITCH + (ku0 % 24) * 16, kst1 = (ku1 / 24) * KPITCH + (ku1 % 24) * 16, kst2 = (ku2 / 24) * KPITCH + (ku2 % 24) * 16;
    const int vb0 = (int)(uintptr_t)V_lds + v_rd_base(lane);
    struct { bf16x8 vs0, vs1, ks0, ks1, ks2; } sr_[1];
    const unsigned voff0 = (unsigned)(sr * DV + sc), voff1 = (unsigned)((32 + sr) * DV + sc), koff0 = (unsigned)(ku0 * 8), koff1 = (unsigned)(ku1 * 8), koff2 = (unsigned)(ku2 * 8);
#define SLOAD(i, k0) do { const bf16_t* vt_ = Vh + (long)(k0) * DV; const bf16_t* kt_ = Kh + (long)(k0) * DQK; \
    sr_[i].vs0 = *reinterpret_cast<const bf16x8*>(vt_ + voff0); sr_[i].vs1 = *reinterpret_cast<const bf16x8*>(vt_ + voff1); \
    sr_[i].ks0 = *reinterpret_cast<const bf16x8*>(kt_ + koff0); sr_[i].ks1 = *reinterpret_cast<const bf16x8*>(kt_ + koff1); sr_[i].ks2 = *reinterpret_cast<const bf16x8*>(kt_ + koff2); } while (0)
#define SWRITE(b, i) do { *(bf16x8*)(V_lds + (b) * SHM_V + vst0) = sr_[i].vs0; *(bf16x8*)(V_lds + (b) * SHM_V + vst1) = sr_[i].vs1; \
    *(bf16x8*)(K_lds + (b) * SHM_K + kst0) = sr_[i].ks0; *(bf16x8*)(K_lds + (b) * SHM_K + kst1) = sr_[i].ks1; *(bf16x8*)(K_lds + (b) * SHM_K + kst2) = sr_[i].ks2; } while (0)
#define SWAIT() asm volatile("s_waitcnt vmcnt(0)" ::: "memory")
#define RESC(a) do { if (__any((a) < 1.f)) { if (hi == 0) al_l[r32] = (a); asm volatile("s_waitcnt lgkmcnt(0)" ::: "memory"); \
    _Pragma("unroll") for (int d = 0; d < 4; ++d) _Pragma("unroll") for (int r = 0; r < 16; ++r) o[d][r] *= al_l[crow(r, hi)]; } } while (0)
    f32x16 pA0, pA1, pB0, pB1; float mnA, mnB, alA, alB; bf16x8 pa0, pa1, pa2, pa3; const int NT = seq / KVBLK;
    constexpr int SE = 0, SO = 0;
    SLOAD(SE, 0); asm volatile("s_waitcnt vmcnt(0)" ::: "memory"); SWRITE(0, SE); __syncthreads();
    qkt(pA0, pA1, K_lds, qr, qrl, r32, hi); partialSM(pA0, pA1, m_reg, mnA, alA);
    SLOAD(SO, KVBLK);
    SWAIT(); SWRITE(1, SO); __syncthreads();
    for (int j = 1; j + 1 < NT; j += 2) {
        SBAR(); qkt(pB0, pB1, K_lds + SHM_K, qr, qrl, r32, hi);
        finishSM(pA0, pA1, alA, l_reg, pa0, pa1, pa2, pa3); SBAR();
        SLOAD(SO, (j + 1) * KVBLK); SBAR();
        pv_d0(o, vb0, pa0, pa1, pa2, pa3); partialSM(pB0, pB1, m_reg, mnB, alB);
        __syncthreads(); SWAIT(); SWRITE(0, SE);
        RESC(alB); __syncthreads();
        SBAR(); qkt(pA0, pA1, K_lds, qr, qrl, r32, hi);
        finishSM(pB0, pB1, alB, l_reg, pa0, pa1, pa2, pa3); SBAR();
        SLOAD(SE, (j + 2) * KVBLK); SBAR();
        pv_d0(o, vb0 + SHM_V, pa0, pa1, pa2, pa3); partialSM(pA0, pA1, m_reg, mnA, alA);
        __syncthreads(); SWAIT(); SWRITE(1, SO);
        RESC(alA); __syncthreads();
    }
    SBAR(); qkt(pB0, pB1, K_lds + SHM_K, qr, qrl, r32, hi);
    finishSM(pA0, pA1, alA, l_reg, pa0, pa1, pa2, pa3); SBAR();
    pv_d0(o, vb0, pa0, pa1, pa2, pa3); partialSM(pB0, pB1, m_reg, mnB, alB);
    __syncthreads(); RESC(alB);
    finishSM(pB0, pB1, alB, l_reg, pa0, pa1, pa2, pa3); SBAR();
    pv_d0(o, vb0 + SHM_V, pa0, pa1, pa2, pa3);
    if (hi == 0) li_l[r32] = l_reg; asm volatile("s_waitcnt lgkmcnt(0)" ::: "memory");
    float rli[16];
#pragma unroll
    for (int r = 0; r < 16; ++r) rli[r] = __builtin_amdgcn_rcpf(li_l[crow(r, hi)]);
    bf16_t* Ow = Ob + (long)(wid * QBLK) * ldo;
#pragma unroll
    for (int r = 0; r < 16; ++r) { const int orow = crow(r, hi);
#pragma unroll
        for (int d0 = 0; d0 < 4; ++d0) Ow[(long)orow * ldo + d0 * 32 + r32] = f2bf(o[d0][r] * rli[r]); }
    __syncthreads();
#undef SLOAD
#undef SWRITE
#undef SWAIT
#undef RESC
}
}
namespace pg8 {
__device__ __forceinline__ unsigned cvt_pk_bf16(float lo, float hi) { unsigned r; asm volatile("v_cvt_pk_bf16_f32 %0, %1, %2" : "=v"(r) : "v"(lo), "v"(hi)); return r; }
typedef unsigned u32x2 __attribute__((ext_vector_type(2)));
__device__ __forceinline__ void st_bf16x4(bf16_t* p, f32x4 v) { u32x2 w; w.x = cvt_pk_bf16(v[0], v[1]); w.y = cvt_pk_bf16(v[2], v[3]); *(u32x2*)p = w; }

template <size_t OFF, int LDC> struct EpiPlain {
    static constexpr bool PERM = false, AFTER_DRAIN = false;
    unsigned char* ws;
    __device__ __forceinline__ void operator()(const f32x4 (&acc)[2][2][4][2], const Unit& u, int wr, int wc, int fr, int fq) const {
#pragma unroll
        for (int ai = 0; ai < 2; ++ai)
#pragma unroll
            for (int m = 0; m < 4; ++m) { bf16_t* rowp = (bf16_t*)(ws + OFF) + (size_t)(u.pm * BM + ai * HALF + wr * 64 + m * 16 + fr) * LDC + u.pn * BM + wc * 32 + 4 * fq;
#pragma unroll
                for (int bj = 0; bj < 2; ++bj)
#pragma unroll
                    for (int n = 0; n < 2; ++n) st_bf16x4(rowp + bj * HALF + n * 16, acc[ai][bj][m][n]); }
    }
};
struct EpiUp {
    static constexpr bool PERM = false, AFTER_DRAIN = false;
    unsigned char* ws;
    __device__ __forceinline__ void operator()(const f32x4 (&acc)[2][2][4][2], const Unit& u, int wr, int wc, int fr, int fq) const {
        bf16_t* O = (bf16_t*)(ws + (u.which ? WS_KVRAW : WS_QRAW)); const int ldc = u.which ? 2048 : 1536;
#pragma unroll
        for (int ai = 0; ai < 2; ++ai)
#pragma unroll
            for (int m = 0; m < 4; ++m) { bf16_t* rowp = O + (size_t)(u.pm * BM + ai * HALF + wr * 64 + m * 16 + fr) * ldc + u.pn * BM + wc * 32 + 4 * fq;
#pragma unroll
                for (int bj = 0; bj < 2; ++bj)
#pragma unroll
                    for (int n = 0; n < 2; ++n) st_bf16x4(rowp + bj * HALF + n * 16, acc[ai][bj][m][n]); }
    }
};
struct EpiInProj {
    static constexpr bool PERM = false, AFTER_DRAIN = false;
    unsigned char* ws;
    __device__ __forceinline__ void operator()(const f32x4 (&acc)[2][2][4][2], const Unit& u, int wr, int wc, int fr, int fq) const {
        const int pn = u.pn;
        bf16_t* cq = (bf16_t*)(ws + WS_CQ); bf16_t* ckv = (bf16_t*)(ws + WS_CKV); bf16_t* mlqk = (bf16_t*)(ws + WS_MLQK); bf16_t* mlv = (bf16_t*)(ws + WS_MLV); bf16_t* mlo = (bf16_t*)(ws + WS_MLO);
        bf16_t* hyt = (bf16_t*)(ws + WS_HYT); bf16_t* hytc = (bf16_t*)(ws + WS_HYTC); float* krope = (float*)(ws + WS_KROPE); float* gates = (float*)(ws + WS_GATES);
#pragma unroll
        for (int ai = 0; ai < 2; ++ai)
#pragma unroll
            for (int m = 0; m < 4; ++m) {
                const int row = u.pm * BM + ai * HALF + wr * 64 + m * 16 + fr;
#pragma unroll
                for (int bj = 0; bj < 2; ++bj)
#pragma unroll
                    for (int n = 0; n < 2; ++n) {
                        const int colt = bj * HALF + wc * 32 + n * 16 + 4 * fq; const f32x4 v = acc[ai][bj][m][n];
                        if (pn < 2) st_bf16x4(cq + (size_t)row * 512 + pn * 256 + colt, v);
                        else if (pn < 4) st_bf16x4(ckv + (size_t)row * 512 + (pn - 2) * 256 + colt, v);
                        else if (pn < 10) { const int ch = (pn - 4) * 256 + colt; const unsigned w0 = cvt_pk_bf16(v[0], v[1]), w1 = cvt_pk_bf16(v[2], v[3]);
                            if (row < 16384) { const int b = row >> 12, t = row & 4095; bf16_t* o = hyt + ((size_t)(b * 1536 + ch)) * 4096 + t;
                                o[0] = (bf16_t)(w0 & 0xffffu); o[4096] = (bf16_t)(w0 >> 16); o[8192] = (bf16_t)(w1 & 0xffffu); o[12288] = (bf16_t)(w1 >> 16); }
                            else { const int rc = row - 16384, b = rc >> 8, t = rc & 255; bf16_t* o = hytc + ((size_t)(b * 1536 + ch)) * 256 + t;
                                o[0] = (bf16_t)(w0 & 0xffffu); o[256] = (bf16_t)(w0 >> 16); o[512] = (bf16_t)(w1 & 0xffffu); o[768] = (bf16_t)(w1 >> 16); } }
                        else if (pn < 14) st_bf16x4(mlqk + (size_t)row * 1024 + (pn - 10) * 256 + colt, v);
                        else if (pn < 16) st_bf16x4(mlv + (size_t)row * 512 + (pn - 14) * 256 + colt, v);
                        else if (pn < 18) st_bf16x4(mlo + (size_t)row * 512 + (pn - 16) * 256 + colt, v);
                        else { float* o = colt < 64 ? krope + (size_t)row * 64 + colt : gates + (size_t)row * 16 + (colt - 64);
                            if (colt < 80) { if (u.atomic) { unsafeAtomicAdd(o, v[0]); unsafeAtomicAdd(o + 1, v[1]); unsafeAtomicAdd(o + 2, v[2]); unsafeAtomicAdd(o + 3, v[3]); } else *(f32x4*)o = v; } }
                    }
            }
    }
};
template <int LAYER, int GIDX> struct EpiResid {
    static constexpr bool PERM = false, AFTER_DRAIN = false;
    const float* xin; float* xl; unsigned char* ws;
    __device__ __forceinline__ void operator()(const f32x4 (&acc)[2][2][4][2], const Unit& u, int wr, int wc, int fr, int fq) const {
        float* xc = (float*)(ws + WS_XC); const float* mod = (const float*)(ws + WS_MOD) + (size_t)LAYER * 5 * 12288; constexpr int gidx = GIDX;
        float* base = u.pm < 64 ? xl + (size_t)u.pm * BM * 2048 : xc + (size_t)(u.pm - 64) * BM * 2048;
        const float* rbase = u.pm < 64 ? xin + (size_t)u.pm * BM * 2048 : base;
        const float* mrow = mod + (size_t)(u.pm < 64 ? (u.pm >> 4) : 4) * 12288 + gidx * 2048;
        const int col0 = u.pn * BM + wc * 32 + 4 * fq;
        f32x4 mv[2][2];
#pragma unroll
        for (int bj = 0; bj < 2; ++bj)
#pragma unroll
            for (int n = 0; n < 2; ++n) mv[bj][n] = *(const f32x4*)(mrow + col0 + bj * HALF + n * 16);
#pragma unroll
        for (int ai = 0; ai < 2; ++ai)
#pragma unroll
            for (int m = 0; m < 4; ++m) { float* rowp = base + (size_t)(ai * HALF + wr * 64 + m * 16 + fr) * 2048 + col0; const float* rrow = rbase + (size_t)(ai * HALF + wr * 64 + m * 16 + fr) * 2048 + col0;
#pragma unroll
                for (int bj = 0; bj < 2; ++bj)
#pragma unroll
                    for (int n = 0; n < 2; ++n) { f32x4* p = (f32x4*)(rowp + bj * HALF + n * 16); const f32x4 d = mv[bj][n] * acc[ai][bj][m][n];
                        if (u.atomic) { float* pf = (float*)p; unsafeAtomicAdd(pf, d[0]); unsafeAtomicAdd(pf + 1, d[1]); unsafeAtomicAdd(pf + 2, d[2]); unsafeAtomicAdd(pf + 3, d[3]); }
                        else { f32x4 x = *(const f32x4*)(rrow + bj * HALF + n * 16); x = x + d; *p = x; } } }
    }
};
struct EpiSwiglu {
    static constexpr bool PERM = false, AFTER_DRAIN = false;
    unsigned char* ws;
    __device__ __forceinline__ void operator()(const f32x4 (&acc)[2][2][4][2], const Unit& u, int wr, int wc, int fr, int fq) const {
#pragma unroll
        for (int ai = 0; ai < 2; ++ai)
#pragma unroll
            for (int m = 0; m < 4; ++m) { bf16_t* rowp = (bf16_t*)(ws + WS_HID) + (size_t)(u.pm * BM + ai * HALF + wr * 64 + m * 16 + fr) * FFH + u.pn * HALF + wc * 32 + 4 * fq;
#pragma unroll
                for (int n = 0; n < 2; ++n) { const f32x4 g = acc[ai][0][m][n], up = acc[ai][1][m][n]; f32x4 o;
#pragma unroll
                    for (int j = 0; j < 4; ++j) o[j] = g[j] / (1.f + __expf(-g[j])) * up[j];
                    st_bf16x4(rowp + n * 16, o); } }
    }
};
}
constexpr int TP = 136;
constexpr int TILE_B = 128 * TP * 2;
__device__ __forceinline__ void mma128(f32x16& acc, const LAS bf16_t* A, int m0, const LAS bf16_t* B, int n0, int r32, int hi) {
    const LAS bf16_t* pa = A + (m0 + r32) * TP + hi * 8; const LAS bf16_t* pb = B + (n0 + r32) * TP + hi * 8;
#pragma unroll
    for (int ks = 0; ks < 8; ++ks) { const bf16x8 a = *(const LAS bf16x8*)(pa + ks * 16), b = *(const LAS bf16x8*)(pb + ks * 16);
        acc = __builtin_amdgcn_mfma_f32_32x32x16_bf16(a, b, acc, 0, 0, 0); }
}


__device__ __forceinline__ float scan16_sum(const LAS float* v, int t) { const int g16 = t & ~15, r = t & 15; float s = 0.f;
#pragma unroll
    for (int i = 0; i < 16; ++i) { const float x = v[g16 + i]; s += (i <= r) ? x : 0.f; } return s; }
__device__ __forceinline__ float scan16_max(const LAS float* v, int t) { const int g16 = t & ~15, r = t & 15; float s = -INFINITY;
#pragma unroll
    for (int i = 0; i < 16; ++i) { const float x = v[g16 + i]; s = (i <= r) ? fmaxf(s, x) : s; } return s; }
__device__ __forceinline__ float group_off_sum(const LAS float* gt, int t) { const int g = t >> 4; float s = 0.f;
#pragma unroll
    for (int h = 0; h < 8; ++h) { const float x = gt[h]; s += (h < g) ? x : 0.f; } return s; }
__device__ __forceinline__ float group_off_max(const LAS float* gt, int t) { const int g = t >> 4; float s = -INFINITY;
#pragma unroll
    for (int h = 0; h < 8; ++h) { const float x = gt[h]; s = (h < g) ? fmaxf(s, x) : s; } return s; }

__device__ __forceinline__ int ml_rowbase(int dir, int b, int j) {
    if (j < 2) { const int oc = dir ? 1 - j : j; return ML + b * CTXL + oc * 128; }
    const int oc = dir ? 33 - j : j - 2; return b * SEQ + oc * 128;
}

struct Args { const float* in[31]; float* out; unsigned char* ws; int ph_lo, ph_hi; };
enum { I_X = 0, I_C, I_CTX, I_CCTX, I_ADAW, I_ADAB, I_N1G, I_N2G, I_WIN, I_QAN, I_KVAN, I_WUQ, I_WUKV, I_QN, I_KN, I_HCW, I_HCB, I_HW1, I_HB1, I_HW2, I_HB2, I_HW3, I_HDEC, I_HSKIP,
       I_MCW, I_MCB, I_MGB, I_MIXG, I_WOUT, I_FW1, I_FW2 };

constexpr int FFT_SLOTS = 8192 + 512;
__device__ __forceinline__ int fphys(int i) { return i + 2 * (i >> 5); }
__device__ __forceinline__ f32x2 cmul(f32x2 a, f32x2 b) { return (f32x2){a.x * b.x - a.y * b.y, a.x * b.y + a.y * b.x}; }
__device__ __forceinline__ f32x2 cmulc(f32x2 a, f32x2 b) { return (f32x2){a.x * b.x + a.y * b.y, a.y * b.x - a.x * b.y}; }
#define FC1 0.9238795325112867f
#define FS1 0.3826834323650898f
#define FR2 0.7071067811865476f
template <bool INV> __device__ __forceinline__ void radix16(f32x2 (&x)[16], f32x2 t0, f32x2 t1, f32x2 t2, f32x2 t3) {
    const f32x2 W16[8] = {{1.f, 0.f}, {FC1, -FS1}, {FR2, -FR2}, {FS1, -FC1}, {0.f, -1.f}, {-FS1, -FC1}, {-FR2, -FR2}, {-FC1, -FS1}};
    if (!INV) {
#pragma unroll
        for (int j = 0; j < 8; ++j) { const f32x2 u = x[j], v = x[j + 8]; x[j] = u + v; x[j + 8] = cmul(u - v, cmul(t0, W16[j])); }
#pragma unroll
        for (int g = 0; g < 2; ++g)
#pragma unroll
            for (int j = 0; j < 4; ++j) { const f32x2 u = x[8 * g + j], v = x[8 * g + j + 4]; x[8 * g + j] = u + v; x[8 * g + j + 4] = cmul(u - v, cmul(t1, W16[2 * j])); }
#pragma unroll
        for (int g = 0; g < 4; ++g)
#pragma unroll
            for (int j = 0; j < 2; ++j) { const f32x2 u = x[4 * g + j], v = x[4 * g + j + 2]; x[4 * g + j] = u + v; x[4 * g + j + 2] = cmul(u - v, cmul(t2, W16[4 * j])); }
#pragma unroll
        for (int g = 0; g < 8; ++g) { const f32x2 u = x[2 * g], v = x[2 * g + 1]; x[2 * g] = u + v; x[2 * g + 1] = cmul(u - v, t3); }
    } else {
#pragma unroll
        for (int g = 0; g < 8; ++g) { const f32x2 u = x[2 * g], t = cmulc(x[2 * g + 1], t3); x[2 * g] = u + t; x[2 * g + 1] = u - t; }
#pragma unroll
        for (int g = 0; g < 4; ++g)
#pragma unroll
            for (int j = 0; j < 2; ++j) { const f32x2 u = x[4 * g + j], t = cmulc(x[4 * g + j + 2], cmul(t2, W16[4 * j])); x[4 * g + j] = u + t; x[4 * g + j + 2] = u - t; }
#pragma unroll
        for (int g = 0; g < 2; ++g)
#pragma unroll
            for (int j = 0; j < 4; ++j) { const f32x2 u = x[8 * g + j], t = cmulc(x[8 * g + j + 4], cmul(t1, W16[2 * j])); x[8 * g + j] = u + t; x[8 * g + j + 4] = u - t; }
#pragma unroll
        for (int j = 0; j < 8; ++j) { const f32x2 u = x[j], t = cmulc(x[j + 8], cmul(t0, W16[j])); x[j] = u + t; x[j + 8] = u - t; }
    }
}
struct FftTw { f32x2 t[3][4]; };
__device__ __forceinline__ void fft_load_tw(FftTw& w, const f32x2* __restrict__ TW, int tid) {
#pragma unroll
    for (int p = 0; p < 3; ++p) { const int r = p == 0 ? tid : p == 1 ? (tid & 31) : (tid & 1);
#pragma unroll
        for (int k = 0; k < 4; ++k) w.t[p][k] = TW[(8192 - (8192 >> (4 * p + k))) + r]; }
}
template <int PASS, bool INV, bool SYNC> __device__ __forceinline__ void fft_pass(LAS f32x2* X, const FftTw& w, int tid) {
    asm volatile("" : "+v"(tid));
    constexpr int stride = PASS == 0 ? 512 : PASS == 1 ? 32 : 2;
    const int r = PASS == 0 ? tid : PASS == 1 ? (tid & 31) : (tid & 1);
    const int base = PASS == 0 ? tid : PASS == 1 ? ((tid >> 5) * 512 + r) : ((tid >> 1) * 32 + r);
    f32x2 x[16];
#pragma unroll
    for (int j = 0; j < 16; ++j) x[j] = X[fphys(base + j * stride)];
    f32x2 t0 = w.t[PASS][0], t1 = w.t[PASS][1], t2 = w.t[PASS][2], t3 = w.t[PASS][3];
    asm volatile("" : "+v"(t0.x), "+v"(t0.y), "+v"(t1.x), "+v"(t1.y), "+v"(t2.x), "+v"(t2.y), "+v"(t3.x), "+v"(t3.y));
    radix16<INV>(x, t0, t1, t2, t3);
#pragma unroll
    for (int j = 0; j < 16; ++j) X[fphys(base + j * stride)] = x[j];
    if (SYNC) __syncthreads(); else asm volatile("s_waitcnt lgkmcnt(0)" ::: "memory");
}
__device__ __forceinline__ int fft_pair(int tid, int q) { return (tid >> 1) * 16 + (tid & 1) * 8 + q; }
__device__ __forceinline__ void fft_fwd_full(LAS f32x2* X, const FftTw& TW, int tid) {
    fft_pass<0, false, true>(X, TW, tid); fft_pass<1, false, false>(X, TW, tid); fft_pass<2, false, false>(X, TW, tid);
    asm volatile("" : "+v"(tid));
#pragma unroll
    for (int q = 0; q < 8; ++q) { const int m = fft_pair(tid, q); LAS f32x4* p = (LAS f32x4*)(X + fphys(2 * m)); const f32x4 v = *p; *p = (f32x4){v.x + v.z, v.y + v.w, v.x - v.z, v.y - v.w}; }
    __syncthreads();
}
__device__ __forceinline__ void fft_conv(LAS f32x2* X, const LAS f32x2* Gs, const FftTw& TW, int tid) {
    fft_pass<0, false, true>(X, TW, tid); fft_pass<1, false, false>(X, TW, tid); fft_pass<2, false, false>(X, TW, tid);
    asm volatile("" : "+v"(tid));
#pragma unroll 2
    for (int q = 0; q < 8; ++q) { const int m = fft_pair(tid, q); LAS f32x4* p = (LAS f32x4*)(X + fphys(2 * m)); const f32x4 v = *p; const f32x4 g = *(const LAS f32x4*)(Gs + fphys(2 * m));
        const f32x2 a = cmul((f32x2){v.x + v.z, v.y + v.w}, (f32x2){g.x, g.y}), b = cmul((f32x2){v.x - v.z, v.y - v.w}, (f32x2){g.z, g.w});
        *p = (f32x4){a.x + b.x, a.y + b.y, a.x - b.x, a.y - b.y}; }
    asm volatile("s_waitcnt lgkmcnt(0)" ::: "memory");
    fft_pass<2, true, false>(X, TW, tid); fft_pass<1, true, true>(X, TW, tid); fft_pass<0, true, true>(X, TW, tid);
}

__device__ __forceinline__ float conv3(const bf16_t* __restrict__ p, int t, int L, float w0, float w1, float w2, float bias) {
    float r = bias + w1 * bf2f(p[t]); if (t > 0) r += w0 * bf2f(p[t - 1]); if (t < L - 1) r += w2 * bf2f(p[t + 1]); return r;
}


#define XB_TMO      128
#define XB_XCNT(j)  (256  + 64 * (j))
#define XB_XSUB(j)  (1280 + 64 * (j))
#define XB_XGEN(j)  (2304 + 64 * (j))
#define XB_TOP      3328
#define XB_TOPGEN   3392
#define XCD_BAR_WORDS 3456
#define XB_SPIN_CAP (1u << 22)
__device__ __forceinline__ unsigned xb_ld(unsigned* p)              { return __hip_atomic_load(p, __ATOMIC_RELAXED, __HIP_MEMORY_SCOPE_AGENT); }
__device__ __forceinline__ unsigned xb_add(unsigned* p, unsigned v) { return __hip_atomic_fetch_add(p, v, __ATOMIC_RELAXED, __HIP_MEMORY_SCOPE_AGENT); }
__device__ __forceinline__ unsigned xb_xcc_id() { return (unsigned)__builtin_amdgcn_s_getreg((3 << 11) | 20) & 0xFu; }
#define XB_SPIN(cond, bar) do { unsigned _sp = 0; while (cond) { __builtin_amdgcn_s_sleep(1); \
    if ((++_sp & 255u) == 0u) { if (xb_ld(&(bar)[XB_TMO])) break; if (_sp > XB_SPIN_CAP) { atomicAdd(&(bar)[XB_TMO], 1u); break; } } } } while (0)
__device__ __forceinline__ void xcd_barrier_complete(unsigned* bar, unsigned x, unsigned& nloc, unsigned& nx) {
    const unsigned G = gridDim.x;
    unsigned sum, cnt, mine, sp = 0u;
    for (;;) {
        sum = 0u; cnt = 0u; mine = 0u;
#pragma unroll
        for (unsigned j = 0; j < 16; ++j) { const unsigned c = xb_ld(&bar[XB_XCNT(j)]); sum += c; cnt += (c > 0u) ? 1u : 0u; mine = (j == x) ? c : mine; }
        if (sum == G) break;
        __builtin_amdgcn_s_sleep(1);
        if ((++sp & 255u) == 0u) { if (xb_ld(&bar[XB_TMO])) break; if (sp > XB_SPIN_CAP) { atomicAdd(&bar[XB_TMO], 1u); break; } }
    }
    nloc = mine > 0u ? mine : 1u; nx = cnt > 0u ? cnt : 1u;
}
__device__ __forceinline__ void xcd_barrier(unsigned* bar, volatile LAS unsigned* st, bool first) {
    asm volatile("s_waitcnt vmcnt(0)" ::: "memory");
    __syncthreads();
    if (first) {
        const unsigned x = xb_xcc_id();
        __builtin_amdgcn_s_waitcnt(0);
        unsigned nloc = st[0], nx = st[1];
        if (nloc == 0u) { xcd_barrier_complete(bar, x, nloc, nx); st[0] = nloc; st[1] = nx; }
        const unsigned old = xb_add(&bar[XB_XSUB(x)], 1u);
        const unsigned gen = old / nloc;
        if (old + 1u == (gen + 1u) * nloc) {
            __builtin_amdgcn_fence(__ATOMIC_RELEASE, "agent");
            asm volatile("s_waitcnt vmcnt(0)" ::: "memory");
            const unsigned og = xb_add(&bar[XB_TOP], 1u);
            const unsigned tg = og / nx;
            if (og + 1u == (tg + 1u) * nx) xb_add(&bar[XB_TOPGEN], 1u);
            else XB_SPIN(xb_ld(&bar[XB_TOPGEN]) == tg, bar);
            __builtin_amdgcn_fence(__ATOMIC_ACQUIRE, "agent");
            xb_add(&bar[XB_XGEN(x)], 1u);
            asm volatile("s_waitcnt vmcnt(0)" ::: "memory");
        } else {
            XB_SPIN(xb_ld(&bar[XB_XGEN(x)]) == gen, bar);
            __builtin_amdgcn_fence(__ATOMIC_ACQUIRE, "agent");
            asm volatile("s_waitcnt vmcnt(0)" ::: "memory");
        }
    }
    __syncthreads();
}
template <int OFF> __device__ __forceinline__ unsigned long long karg() {
    unsigned long long v;
    asm volatile("s_load_dwordx2 %0, %1, %2\n\ts_waitcnt lgkmcnt(0)" : "=s"(v) : "s"(__builtin_amdgcn_kernarg_segment_ptr()), "n"(OFF) : "memory");
    return v;
}
__global__ void __launch_bounds__(NTHREADS, 2) fwd_kernel(Args args) {
    extern __shared__ __attribute__((aligned(16))) unsigned char lds_raw[];
    LAS unsigned char* lds = (LAS unsigned char*)lds_raw;
    const int WAVE_S = __builtin_amdgcn_readfirstlane((int)threadIdx.x >> 6);
#define XB_ST ((volatile LAS unsigned*)(lds + LDS_BYTES - 16))
#define XB_BAR ((unsigned*)ws + 4096)
#define XB_FIRST(res) do { int l_; asm volatile("v_mbcnt_lo_u32_b32 %0, -1, 0\n\tv_mbcnt_hi_u32_b32 %0, -1, %0" : "=v"(l_)); res = (WAVE_S == 0) && (l_ == 0); } while (0)
    typedef __attribute__((address_space(1))) unsigned char gbyte_t; typedef __attribute__((address_space(1))) const float gcfloat_t; typedef __attribute__((address_space(1))) float gfloat_t;
    unsigned char* const ws = (unsigned char*)(gbyte_t*)karg<256>();
    { bool f_; XB_FIRST(f_); if (f_) { XB_ST[0] = 0u; XB_ST[1] = 0u; (void)xb_add(&XB_BAR[XB_XCNT(xb_xcc_id())], 1u); } __syncthreads(); }
#define GRID_BAR() do { bool f_; XB_FIRST(f_); xcd_barrier(XB_BAR, XB_ST, f_); } while (0)
#define INP(i) ((const float*)(gcfloat_t*)karg<(i) * 8>())
#define OUT ((float*)(gfloat_t*)karg<248>())
#define MOD ((float*)(ws + WS_MOD))
#define TW ((const f32x2*)(ws + WS_TW))
#define TWW ((f32x2*)(ws + WS_TW))
#define H2L ((float*)(ws + WS_H2L))
#define H2C ((float*)(ws + WS_H2C))
#define MODP ((float*)(ws + WS_MODP))
#define KROPE ((float*)(ws + WS_KROPE))
#define GATES ((float*)(ws + WS_GATES))
#define MLN ((float*)(ws + WS_MLN))
#define XC ((float*)(ws + WS_XC))
#define WIN ((bf16_t*)(ws + WS_WIN))
#define WUQ ((bf16_t*)(ws + WS_WUQ))
#define WUKV ((bf16_t*)(ws + WS_WUKV))
#define WOUT ((bf16_t*)(ws + WS_WOUT))
#define W1 ((bf16_t*)(ws + WS_W1))
#define W2 ((bf16_t*)(ws + WS_W2))
#define ABUF ((bf16_t*)(ws + WS_A))
#define CQ ((bf16_t*)(ws + WS_CQ))
#define CKV ((bf16_t*)(ws + WS_CKV))
#define HYT ((const bf16_t*)(ws + WS_HYT))
#define HYTC ((const bf16_t*)(ws + WS_HYTC))
#define MLQK ((bf16_t*)(ws + WS_MLQK))
#define MLQK2 ((bf16_t*)(ws + WS_MLQK2))
#define MLV ((bf16_t*)(ws + WS_MLV))
#define MLO ((bf16_t*)(ws + WS_MLO))
#define QRAW ((bf16_t*)(ws + WS_QRAW))
#define KVRAW ((bf16_t*)(ws + WS_KVRAW))
#define QB ((bf16_t*)(ws + WS_Q))
#define QCB ((bf16_t*)(ws + WS_QC))
#define KB ((bf16_t*)(ws + WS_K))
#define VB ((bf16_t*)(ws + WS_V))
#define AO ((bf16_t*)(ws + WS_AO))
#define FILT ((float*)(ws + WS_Q))
#define YT ((bf16_t*)(ws + WS_YT))
#define YTC ((bf16_t*)(ws + WS_YTC))
#define CST ((float*)(ws + WS_CST))
#define HF ((bf16_t*)(ws + WS_HF))
#define HB ((bf16_t*)(ws + WS_HB))
#define HID ((bf16_t*)(ws + WS_HID))
#define MLOC ((float*)(ws + WS_MLS))
#define BLAST ((float*)(ws + WS_MLS) + 1088)
#define MIN_ ((float*)(ws + WS_MLS) + 2176)
#ifndef PMASK
#define PMASK 0xFFFFu
#endif
#define PH_BEGIN(n) { if constexpr ((PMASK >> (n)) & 1u) { int tid; asm volatile("v_mbcnt_lo_u32_b32 %0, -1, 0\n\tv_mbcnt_hi_u32_b32 %0, -1, %0" : "=v"(tid)); tid += WAVE_S * 64; \
    const int lane = tid & 63, wave = __builtin_amdgcn_readfirstlane(tid >> 6); const int G = gridDim.x, bid = blockIdx.x, gw = bid * NWAVES + wave, NGW = G * NWAVES; \
    const long gtid = (long)bid * NTHREADS + tid, GT = (long)G * NTHREADS; const int r32 = lane & 31, hi = lane >> 5; (void)gw; (void)NGW; (void)gtid; (void)GT; (void)r32; (void)hi;
#define PH_END } } GRID_BAR(); for (int ds_ = 0; ds_ < DUP_SYNC; ++ds_) GRID_BAR();

#define CONVERT_WEIGHTS(l) do { LAS float* scr = (LAS float*)(lds + wave * 8448); \
        constexpr int I0 = 32 * 152, I1 = 8 * 48, I2 = 8 * 64, I3 = 32 * 64, I4 = 32 * 352, I5 = 88 * 64; \
        for (int it = gw; it < I0 + I1 + I2 + I3 + I4 + I5; it += NGW) { int r = it; \
            if (r < I0) { wt_item(INP(I_WIN) + (size_t)(l) * DM * NIN, NIN, DM, WIN, nullptr, scr, r / 152, r % 152, lane, MapWin()); continue; } r -= I0; \
            if (r < I1) { wt_item(INP(I_WUQ) + (size_t)(l) * 512 * 1536, 1536, 512, WUQ, INP(I_QAN) + (l) * 512, scr, r / 48, r % 48, lane, MapIdent()); continue; } r -= I1; \
            if (r < I2) { wt_item(INP(I_WUKV) + (size_t)(l) * 512 * 2048, 2048, 512, WUKV, INP(I_KVAN) + (l) * 512, scr, r / 64, r % 64, lane, MapIdent()); continue; } r -= I2; \
            if (r < I3) { wt_item(INP(I_WOUT) + (size_t)(l) * DM * DM, DM, DM, WOUT, nullptr, scr, r / 64, r % 64, lane, MapIdent()); continue; } r -= I3; \
            if (r < I4) { wt_item(INP(I_FW1) + (size_t)(l) * DM * 2 * FFH, 2 * FFH, DM, W1, nullptr, scr, r / 352, r % 352, lane, MapW1()); continue; } r -= I4; \
            wt_item(INP(I_FW2) + (size_t)(l) * FFH * DM, DM, FFH, W2, nullptr, scr, r / 64, r % 64, lane, MapIdent()); } } while (0)


#define BUILD_FILTERS(l) do { LAS float* w3t = (LAS float*)lds; LAS float* h2t = (LAS float*)(lds + 16384 + 256); \
        const float* w3g = INP(I_HW3) + (size_t)(l) * 64 * 2048; const float* decg = INP(I_HDEC) + (size_t)(l) * 2048; const float* h2g = H2L + (size_t)(l) * SEQ * 64; \
        for (int it = bid; it < 1024; it += G) { const int ob_ = (it & 31) * 64, tb_ = (it >> 5) * 128; \
            __syncthreads(); \
            _Pragma("unroll") for (int q = 0; q < 8; ++q) { const int e = tid + NTHREADS * q; w3t[(e >> 6) * 65 + (e & 63)] = w3g[(size_t)(e >> 6) * 2048 + ob_ + (e & 63)]; } \
            _Pragma("unroll") for (int q = 0; q < 4; ++q) { const int e = tid + NTHREADS * q; *(LAS f32x4*)(h2t + 4 * e) = *(const f32x4*)(h2g + (size_t)tb_ * 64 + 4 * e); } \
            __syncthreads(); \
            const int to = tid & 63, tq = tid >> 6; float acc[16]; \
            _Pragma("unroll") for (int k = 0; k < 16; ++k) acc[k] = 0.f; \
            _Pragma("unroll 2") for (int i4 = 0; i4 < 16; ++i4) { const float w0 = w3t[(4 * i4) * 65 + to], w1 = w3t[(4 * i4 + 1) * 65 + to], w2 = w3t[(4 * i4 + 2) * 65 + to], w3v = w3t[(4 * i4 + 3) * 65 + to]; \
                _Pragma("unroll") for (int k = 0; k < 16; ++k) { const f32x4 hv = *(const LAS f32x4*)(h2t + (tq * 16 + k) * 64 + 4 * i4); acc[k] += hv.x * w0 + hv.y * w1 + hv.z * w2 + hv.w * w3v; } } \
            const float dc = decg[ob_ + to]; float* dst = FILT + (size_t)(ob_ + to) * 4096 + tb_ + tq * 16; \
            _Pragma("unroll") for (int k4 = 0; k4 < 4; ++k4) { f32x4 o; \
                _Pragma("unroll") for (int k = 0; k < 4; ++k) { const float tn = (float)(tb_ + tq * 16 + 4 * k4 + k) * (1.f / 4096.f); o[k] = acc[4 * k4 + k] * (expf(-tn * dc) + 0.05f); } \
                *(f32x4*)(dst + 4 * k4) = o; } } \
        __syncthreads(); } while (0)

#define NORM_ROWS(l, gptr, si, nrows, xsrc) do { const float* gp_ = (gptr); const float* const xo_ = (xsrc); for (int rp_ = 0; rp_ <= DUP_NORM; ++rp_) for (int r = gw; r < (nrows); r += NGW) { \
        const float* xr = r < ML ? xo_ + (size_t)r * DM : XC + (size_t)(r - ML) * DM; const float* mrow = MOD + ((size_t)(l) * 5 + (r < ML ? (r >> 12) : 4)) * 12288; \
        f32x4 v[8]; float ss = 0.f; \
        _Pragma("unroll") for (int j = 0; j < 8; ++j) { v[j] = *(const f32x4*)(xr + 4 * lane + 256 * j); ss += v[j].x * v[j].x + v[j].y * v[j].y + v[j].z * v[j].z + v[j].w * v[j].w; } \
        const float rs = rsqrtf(wave_sum(ss) * (1.f / DM) + EPS); \
        _Pragma("unroll") for (int j = 0; j < 8; ++j) { const int c = 4 * lane + 256 * j; const f32x4 g = *(const f32x4*)(gp_ + c), sh = *(const f32x4*)(mrow + (si) * DM + c), sc = *(const f32x4*)(mrow + ((si) + 1) * DM + c); \
            const f32x4 y = (v[j] * rs * g) * (sc + 1.f) + sh; pg8::st_bf16x4(ABUF + (size_t)r * DM + c, y); } } } while (0)

    PH_BEGIN(0)
    for (int rg_ = 0; rg_ <= DUP_G0; ++rg_) {
        { const f32x4* s2 = (const f32x4*)INP(I_CTX); f32x4* d2 = (f32x4*)XC; for (long i = gtid; i < (long)MC * DM / 4; i += GT) d2[i] = s2[i]; }
        { LAS float* sc = (LAS float*)lds;
          for (int it = bid; it < 2 * 32 * 12; it += G) { const int nc = it % 12, kc = (it / 12) % 32, l = it / 384;
            __syncthreads();
            if (tid < 320) { const float* cp = INP(I_C); const float* ccp = INP(I_CCTX); const int i = tid >> 6, k = kc * 64 + (tid & 63); const float cv = i < 4 ? cp[i * DM + k] : ccp[k]; sc[tid] = siluf(cv); }
            __syncthreads();
            const int n = nc * 1024 + tid * 2; const float* wp = INP(I_ADAW) + ((size_t)l * DM + kc * 64) * 12288 + n;
            f32x2 a0 = {0.f, 0.f}, a1 = a0, a2 = a0, a3 = a0, a4 = a0;
#pragma unroll 8
            for (int k = 0; k < 64; ++k) { const f32x2 w = *(const f32x2*)(wp + (size_t)k * 12288); a0 += w * sc[k]; a1 += w * sc[64 + k]; a2 += w * sc[128 + k]; a3 += w * sc[192 + k]; a4 += w * sc[256 + k]; }
            float* o = MODP + (((size_t)kc * 2 + l) * 5) * 12288 + n;
            *(f32x2*)(o) = a0; *(f32x2*)(o + 12288) = a1; *(f32x2*)(o + 2 * 12288) = a2; *(f32x2*)(o + 3 * 12288) = a3; *(f32x2*)(o + 4 * 12288) = a4; }
          __syncthreads(); }
        for (long e = gtid; e < 8191; e += GT) { int s = 0; while (e >= 8192 - (8192 >> (s + 1))) ++s; const int pos = (int)e - (8192 - (8192 >> s));
            float sn, cs; sincospif((float)(pos << s) * (1.f / 4096.f), &sn, &cs); TWW[e] = (f32x2){cs, -sn}; }
        for (int it = gw; it < 2 * (SEQ + CTXL); it += NGW) { const int l = it / (SEQ + CTXL), rr = it % (SEQ + CTXL); const bool isc = rr >= SEQ; const int t = isc ? rr - SEQ : rr; const float Lf = isc ? 256.f : 4096.f;
            float feat = 0.f;
            if (lane == 0) feat = (float)t / Lf; else if (lane <= 16) feat = cospif(2.f * (float)(t * lane) / Lf); else if (lane <= 32) feat = sinpif(2.f * (float)(t * (lane - 16)) / Lf);
            const float* w1 = INP(I_HW1) + (size_t)l * 33 * 64; float a = INP(I_HB1)[l * 64 + lane];
            for (int i = 0; i < 33; ++i) a += __int_as_float(__builtin_amdgcn_readlane(__float_as_int(feat), i)) * w1[i * 64 + lane];
            const float h1 = sinf(a);
            const float* w2 = INP(I_HW2) + (size_t)l * 64 * 64; float a2 = INP(I_HB2)[l * 64 + lane];
            for (int i = 0; i < 64; ++i) a2 += __int_as_float(__builtin_amdgcn_readlane(__float_as_int(h1), i)) * w2[i * 64 + lane];
            (isc ? H2C + ((size_t)l * CTXL + t) * 64 : H2L + ((size_t)l * SEQ + t) * 64)[lane] = sinf(a2); }
        __syncthreads();
        CONVERT_WEIGHTS(0);
    }
    PH_END
    cg::this_grid().sync();
    PH_BEGIN(1)
    for (int rg_ = 0; rg_ <= DUP_G1; ++rg_) {
        for (long e = gtid; e < 2 * 5 * 12288; e += GT) { const int n = (int)(e % 12288), l = (int)(e / (5 * 12288)); float a = INP(I_ADAB)[l * 12288 + n];
            for (int kc = 0; kc < 32; ++kc) a += MODP[(size_t)kc * 2 * 5 * 12288 + e]; MOD[e] = a; }
        BUILD_FILTERS(0);
    }
    PH_END

    { constexpr int l = 0; constexpr bool need_ctx = (l == 0);
        PH_BEGIN(2)
            NORM_ROWS(l, INP(I_N1G) + l * DM, 0, MT, (l == 0 ? (float*)INP(I_X) : OUT));
            if (l == 1) { __syncthreads(); CONVERT_WEIGHTS(1); __syncthreads(); BUILD_FILTERS(1); }
        PH_END
        PH_BEGIN(3)
            pg8::Gemm g{ABUF, WIN, MT, NINP, DM}; pg8::EpiInProj E{ws};
            if constexpr (l == 0) { pg8::StaticOrder S; S.init(MT, NINP, G, bid, DM); for (int rp_ = 0; rp_ <= DUP_INPROJ; ++rp_) pg8::gemm_phase<pg8::EpiInProj, pg8::StaticOrder, true, true>(lds, g, S, E, tid); }
            else { pg8::InProjL1Order S; S.init(G, bid, DM); for (int rp_ = 0; rp_ <= DUP_INPROJ; ++rp_) pg8::gemm_phase<pg8::EpiInProj, pg8::InProjL1Order, true, true>(lds, g, S, E, tid); }
        PH_END
        PH_BEGIN(4)
            { pg8::Gemm g{CQ, WUQ, MT, 1536, 512, CKV, WUKV}; pg8::DualUpOrder S; S.init(G, bid); pg8::EpiUp E{ws};
              for (int rp_ = 0; rp_ <= DUP_UP; ++rp_) pg8::gemm_phase<pg8::EpiUp, pg8::DualUpOrder, true, true>(lds, g, S, E, tid); }
            { const float* cw = INP(I_MCW) + (size_t)l * 3 * 1024; const float* cb = INP(I_MCB) + (size_t)l * 1024;
              for (int rp_ = 0; rp_ <= DUP_M0; ++rp_)
              for (long e = gtid; e < (long)MT * 128; e += GT) { const int r = (int)(e >> 7), c8 = (int)(e & 127) * 8;
                int t, L; if (r < ML) { t = r & 4095; L = SEQ; } else { t = (r - ML) & 255; L = CTXL; }
                const bf16x8 z = {0, 0, 0, 0, 0, 0, 0, 0};
                const bf16x8 xm = *(const bf16x8*)(MLQK + (size_t)r * 1024 + c8), xp = t > 0 ? *(const bf16x8*)(MLQK + (size_t)(r - 1) * 1024 + c8) : z, xn = t < L - 1 ? *(const bf16x8*)(MLQK + (size_t)(r + 1) * 1024 + c8) : z;
                float y[8]; const float qs = c8 < 512 ? 0.08838834764831845f : 1.f;
#pragma unroll
                for (int i = 0; i < 8; ++i) { const int c = c8 + i; y[i] = siluf(cb[c] + cw[c] * bf2f_s(xp[i]) + cw[1024 + c] * bf2f_s(xm[i]) + cw[2048 + c] * bf2f_s(xn[i])) * qs; }
                u32x4 o; o.x = cvtpk(y[0], y[1]); o.y = cvtpk(y[2], y[3]); o.z = cvtpk(y[4], y[5]); o.w = cvtpk(y[6], y[7]); *(u32x4*)(MLQK2 + (size_t)r * 1024 + c8) = o; } }
            { LAS f32x2* X = (LAS f32x2*)lds; LAS f32x2* Gs = (LAS f32x2*)(lds + FFT_SLOTS * 8); LAS float* w3s = (LAS float*)(lds + 2 * FFT_SLOTS * 8);
              const float* hcw = INP(I_HCW) + (size_t)l * 3 * 1536; const float* hcb = INP(I_HCB) + (size_t)l * 1536;
              const float* w3 = INP(I_HW3) + (size_t)l * 64 * 2048; const float* dec = INP(I_HDEC) + (size_t)l * 2048; const float* skip = INP(I_HSKIP) + (size_t)l * 1024;
              const float* H2 = H2L + (size_t)l * SEQ * 64;
              FftTw ftw; fft_load_tw(ftw, TW, tid);
              for (int rep_ = 0; rep_ <= DUP_HY; ++rep_)
              for (int c0 = bid; c0 < 512; c0 += G) { int c = c0; asm volatile("" : "+s"(c));
                const float vw0 = hcw[c], vw1 = hcw[1536 + c], vw2 = hcw[3072 + c], vbb = hcb[c];
                for (int n = 0; n < 2; ++n) {
                    const int of = n * 1024 + c, ob = n * 1024 + 512 + c;
                    __syncthreads();
                    { const float* ff = FILT + (size_t)of * 4096; const float* fb = FILT + (size_t)ob * 4096;
#pragma unroll 2
                      for (int q = 0; q < 8; ++q) { const int t = tid + 512 * q; Gs[fphys(t)] = (f32x2){ff[t], 0.f};
                        if (t == 0) Gs[fphys(4096)] = (f32x2){0.f, 0.f}; else Gs[fphys(8192 - t)] = (f32x2){fb[t], 0.f}; } }
                    __syncthreads();
                    fft_fwd_full(Gs, ftw, tid);
                    const float sk = skip[n * 512 + c];
                    const int gch = (n + 1) * 512 + c;
                    const float gw0 = hcw[gch], gw1 = hcw[1536 + gch], gw2 = hcw[3072 + gch], gbb = hcb[gch];
#pragma unroll 1
                    for (int bp = 0; bp < 2; ++bp) {
                        const bf16_t* u0 = HYT + ((size_t)((2 * bp) * 1536 + c)) * 4096; const bf16_t* u1 = HYT + ((size_t)((2 * bp + 1) * 1536 + c)) * 4096;
                        bf16_t* y0p = YT + ((size_t)((2 * bp) * 512 + c)) * 4096; bf16_t* y1p = YT + ((size_t)((2 * bp + 1) * 512 + c)) * 4096;
                        const bf16_t* g0p = HYT + ((size_t)((2 * bp) * 1536 + gch)) * 4096; const bf16_t* g1p = HYT + ((size_t)((2 * bp + 1) * 1536 + gch)) * 4096;
                        f32x2 zq[8], gq[8];
#pragma unroll
                        for (int q = 0; q < 8; ++q) { const int t = tid + 512 * q;
                            if (n == 0) { zq[q].x = conv3(u0, t, SEQ, vw0, vw1, vw2, vbb); zq[q].y = conv3(u1, t, SEQ, vw0, vw1, vw2, vbb); } else { zq[q].x = bf2f(y0p[t]); zq[q].y = bf2f(y1p[t]); }
                            gq[q].x = conv3(g0p, t, SEQ, gw0, gw1, gw2, gbb); gq[q].y = conv3(g1p, t, SEQ, gw0, gw1, gw2, gbb); }
#pragma unroll
                        for (int q = 0; q < 8; ++q) { const int t = tid + 512 * q; X[fphys(t)] = zq[q]; X[fphys(4096 + t)] = (f32x2){0.f, 0.f}; }
                        __syncthreads();
                        fft_conv(X, Gs, ftw, tid);
#pragma unroll
                        for (int q = 0; q < 8; ++q) { const int t = tid + 512 * q; const f32x2 y = X[fphys(t)] * (1.f / 8192.f);
                            y0p[t] = f2bf(gq[q].x * (y.x + sk * zq[q].x)); y1p[t] = f2bf(gq[q].y * (y.y + sk * zq[q].y)); }
                        __syncthreads();
                    }
                }
              }
              if (need_ctx) {
                LAS float* hf = (LAS float*)lds;
                LAS float* zs = (LAS float*)(lds + 4096);
                LAS float* w3c = (LAS float*)(lds + 8192);
                const float* H2c = H2C + (size_t)l * CTXL * 64;
                for (int c = bid; c < 512; c += G) {
                    __syncthreads();
                    if (tid < 256) { const int f = tid >> 6, i = tid & 63; w3c[tid] = w3[i * 2048 + (f >> 1) * 1024 + (f & 1) * 512 + c]; }
                    __syncthreads();
                    for (int e = tid; e < 1024; e += NTHREADS) { const int f = e >> 8, t = e & 255; const int o = (f >> 1) * 1024 + (f & 1) * 512 + c; float a = 0.f;
                        for (int i = 0; i < 64; ++i) a += H2c[t * 64 + i] * w3c[f * 64 + i];
                        hf[e] = a * (expf(-((float)t * (1.f / 256.f)) * dec[o]) + 0.05f); }
                    const int b = tid >> 7; float zv[2], zc[2];
#pragma unroll
                    for (int q = 0; q < 2; ++q) { const int t = (tid & 127) + 128 * q; zv[q] = conv3(HYTC + ((size_t)(b * 1536 + c)) * 256, t, CTXL, hcw[c], hcw[1536 + c], hcw[3072 + c], hcb[c]); zs[b * 256 + t] = zv[q]; }
                    __syncthreads();
                    for (int n = 0; n < 2; ++n) { const LAS float* gf = hf + n * 512; const LAS float* gb = hf + n * 512 + 256; const int gch = (n + 1) * 512 + c;
#pragma unroll
                        for (int q = 0; q < 2; ++q) { const int t = (tid & 127) + 128 * q; float y = 0.f;
                            for (int s = 0; s <= t; ++s) y += zs[b * 256 + s] * gf[t - s];
                            for (int s = t + 1; s < 256; ++s) y += zs[b * 256 + s] * gb[s - t];
                            const float gate = conv3(HYTC + ((size_t)(b * 1536 + gch)) * 256, t, CTXL, hcw[gch], hcw[1536 + gch], hcw[3072 + gch], hcb[gch]);
                            zc[q] = gate * (y + skip[n * 512 + c] * zv[q]); }
                        __syncthreads();
#pragma unroll
                        for (int q = 0; q < 2; ++q) { const int t = (tid & 127) + 128 * q; zv[q] = zc[q]; if (n == 0) zs[b * 256 + t] = zc[q]; else YTC[((size_t)(b * 512 + c)) * 256 + t] = f2bf(zc[q]); }
                        __syncthreads(); }
                }
              }
            }
        PH_END
        PH_BEGIN(5)
            { LAS f32x2* rtab = (LAS f32x2*)lds;
              __syncthreads();
              for (int e = tid; e < 1024; e += NTHREADS) { const float ang = (float)(e >> 4) * powf(10000.f, -(float)(e & 15) * (1.f / 16.f)); rtab[e] = (f32x2){cosf(ang), sinf(ang)}; }
              __syncthreads();
              const int l16 = lane & 15, ts = lane >> 4; const bool xhi = l16 >= 8, rowax = (l16 & 7) < 4; const int f0 = 4 * (l16 & 3);
              const float* qg = INP(I_QN) + l * 192; const float* kg = INP(I_KN) + l * 192;
              float qgn[8], kgn[8], qgr[4], kgr[4];
#pragma unroll
              for (int i = 0; i < 8; ++i) { qgn[i] = qg[8 * l16 + i]; kgn[i] = kg[8 * l16 + i]; }
#pragma unroll
              for (int i = 0; i < 4; ++i) { qgr[i] = qg[128 + 4 * l16 + i]; kgr[i] = kg[128 + 4 * l16 + i]; }
#define RED16(v) do { v += swz_xor<1>(v); v += swz_xor<2>(v); v += swz_xor<4>(v); v += swz_xor<8>(v); } while (0)
              for (int rp_ = 0; rp_ <= DUP_POST; ++rp_)
              for (int r0 = gw * 4; r0 < MT; r0 += NGW * 4) { const int r = r0 + ts;
                int b, t, key; const bool isl = r < ML; if (isl) { b = r >> 12; t = r & 4095; key = CTXL + t; } else { b = (r - ML) >> 8; t = (r - ML) & 255; key = t; }
                const bf16_t* qrow = QRAW + (size_t)r * 1536; const bf16_t* kvrow = KVRAW + (size_t)r * 2048;
                bf16x8 cqv[4], ckv4[4], qn_[8], kn_[8], vn_[8]; u32x2 qr_[8];
#pragma unroll
                for (int i = 0; i < 4; ++i) { cqv[i] = *(const bf16x8*)(CQ + (size_t)r * 512 + 32 * l16 + 8 * i); ckv4[i] = *(const bf16x8*)(CKV + (size_t)r * 512 + 32 * l16 + 8 * i); }
                const f32x4 krv = *(const f32x4*)(KROPE + (size_t)r * 64 + 4 * l16);
#pragma unroll
                for (int h = 0; h < 8; ++h) { qn_[h] = *(const bf16x8*)(qrow + h * 192 + 8 * l16); qr_[h] = *(const u32x2*)(qrow + h * 192 + 128 + 4 * l16);
                    kn_[h] = *(const bf16x8*)(kvrow + h * 256 + 8 * l16); vn_[h] = *(const bf16x8*)(kvrow + h * 256 + 128 + 8 * l16); }
                float ssq = 0.f, sskv = 0.f;
#pragma unroll
                for (int i = 0; i < 4; ++i)
#pragma unroll
                    for (int e = 0; e < 8; ++e) { const float x = bf2f_s(cqv[i][e]), y = bf2f_s(ckv4[i][e]); ssq += x * x; sskv += y * y; }
                RED16(ssq); RED16(sskv);
                const float rsq = rsqrtf(ssq * (1.f / 512.f) + EPS), rskv = rsqrtf(sskv * (1.f / 512.f) + EPS);
                float cs[4], sn[4];
#pragma unroll
                for (int i = 0; i < 4; ++i) { cs[i] = 1.f; sn[i] = 0.f; }
                if (isl) { const int pos = rowax ? (t >> 6) : (t & 63);
#pragma unroll
                    for (int i = 0; i < 4; ++i) { const f32x2 e = rtab[pos * 16 + f0 + i]; cs[i] = e.x; sn[i] = e.y; } }
                float krss = krv.x * krv.x + krv.y * krv.y + krv.z * krv.z + krv.w * krv.w;
#pragma unroll
                for (int h = 0; h < 8; ++h) {
                    float xn[8], xr[4]; float ss = 0.f;
#pragma unroll
                    for (int i = 0; i < 8; ++i) { xn[i] = bf2f_s(qn_[h][i]) * rsq; ss += xn[i] * xn[i]; }
                    xr[0] = __uint_as_float(qr_[h].x << 16) * rsq; xr[1] = __uint_as_float(qr_[h].x & 0xffff0000u) * rsq; xr[2] = __uint_as_float(qr_[h].y << 16) * rsq; xr[3] = __uint_as_float(qr_[h].y & 0xffff0000u) * rsq;
#pragma unroll
                    for (int i = 0; i < 4; ++i) ss += xr[i] * xr[i];
                    RED16(ss);
                    float rn = rsqrtf(ss * (1.f / 192.f) + EPS);
                    if (isl || need_ctx) {
                        bf16_t* qo = isl ? QB + ((size_t)((b * 8 + h) * SEQ + t)) * 192 : QCB + ((size_t)((b * 8 + h) * CTXL + t)) * 192;
                        u32x4 w; w.x = cvtpk(xn[0] * rn * qgn[0], xn[1] * rn * qgn[1]); w.y = cvtpk(xn[2] * rn * qgn[2], xn[3] * rn * qgn[3]); w.z = cvtpk(xn[4] * rn * qgn[4], xn[5] * rn * qgn[5]); w.w = cvtpk(xn[6] * rn * qgn[6], xn[7] * rn * qgn[7]);
                        *(u32x4*)(qo + 8 * l16) = w;
                        float yo[4];
#pragma unroll
                        for (int i = 0; i < 4; ++i) { const float v = xr[i] * rn * qgr[i]; const float pr = swz_xor<8>(v); yo[i] = xhi ? v * cs[i] + pr * sn[i] : v * cs[i] - pr * sn[i]; }
                        u32x2 w2; w2.x = cvtpk(yo[0], yo[1]); w2.y = cvtpk(yo[2], yo[3]); *(u32x2*)(qo + 128 + 4 * l16) = w2; }
                    float yn[8]; ss = krss;
#pragma unroll
                    for (int i = 0; i < 8; ++i) { yn[i] = bf2f_s(kn_[h][i]) * rskv; ss += yn[i] * yn[i]; }
                    RED16(ss);
                    rn = rsqrtf(ss * (1.f / 192.f) + EPS);
                    { bf16_t* ko = KB + ((size_t)((b * 8 + h) * NKEY + key)) * 192;
                      u32x4 w; w.x = cvtpk(yn[0] * rn * kgn[0], yn[1] * rn * kgn[1]); w.y = cvtpk(yn[2] * rn * kgn[2], yn[3] * rn * kgn[3]); w.z = cvtpk(yn[4] * rn * kgn[4], yn[5] * rn * kgn[5]); w.w = cvtpk(yn[6] * rn * kgn[6], yn[7] * rn * kgn[7]);
                      *(u32x4*)(ko + 8 * l16) = w;
                      const float kr4[4] = {krv.x, krv.y, krv.z, krv.w}; float yo[4];
#pragma unroll
                      for (int i = 0; i < 4; ++i) { const float v = kr4[i] * rn * kgr[i]; const float pr = swz_xor<8>(v); yo[i] = xhi ? v * cs[i] + pr * sn[i] : v * cs[i] - pr * sn[i]; }
                      u32x2 w2; w2.x = cvtpk(yo[0], yo[1]); w2.y = cvtpk(yo[2], yo[3]); *(u32x2*)(ko + 128 + 4 * l16) = w2;
                      bf16_t* vo = VB + ((size_t)((b * 8 + h) * NKEY + key)) * 128;
                      u32x4 wv; wv.x = cvtpk(bf2f_s(vn_[h][0]) * rskv, bf2f_s(vn_[h][1]) * rskv); wv.y = cvtpk(bf2f_s(vn_[h][2]) * rskv, bf2f_s(vn_[h][3]) * rskv);
                      wv.z = cvtpk(bf2f_s(vn_[h][4]) * rskv, bf2f_s(vn_[h][5]) * rskv); wv.w = cvtpk(bf2f_s(vn_[h][6]) * rskv, bf2f_s(vn_[h][7]) * rskv);
                      *(u32x4*)(vo + 8 * l16) = wv; }
                }
              }
#undef RED16
              __syncthreads(); }
            { LAS bf16_t* kwT = (LAS bf16_t*)lds; LAS bf16_t* vT = (LAS bf16_t*)(lds + TILE_B); LAS float* ar = (LAS float*)(lds + 4 * TILE_B);
              LAS float* a_li = ar, *a_lf = ar + 128, *a_b = ar + 256, *a_g = ar + 384, *a_w = ar + 512, *a_gt = ar + 640;
              const float* gb = INP(I_MGB) + l * 16;
              for (int rep_ = 0; rep_ <= DUP_ML; ++rep_)
              for (int u = bid; u < 1088; u += G) { const int j = u % 34, h = (u / 34) & 3, b = (u / 136) & 3, dir = u / 544, sc = (dir * 4 + b) * 4 + h; const int rowbase = ml_rowbase(dir, b, j);
                __syncthreads();
                bf16x8 kk[4], vv[4];
#pragma unroll
                for (int i = 0; i < 4; ++i) { const int idx = tid + NTHREADS * i, s = idx & 127, c8 = (idx >> 7) * 8; const int row = rowbase + (dir ? 127 - s : s);
                    kk[i] = *(const bf16x8*)(MLQK2 + (size_t)row * 1024 + 512 + h * 128 + c8); vv[i] = *(const bf16x8*)(MLV + (size_t)row * 512 + h * 128 + c8); }
                if (tid < 128) { const int row = rowbase + (dir ? 127 - tid : tid); const float* g = GATES + (size_t)row * 16;
                    a_li[tid] = g[dir * 4 + h] + gb[dir * 4 + h]; a_lf[tid] = logsigmoidf(g[(2 + dir) * 4 + h] + gb[(2 + dir) * 4 + h]); }
                __syncthreads();
                { float loc = 0.f; if (tid < 128) { loc = scan16_sum(a_lf, tid); if ((tid & 15) == 15) a_gt[tid >> 4] = loc; }
                  __syncthreads();
                  if (tid < 128) a_b[tid] = group_off_sum(a_gt, tid) + loc; }
                __syncthreads();
                if (tid < 128) a_g[tid] = a_b[127] - a_b[tid] + a_li[tid];
                __syncthreads();
                if (tid < 128) { float mx = a_g[0]; for (int i = 1; i < 128; ++i) mx = fmaxf(mx, a_g[i]); a_w[tid] = expf(a_g[tid] - mx); if (tid == 0) { MLOC[sc * 34 + j] = mx; BLAST[sc * 34 + j] = a_b[127]; } }
                __syncthreads();
#pragma unroll
                for (int q = 0; q < 4; ++q) { const int idx = tid + NTHREADS * q, s = idx & 127, c8 = (idx >> 7) * 8; const float wsv = a_w[s];
#pragma unroll
                    for (int i = 0; i < 8; ++i) { kwT[(c8 + i) * TP + s] = f2bf(bf2f_s(kk[q][i]) * wsv); vT[(c8 + i) * TP + s] = (bf16_t)vv[q][i]; } }
                __syncthreads();
                { const int nb = wave & 3, mh = wave >> 2; float* dst = CST + ((size_t)(sc * 34 + j)) * 16384;
#pragma unroll
                  for (int mt = 0; mt < 2; ++mt) { f32x16 acc = {}; mma128(acc, vT, 64 * mh + 32 * mt, kwT, 32 * nb, r32, hi);
#pragma unroll
                    for (int r = 0; r < 16; ++r) dst[(64 * mh + 32 * mt + crow(r, hi)) * 128 + 32 * nb + r32] = acc[r]; } }
                if (tid < 128) { float s = 0.f;
#pragma unroll
                    for (int i = 0; i < 16; ++i) { const bf16x8 kv = *(const LAS bf16x8*)(kwT + tid * TP + 8 * i);
#pragma unroll
                        for (int e = 0; e < 8; ++e) s += bf2f_s(kv[e]); }
                    MLN[((size_t)(sc * 34 + j)) * 128 + tid] = s; }
              }
              __syncthreads(); }
        PH_END
        PH_BEGIN(6)
            { const int nlat = NB * 8 * 16, nunits = nlat + (need_ctx ? NB * 8 : 0);
              for (int rp_ = 0; rp_ <= DUP_ATT; ++rp_)
              for (int u = bid; u < nunits; u += G) {
                const bf16_t* qp; bf16_t* op; int seq, bh;
                if (u < nlat) { const int xcd = u & 7, idx = ((u & 255) >> 3) + 32 * (u >> 8), qb = idx & 15; bh = xcd * 4 + (idx >> 4); const int h = bh & 7, b = bh >> 3;     qp = QB + ((size_t)(bh * SEQ + qb * 256)) * 192; op = AO + ((size_t)(b * SEQ + qb * 256)) * 1024 + h * 128; seq = NKEY; }
                else { const int v = u - nlat, h = v & 7, b = v >> 3; bh = b * 8 + h; qp = QCB + ((size_t)(bh * CTXL)) * 192; op = AO + ((size_t)(ML + b * CTXL)) * 1024 + h * 128; seq = CTXL; }
                att::attn_body(qp, KB + (size_t)bh * NKEY * 192, VB + (size_t)bh * NKEY * 128, op, 1024, seq, (char*)lds_raw, tid);
              } }
            for (long e = gtid; e < 131072 + 1024; e += GT) {
                int sc; float* base; int stride; bool lead = false;
                if (e < 131072) { sc = (int)(e >> 12); base = CST + (size_t)sc * 34 * 16384 + (e & 4095) * 4; stride = 16384; lead = (e & 4095) == 0; }
                else { const int e2 = (int)(e - 131072); sc = e2 >> 5; base = MLN + (size_t)sc * 34 * 128 + (e2 & 31) * 4; stride = 128; }
                float m = 0.f; f32x4 st = {0.f, 0.f, 0.f, 0.f};
#pragma unroll 1
                for (int jb = 0; jb < 34; jb += 17) { f32x4 tmp[17];
#pragma unroll
                    for (int k = 0; k < 17; ++k) tmp[k] = *(const f32x4*)(base + (size_t)(jb + k) * stride);
#pragma unroll
                    for (int k = 0; k < 17; ++k) { const int j = jb + k; const float ml = MLOC[sc * 34 + j], bl = BLAST[sc * 34 + j]; *(f32x4*)(base + (size_t)j * stride) = st;
                        const float mnew = fmaxf(bl + m, ml), a = expf(bl + m - mnew), wg = expf(ml - mnew); st = st * a + tmp[k] * wg; if (lead) MIN_[sc * 34 + j] = m; m = mnew; } }
            }
        PH_END
        PH_BEGIN(7)
            { LAS bf16_t* qs = (LAS bf16_t*)lds; LAS bf16_t* ks = (LAS bf16_t*)(lds + TILE_B); LAS bf16_t* vT = (LAS bf16_t*)(lds + 2 * TILE_B); LAS bf16_t* CT = (LAS bf16_t*)(lds + 3 * TILE_B);
              LAS float* ar = (LAS float*)(lds + 4 * TILE_B);
              LAS float* a_li = ar, *a_lf = ar + 128, *a_b = ar + 256, *a_u = ar + 384, *a_M = ar + 512, *a_iw = ar + 640, *a_rs = ar + 768, *a_dn = ar + 896, *a_n = ar + 1024, *a_gt = ar + 1152;
              const float* gb = INP(I_MGB) + l * 16;
              for (int rep_ = 0; rep_ <= DUP_ML; ++rep_)
              for (int u = bid; u < 1088; u += G) { const int j = u % 34, h = (u / 34) & 3, b = (u / 136) & 3, dir = u / 544, sc = (dir * 4 + b) * 4 + h; const int rowbase = ml_rowbase(dir, b, j);
                if (j < 2 && !need_ctx) continue;
                __syncthreads();
                bf16x8 rq[4], rk[4], rv[4]; f32x4 rc[8];
#pragma unroll
                for (int i = 0; i < 4; ++i) { const int idx = tid + NTHREADS * i; { const int s = idx >> 4, c8 = (idx & 15) * 8; const int row = rowbase + (dir ? 127 - s : s);
                        rq[i] = *(const bf16x8*)(MLQK2 + (size_t)row * 1024 + h * 128 + c8); rk[i] = *(const bf16x8*)(MLQK2 + (size_t)row * 1024 + 512 + h * 128 + c8); }
                    { const int s = idx & 127, c8 = (idx >> 7) * 8; const int row = rowbase + (dir ? 127 - s : s); rv[i] = *(const bf16x8*)(MLV + (size_t)row * 512 + h * 128 + c8); } }
                { const float* src = CST + ((size_t)(sc * 34 + j)) * 16384;
#pragma unroll
                  for (int i = 0; i < 8; ++i) rc[i] = *(const f32x4*)(src + (tid + NTHREADS * i) * 4); }
                const float m_in = MIN_[sc * 34 + j];
                if (tid < 128) { const int row = rowbase + (dir ? 127 - tid : tid); const float* g = GATES + (size_t)row * 16;
                    a_li[tid] = g[dir * 4 + h] + gb[dir * 4 + h]; a_lf[tid] = logsigmoidf(g[(2 + dir) * 4 + h] + gb[(2 + dir) * 4 + h]);
                    a_n[tid] = MLN[((size_t)(sc * 34 + j)) * 128 + tid]; }
                __syncthreads();
                { float loc = 0.f; if (tid < 128) { loc = scan16_sum(a_lf, tid); if ((tid & 15) == 15) a_gt[tid >> 4] = loc; }
                  __syncthreads();
                  if (tid < 128) { const float sb = group_off_sum(a_gt, tid) + loc; a_b[tid] = sb; a_u[tid] = a_li[tid] - sb; } }
                __syncthreads();
                { float loc = 0.f; if (tid < 128) { loc = scan16_max(a_u, tid); if ((tid & 15) == 15) a_gt[8 + (tid >> 4)] = loc; }
                  __syncthreads();
                  if (tid < 128) { const float mx = fmaxf(m_in, fmaxf(group_off_max(a_gt + 8, tid), loc)); a_M[tid] = mx; a_iw[tid] = expf(m_in - mx); } }
#pragma unroll
                for (int i = 0; i < 4; ++i) { const int idx = tid + NTHREADS * i; { const int s = idx >> 4, c8 = (idx & 15) * 8; *(LAS bf16x8*)(qs + s * TP + c8) = rq[i]; *(LAS bf16x8*)(ks + s * TP + c8) = rk[i]; }
                    { const int s = idx & 127, c8 = (idx >> 7) * 8;
#pragma unroll
                      for (int e = 0; e < 8; ++e) vT[(c8 + e) * TP + s] = (bf16_t)rv[i][e]; } }
#pragma unroll
                for (int i = 0; i < 8; ++i) { const int idx = tid + NTHREADS * i, e = idx >> 5, d = (idx & 31) * 4; u32x2 w; w.x = cvtpk(rc[i].x, rc[i].y); w.y = cvtpk(rc[i].z, rc[i].w); *(LAS u32x2*)(CT + e * TP + d) = w; }
                __syncthreads();
                const int tb = wave & 3, eh = wave >> 2;
                float rsum = 0.f; f32x16 o[2];
#pragma unroll
                for (int et = 0; et < 2; ++et) { o[et] = f32x16{}; mma128(o[et], qs, 32 * tb, CT, 64 * eh + 32 * et, r32, hi);
#pragma unroll
                    for (int r = 0; r < 16; ++r) o[et][r] *= a_iw[32 * tb + crow(r, hi)]; }
                { const float Mt = a_M[32 * tb + r32];
#pragma unroll 1
                  for (int st = 0; st <= tb; ++st) { f32x16 p = {}; mma128(p, ks, 32 * st, qs, 32 * tb, r32, hi);
#pragma unroll
                    for (int r = 0; r < 16; ++r) { const int s = 32 * st + crow(r, hi); const float v = (s <= 32 * tb + r32) ? p[r] * expf(a_u[s] - Mt) : 0.f; p[r] = v; rsum += v; }
                    bf16x8 pa0, pa1; PK4(p, 0, pa0); PK4(p, 8, pa1);
#pragma unroll
                    for (int et = 0; et < 2; ++et) { const LAS bf16_t* vp = vT + (64 * eh + 32 * et + r32) * TP + 32 * st + 8 * hi;
                        o[et] = __builtin_amdgcn_mfma_f32_32x32x16_bf16(pa0, *(const LAS bf16x8*)(vp), o[et], 0, 0, 0);
                        o[et] = __builtin_amdgcn_mfma_f32_32x32x16_bf16(pa1, *(const LAS bf16x8*)(vp + 16), o[et], 0, 0, 0); } } }
                rsum += xor32_get(rsum, hi);
                if (eh == 0 && hi == 0) a_rs[32 * tb + r32] = rsum;
                __syncthreads();
                if (tid < 128) { float qn = 0.f;
#pragma unroll
                    for (int i = 0; i < 16; ++i) { const bf16x8 qv = *(const LAS bf16x8*)(qs + tid * TP + 8 * i); const f32x4 n0 = *(const LAS f32x4*)(a_n + 8 * i), n1 = *(const LAS f32x4*)(a_n + 8 * i + 4);
                        qn += bf2f_s(qv[0]) * n0.x + bf2f_s(qv[1]) * n0.y + bf2f_s(qv[2]) * n0.z + bf2f_s(qv[3]) * n0.w + bf2f_s(qv[4]) * n1.x + bf2f_s(qv[5]) * n1.y + bf2f_s(qv[6]) * n1.z + bf2f_s(qv[7]) * n1.w; }
                    const float den = a_iw[tid] * qn + a_rs[tid]; a_dn[tid] = 1.f / fmaxf(fabsf(den), expf(-(a_b[tid] + a_M[tid]))); }
                __syncthreads();
                { bf16_t* Hd = dir ? HB : HF;
#pragma unroll
                  for (int et = 0; et < 2; ++et)
#pragma unroll
                    for (int r = 0; r < 16; ++r) { const int t = 32 * tb + crow(r, hi); const int row = rowbase + (dir ? 127 - t : t);
                        Hd[(size_t)row * 512 + h * 128 + 64 * eh + 32 * et + r32] = f2bf(o[et][r] * a_dn[t]); } }
              }
              __syncthreads(); }
        PH_END
        PH_BEGIN(8)
            { LAS float* ysm = (LAS float*)lds;
              const float* mg = INP(I_MIXG) + (size_t)l * 2048;
              const int ntile = need_ctx ? MT / 32 : ML / 32;
              for (int rp_ = 0; rp_ <= DUP_COMB; ++rp_)
              for (int tile = bid; tile < ntile; tile += G) { const int r0 = tile * 32;
                __syncthreads();
                { const bool isl = r0 < ML; const int b = isl ? r0 >> 12 : (r0 - ML) >> 8, t0 = isl ? r0 & 4095 : (r0 - ML) & 255; const bf16_t* src = isl ? YT + (size_t)b * 512 * 4096 + t0 : YTC + (size_t)b * 512 * 256 + t0; const int Ls = isl ? 4096 : 256;
                  for (int idx = tid; idx < 512 * 32; idx += NTHREADS) { const int c = idx >> 5, tt = idx & 31; ysm[c * 33 + tt] = bf2f(src[(size_t)c * Ls + tt]); } }
                __syncthreads();
#pragma unroll 2
                for (int q = 0; q < 4; ++q) { const int tt = wave * 4 + q, r = r0 + tt; bf16_t* orow = ABUF + (size_t)r * DM;
                    { const bf16x8 a0 = *(const bf16x8*)(AO + (size_t)r * 1024 + lane * 8), a1 = *(const bf16x8*)(AO + (size_t)r * 1024 + 512 + lane * 8); float x[16], ss = 0.f;
#pragma unroll
                      for (int i = 0; i < 8; ++i) { x[i] = bf2f_s(a0[i]); x[8 + i] = bf2f_s(a1[i]); ss += x[i] * x[i] + x[8 + i] * x[8 + i]; }
                      const float rs = rsqrtf(wave_sum(ss) * (1.f / 1024.f) + EPS);
#pragma unroll
                      for (int hh = 0; hh < 2; ++hh) { const float* gp = mg + hh * 512 + lane * 8; u32x4 o;
                        o.x = cvtpk(x[hh * 8 + 0] * rs * gp[0], x[hh * 8 + 1] * rs * gp[1]); o.y = cvtpk(x[hh * 8 + 2] * rs * gp[2], x[hh * 8 + 3] * rs * gp[3]);
                        o.z = cvtpk(x[hh * 8 + 4] * rs * gp[4], x[hh * 8 + 5] * rs * gp[5]); o.w = cvtpk(x[hh * 8 + 6] * rs * gp[6], x[hh * 8 + 7] * rs * gp[7]);
                        *(u32x4*)(orow + hh * 512 + lane * 8) = o; } }
                    { float y[8], ss = 0.f;
#pragma unroll
                      for (int i = 0; i < 8; ++i) { y[i] = ysm[(lane + 64 * i) * 33 + tt]; ss += y[i] * y[i]; }
                      const float rs = rsqrtf(wave_sum(ss) * (1.f / 512.f) + EPS);
#pragma unroll
                      for (int i = 0; i < 8; ++i) orow[1024 + lane + 64 * i] = f2bf(y[i] * rs * mg[1024 + lane + 64 * i]); }
                    {
#pragma unroll
                      for (int hh = 0; hh < 4; ++hh) { const int c = hh * 128 + 2 * lane; const unsigned fw = *(const unsigned*)(HF + (size_t)r * 512 + c), bw = *(const unsigned*)(HB + (size_t)r * 512 + c); const f32x2 f = {__uint_as_float(fw << 16), __uint_as_float(fw & 0xffff0000u)}, bk = {__uint_as_float(bw << 16), __uint_as_float(bw & 0xffff0000u)};
                        const float v0 = f.x + bk.x, v1 = f.y + bk.y; const float rs = rsqrtf(wave_sum(v0 * v0 + v1 * v1) * (1.f / 128.f) + EPS);
                        const unsigned ow = *(const unsigned*)(MLO + (size_t)r * 512 + c); const float o0 = __uint_as_float(ow << 16), o1 = __uint_as_float(ow & 0xffff0000u);
                        const float g0 = mg[1536 + c], g1 = mg[1536 + c + 1];
                        *(unsigned*)(orow + 1536 + c) = cvtpk(v0 * rs * g0 / (1.f + __expf(-o0)), v1 * rs * g1 / (1.f + __expf(-o1))); } }
                }
              }
              __syncthreads(); }
        PH_END
        constexpr int Mrows = need_ctx ? MT : ML;
        PH_BEGIN(9)
            pg8::Gemm g{ABUF, WOUT, Mrows, DM, DM}; pg8::EpiResid<l, 2> E{(l == 0 ? INP(I_X) : (const float*)OUT), OUT, ws};
            if constexpr (need_ctx) { pg8::SplitCtxOrder S; S.init(G, bid, DM); pg8::gemm_phase<pg8::EpiResid<l, 2>, pg8::SplitCtxOrder, true, true>(lds, g, S, E, tid); }
            else { pg8::StaticOrder S; S.init(Mrows, DM, G, bid, DM); pg8::gemm_phase<pg8::EpiResid<l, 2>, pg8::StaticOrder, true, true>(lds, g, S, E, tid); }
        PH_END
        PH_BEGIN(10)
            NORM_ROWS(l, INP(I_N2G) + l * DM, 3, Mrows, OUT);
        PH_END
        PH_BEGIN(11)
            pg8::Gemm g{ABUF, W1, Mrows, 2 * FFH, DM}; pg8::StaticOrder S; S.init(Mrows, 2 * FFH, G, bid, DM); pg8::EpiSwiglu E{ws};
            for (int rp_ = 0; rp_ <= DUP_W1; ++rp_) pg8::gemm_phase<pg8::EpiSwiglu, pg8::StaticOrder, true, true>(lds, g, S, E, tid);
        PH_END
        PH_BEGIN(12)
            pg8::Gemm g{HID, W2, Mrows, DM, FFH}; pg8::EpiResid<l, 5> E{(const float*)OUT, OUT, ws};
            if constexpr (need_ctx) { pg8::SplitCtxOrder S; S.init(G, bid, FFH); pg8::gemm_phase<pg8::EpiResid<l, 5>, pg8::SplitCtxOrder, true, true>(lds, g, S, E, tid); }
            else { pg8::StaticOrder S; S.init(Mrows, DM, G, bid, FFH); pg8::gemm_phase<pg8::EpiResid<l, 5>, pg8::StaticOrder, true, true>(lds, g, S, E, tid); }
        PH_END


    }
    { constexpr int l = 1; constexpr bool need_ctx = (l == 0);
        PH_BEGIN(2)
            NORM_ROWS(l, INP(I_N1G) + l * DM, 0, MT, (l == 0 ? (float*)INP(I_X) : OUT));
            if (l == 1) { __syncthreads(); CONVERT_WEIGHTS(1); __syncthreads(); BUILD_FILTERS(1); }
        PH_END
        PH_BEGIN(3)
            pg8::Gemm g{ABUF, WIN, MT, NINP, DM}; pg8::EpiInProj E{ws};
            if constexpr (l == 0) { pg8::StaticOrder S; S.init(MT, NINP, G, bid, DM); for (int rp_ = 0; rp_ <= DUP_INPROJ; ++rp_) pg8::gemm_phase<pg8::EpiInProj, pg8::StaticOrder, true, true>(lds, g, S, E, tid); }
            else { pg8::InProjL1Order S; S.init(G, bid, DM); for (int rp_ = 0; rp_ <= DUP_INPROJ; ++rp_) pg8::gemm_phase<pg8::EpiInProj, pg8::InProjL1Order, true, true>(lds, g, S, E, tid); }
        PH_END
        PH_BEGIN(4)
            { pg8::Gemm g{CQ, WUQ, MT, 1536, 512, CKV, WUKV}; pg8::DualUpOrder S; S.init(G, bid); pg8::EpiUp E{ws};
              for (int rp_ = 0; rp_ <= DUP_UP; ++rp_) pg8::gemm_phase<pg8::EpiUp, pg8::DualUpOrder, true, true>(lds, g, S, E, tid); }
            { const float* cw = INP(I_MCW) + (size_t)l * 3 * 1024; const float* cb = INP(I_MCB) + (size_t)l * 1024;
              for (int rp_ = 0; rp_ <= DUP_M0; ++rp_)
              for (long e = gtid; e < (long)MT * 128; e += GT) { const int r = (int)(e >> 7), c8 = (int)(e & 127) * 8;
                int t, L; if (r < ML) { t = r & 4095; L = SEQ; } else { t = (r - ML) & 255; L = CTXL; }
                const bf16x8 z = {0, 0, 0, 0, 0, 0, 0, 0};
                const bf16x8 xm = *(const bf16x8*)(MLQK + (size_t)r * 1024 + c8), xp = t > 0 ? *(const bf16x8*)(MLQK + (size_t)(r - 1) * 1024 + c8) : z, xn = t < L - 1 ? *(const bf16x8*)(MLQK + (size_t)(r + 1) * 1024 + c8) : z;
                float y[8]; const float qs = c8 < 512 ? 0.08838834764831845f : 1.f;
#pragma unroll
                for (int i = 0; i < 8; ++i) { const int c = c8 + i; y[i] = siluf(cb[c] + cw[c] * bf2f_s(xp[i]) + cw[1024 + c] * bf2f_s(xm[i]) + cw[2048 + c] * bf2f_s(xn[i])) * qs; }
                u32x4 o; o.x = cvtpk(y[0], y[1]); o.y = cvtpk(y[2], y[3]); o.z = cvtpk(y[4], y[5]); o.w = cvtpk(y[6], y[7]); *(u32x4*)(MLQK2 + (size_t)r * 1024 + c8) = o; } }
            { LAS f32x2* X = (LAS f32x2*)lds; LAS f32x2* Gs = (LAS f32x2*)(lds + FFT_SLOTS * 8); LAS float* w3s = (LAS float*)(lds + 2 * FFT_SLOTS * 8);
              const float* hcw = INP(I_HCW) + (size_t)l * 3 * 1536; const float* hcb = INP(I_HCB) + (size_t)l * 1536;
              const float* w3 = INP(I_HW3) + (size_t)l * 64 * 2048; const float* dec = INP(I_HDEC) + (size_t)l * 2048; const float* skip = INP(I_HSKIP) + (size_t)l * 1024;
              const float* H2 = H2L + (size_t)l * SEQ * 64;
              FftTw ftw; fft_load_tw(ftw, TW, tid);
              for (int rep_ = 0; rep_ <= DUP_HY; ++rep_)
              for (int c0 = bid; c0 < 512; c0 += G) { int c = c0; asm volatile("" : "+s"(c));
                const float vw0 = hcw[c], vw1 = hcw[1536 + c], vw2 = hcw[3072 + c], vbb = hcb[c];
                for (int n = 0; n < 2; ++n) {
                    const int of = n * 1024 + c, ob = n * 1024 + 512 + c;
                    __syncthreads();
                    { const float* ff = FILT + (size_t)of * 4096; const float* fb = FILT + (size_t)ob * 4096;
#pragma unroll 2
                      for (int q = 0; q < 8; ++q) { const int t = tid + 512 * q; Gs[fphys(t)] = (f32x2){ff[t], 0.f};
                        if (t == 0) Gs[fphys(4096)] = (f32x2){0.f, 0.f}; else Gs[fphys(8192 - t)] = (f32x2){fb[t], 0.f}; } }
                    __syncthreads();
                    fft_fwd_full(Gs, ftw, tid);
                    const float sk = skip[n * 512 + c];
                    const int gch = (n + 1) * 512 + c;
                    const float gw0 = hcw[gch], gw1 = hcw[1536 + gch], gw2 = hcw[3072 + gch], gbb = hcb[gch];
#pragma unroll 1
                    for (int bp = 0; bp < 2; ++bp) {
                        const bf16_t* u0 = HYT + ((size_t)((2 * bp) * 1536 + c)) * 4096; const bf16_t* u1 = HYT + ((size_t)((2 * bp + 1) * 1536 + c)) * 4096;
                        bf16_t* y0p = YT + ((size_t)((2 * bp) * 512 + c)) * 4096; bf16_t* y1p = YT + ((size_t)((2 * bp + 1) * 512 + c)) * 4096;
                        const bf16_t* g0p = HYT + ((size_t)((2 * bp) * 1536 + gch)) * 4096; const bf16_t* g1p = HYT + ((size_t)((2 * bp + 1) * 1536 + gch)) * 4096;
                        f32x2 zq[8], gq[8];
#pragma unroll
                        for (int q = 0; q < 8; ++q) { const int t = tid + 512 * q;
                            if (n == 0) { zq[q].x = conv3(u0, t, SEQ, vw0, vw1, vw2, vbb); zq[q].y = conv3(u1, t, SEQ, vw0, vw1, vw2, vbb); } else { zq[q].x = bf2f(y0p[t]); zq[q].y = bf2f(y1p[t]); }
                            gq[q].x = conv3(g0p, t, SEQ, gw0, gw1, gw2, gbb); gq[q].y = conv3(g1p, t, SEQ, gw0, gw1, gw2, gbb); }
#pragma unroll
                        for (int q = 0; q < 8; ++q) { const int t = tid + 512 * q; X[fphys(t)] = zq[q]; X[fphys(4096 + t)] = (f32x2){0.f, 0.f}; }
                        __syncthreads();
                        fft_conv(X, Gs, ftw, tid);
#pragma unroll
                        for (int q = 0; q < 8; ++q) { const int t = tid + 512 * q; const f32x2 y = X[fphys(t)] * (1.f / 8192.f);
                            y0p[t] = f2bf(gq[q].x * (y.x + sk * zq[q].x)); y1p[t] = f2bf(gq[q].y * (y.y + sk * zq[q].y)); }
                        __syncthreads();
                    }
                }
              }
              if (need_ctx) {
                LAS float* hf = (LAS float*)lds;
                LAS float* zs = (LAS float*)(lds + 4096);
                LAS float* w3c = (LAS float*)(lds + 8192);
                const float* H2c = H2C + (size_t)l * CTXL * 64;
                for (int c = bid; c < 512; c += G) {
                    __syncthreads();
                    if (tid < 256) { const int f = tid >> 6, i = tid & 63; w3c[tid] = w3[i * 2048 + (f >> 1) * 1024 + (f & 1) * 512 + c]; }
                    __syncthreads();
                    for (int e = tid; e < 1024; e += NTHREADS) { const int f = e >> 8, t = e & 255; const int o = (f >> 1) * 1024 + (f & 1) * 512 + c; float a = 0.f;
                        for (int i = 0; i < 64; ++i) a += H2c[t * 64 + i] * w3c[f * 64 + i];
                        hf[e] = a * (expf(-((float)t * (1.f / 256.f)) * dec[o]) + 0.05f); }
                    const int b = tid >> 7; float zv[2], zc[2];
#pragma unroll
                    for (int q = 0; q < 2; ++q) { const int t = (tid & 127) + 128 * q; zv[q] = conv3(HYTC + ((size_t)(b * 1536 + c)) * 256, t, CTXL, hcw[c], hcw[1536 + c], hcw[3072 + c], hcb[c]); zs[b * 256 + t] = zv[q]; }
                    __syncthreads();
                    for (int n = 0; n < 2; ++n) { const LAS float* gf = hf + n * 512; const LAS float* gb = hf + n * 512 + 256; const int gch = (n + 1) * 512 + c;
#pragma unroll
                        for (int q = 0; q < 2; ++q) { const int t = (tid & 127) + 128 * q; float y = 0.f;
                            for (int s = 0; s <= t; ++s) y += zs[b * 256 + s] * gf[t - s];
                            for (int s = t + 1; s < 256; ++s) y += zs[b * 256 + s] * gb[s - t];
                            const float gate = conv3(HYTC + ((size_t)(b * 1536 + gch)) * 256, t, CTXL, hcw[gch], hcw[1536 + gch], hcw[3072 + gch], hcb[gch]);
                            zc[q] = gate * (y + skip[n * 512 + c] * zv[q]); }
                        __syncthreads();
#pragma unroll
                        for (int q = 0; q < 2; ++q) { const int t = (tid & 127) + 128 * q; zv[q] = zc[q]; if (n == 0) zs[b * 256 + t] = zc[q]; else YTC[((size_t)(b * 512 + c)) * 256 + t] = f2bf(zc[q]); }
                        __syncthreads(); }
                }
              }
            }
        PH_END
        PH_BEGIN(5)
            { LAS f32x2* rtab = (LAS f32x2*)lds;
              __syncthreads();
              for (int e = tid; e < 1024; e += NTHREADS) { const float ang = (float)(e >> 4) * powf(10000.f, -(float)(e & 15) * (1.f / 16.f)); rtab[e] = (f32x2){cosf(ang), sinf(ang)}; }
              __syncthreads();
              const int l16 = lane & 15, ts = lane >> 4; const bool xhi = l16 >= 8, rowax = (l16 & 7) < 4; const int f0 = 4 * (l16 & 3);
              const float* qg = INP(I_QN) + l * 192; const float* kg = INP(I_KN) + l * 192;
              float qgn[8], kgn[8], qgr[4], kgr[4];
#pragma unroll
              for (int i = 0; i < 8; ++i) { qgn[i] = qg[8 * l16 + i]; kgn[i] = kg[8 * l16 + i]; }
#pragma unroll
              for (int i = 0; i < 4; ++i) { qgr[i] = qg[128 + 4 * l16 + i]; kgr[i] = kg[128 + 4 * l16 + i]; }
#define RED16(v) do { v += swz_xor<1>(v); v += swz_xor<2>(v); v += swz_xor<4>(v); v += swz_xor<8>(v); } while (0)
              for (int rp_ = 0; rp_ <= DUP_POST; ++rp_)
              for (int r0 = gw * 4; r0 < MT; r0 += NGW * 4) { const int r = r0 + ts;
                int b, t, key; const bool isl = r < ML; if (isl) { b = r >> 12; t = r & 4095; key = CTXL + t; } else { b = (r - ML) >> 8; t = (r - ML) & 255; key = t; }
                const bf16_t* qrow = QRAW + (size_t)r * 1536; const bf16_t* kvrow = KVRAW + (size_t)r * 2048;
                bf16x8 cqv[4], ckv4[4], qn_[8], kn_[8], vn_[8]; u32x2 qr_[8];
#pragma unroll
                for (int i = 0; i < 4; ++i) { cqv[i] = *(const bf16x8*)(CQ + (size_t)r * 512 + 32 * l16 + 8 * i); ckv4[i] = *(const bf16x8*)(CKV + (size_t)r * 512 + 32 * l16 + 8 * i); }
                const f32x4 krv = *(const f32x4*)(KROPE + (size_t)r * 64 + 4 * l16);
#pragma unroll
                for (int h = 0; h < 8; ++h) { qn_[h] = *(const bf16x8*)(qrow + h * 192 + 8 * l16); qr_[h] = *(const u32x2*)(qrow + h * 192 + 128 + 4 * l16);
                    kn_[h] = *(const bf16x8*)(kvrow + h * 256 + 8 * l16); vn_[h] = *(const bf16x8*)(kvrow + h * 256 + 128 + 8 * l16); }
                float ssq = 0.f, sskv = 0.f;
#pragma unroll
                for (int i = 0; i < 4; ++i)
#pragma unroll
                    for (int e = 0; e < 8; ++e) { const float x = bf2f_s(cqv[i][e]), y = bf2f_s(ckv4[i][e]); ssq += x * x; sskv += y * y; }
                RED16(ssq); RED16(sskv);
                const float rsq = rsqrtf(ssq * (1.f / 512.f) + EPS), rskv = rsqrtf(sskv * (1.f / 512.f) + EPS);
                float cs[4], sn[4];
#pragma unroll
                for (int i = 0; i < 4; ++i) { cs[i] = 1.f; sn[i] = 0.f; }
                if (isl) { const int pos = rowax ? (t >> 6) : (t & 63);
#pragma unroll
                    for (int i = 0; i < 4; ++i) { const f32x2 e = rtab[pos * 16 + f0 + i]; cs[i] = e.x; sn[i] = e.y; } }
                float krss = krv.x * krv.x + krv.y * krv.y + krv.z * krv.z + krv.w * krv.w;
#pragma unroll
                for (int h = 0; h < 8; ++h) {
                    float xn[8], xr[4]; float ss = 0.f;
#pragma unroll
                    for (int i = 0; i < 8; ++i) { xn[i] = bf2f_s(qn_[h][i]) * rsq; ss += xn[i] * xn[i]; }
                    xr[0] = __uint_as_float(qr_[h].x << 16) * rsq; xr[1] = __uint_as_float(qr_[h].x & 0xffff0000u) * rsq; xr[2] = __uint_as_float(qr_[h].y << 16) * rsq; xr[3] = __uint_as_float(qr_[h].y & 0xffff0000u) * rsq;
#pragma unroll
                    for (int i = 0; i < 4; ++i) ss += xr[i] * xr[i];
                    RED16(ss);
                    float rn = rsqrtf(ss * (1.f / 192.f) + EPS);
                    if (isl || need_ctx) {
                        bf16_t* qo = isl ? QB + ((size_t)((b * 8 + h) * SEQ + t)) * 192 : QCB + ((size_t)((b * 8 + h) * CTXL + t)) * 192;
                        u32x4 w; w.x = cvtpk(xn[0] * rn * qgn[0], xn[1] * rn * qgn[1]); w.y = cvtpk(xn[2] * rn * qgn[2], xn[3] * rn * qgn[3]); w.z = cvtpk(xn[4] * rn * qgn[4], xn[5] * rn * qgn[5]); w.w = cvtpk(xn[6] * rn * qgn[6], xn[7] * rn * qgn[7]);
                        *(u32x4*)(qo + 8 * l16) = w;
                        float yo[4];
#pragma unroll
                        for (int i = 0; i < 4; ++i) { const float v = xr[i] * rn * qgr[i]; const float pr = swz_xor<8>(v); yo[i] = xhi ? v * cs[i] + pr * sn[i] : v * cs[i] - pr * sn[i]; }
                        u32x2 w2; w2.x = cvtpk(yo[0], yo[1]); w2.y = cvtpk(yo[2], yo[3]); *(u32x2*)(qo + 128 + 4 * l16) = w2; }
                    float yn[8]; ss = krss;
#pragma unroll
                    for (int i = 0; i < 8; ++i) { yn[i] = bf2f_s(kn_[h][i]) * rskv; ss += yn[i] * yn[i]; }
                    RED16(ss);
                    rn = rsqrtf(ss * (1.f / 192.f) + EPS);
                    { bf16_t* ko = KB + ((size_t)((b * 8 + h) * NKEY + key)) * 192;
                      u32x4 w; w.x = cvtpk(yn[0] * rn * kgn[0], yn[1] * rn * kgn[1]); w.y = cvtpk(yn[2] * rn * kgn[2], yn[3] * rn * kgn[3]); w.z = cvtpk(yn[4] * rn * kgn[4], yn[5] * rn * kgn[5]); w.w = cvtpk(yn[6] * rn * kgn[6], yn[7] * rn * kgn[7]);
                      *(u32x4*)(ko + 8 * l16) = w;
                      const float kr4[4] = {krv.x, krv.y, krv.z, krv.w}; float yo[4];
#pragma unroll
                      for (int i = 0; i < 4; ++i) { const float v = kr4[i] * rn * kgr[i]; const float pr = swz_xor<8>(v); yo[i] = xhi ? v * cs[i] + pr * sn[i] : v * cs[i] - pr * sn[i]; }
                      u32x2 w2; w2.x = cvtpk(yo[0], yo[1]); w2.y = cvtpk(yo[2], yo[3]); *(u32x2*)(ko + 128 + 4 * l16) = w2;
                      bf16_t* vo = VB + ((size_t)((b * 8 + h) * NKEY + key)) * 128;
                      u32x4 wv; wv.x = cvtpk(bf2f_s(vn_[h][0]) * rskv, bf2f_s(vn_[h][1]) * rskv); wv.y = cvtpk(bf2f_s(vn_[h][2]) * rskv, bf2f_s(vn_[h][3]) * rskv);
                      wv.z = cvtpk(bf2f_s(vn_[h][4]) * rskv, bf2f_s(vn_[h][5]) * rskv); wv.w = cvtpk(bf2f_s(vn_[h][6]) * rskv, bf2f_s(vn_[h][7]) * rskv);
                      *(u32x4*)(vo + 8 * l16) = wv; }
                }
              }
#undef RED16
              __syncthreads(); }
            { LAS bf16_t* kwT = (LAS bf16_t*)lds; LAS bf16_t* vT = (LAS bf16_t*)(lds + TILE_B); LAS float* ar = (LAS float*)(lds + 4 * TILE_B);
              LAS float* a_li = ar, *a_lf = ar + 128, *a_b = ar + 256, *a_g = ar + 384, *a_w = ar + 512, *a_gt = ar + 640;
              const float* gb = INP(I_MGB) + l * 16;
              for (int rep_ = 0; rep_ <= DUP_ML; ++rep_)
              for (int u = bid; u < 1088; u += G) { const int j = u % 34, h = (u / 34) & 3, b = (u / 136) & 3, dir = u / 544, sc = (dir * 4 + b) * 4 + h; const int rowbase = ml_rowbase(dir, b, j);
                __syncthreads();
                bf16x8 kk[4], vv[4];
#pragma unroll
                for (int i = 0; i < 4; ++i) { const int idx = tid + NTHREADS * i, s = idx & 127, c8 = (idx >> 7) * 8; const int row = rowbase + (dir ? 127 - s : s);
                    kk[i] = *(const bf16x8*)(MLQK2 + (size_t)row * 1024 + 512 + h * 128 + c8); vv[i] = *(const bf16x8*)(MLV + (size_t)row * 512 + h * 128 + c8); }
                if (tid < 128) { const int row = rowbase + (dir ? 127 - tid : tid); const float* g = GATES + (size_t)row * 16;
                    a_li[tid] = g[dir * 4 + h] + gb[dir * 4 + h]; a_lf[tid] = logsigmoidf(g[(2 + dir) * 4 + h] + gb[(2 + dir) * 4 + h]); }
                __syncthreads();
                { float loc = 0.f; if (tid < 128) { loc = scan16_sum(a_lf, tid); if ((tid & 15) == 15) a_gt[tid >> 4] = loc; }
                  __syncthreads();
                  if (tid < 128) a_b[tid] = group_off_sum(a_gt, tid) + loc; }
                __syncthreads();
                if (tid < 128) a_g[tid] = a_b[127] - a_b[tid] + a_li[tid];
                __syncthreads();
                if (tid < 128) { float mx = a_g[0]; for (int i = 1; i < 128; ++i) mx = fmaxf(mx, a_g[i]); a_w[tid] = expf(a_g[tid] - mx); if (tid == 0) { MLOC[sc * 34 + j] = mx; BLAST[sc * 34 + j] = a_b[127]; } }
                __syncthreads();
#pragma unroll
                for (int q = 0; q < 4; ++q) { const int idx = tid + NTHREADS * q, s = idx & 127, c8 = (idx >> 7) * 8; const float wsv = a_w[s];
#pragma unroll
                    for (int i = 0; i < 8; ++i) { kwT[(c8 + i) * TP + s] = f2bf(bf2f_s(kk[q][i]) * wsv); vT[(c8 + i) * TP + s] = (bf16_t)vv[q][i]; } }
                __syncthreads();
                { const int nb = wave & 3, mh = wave >> 2; float* dst = CST + ((size_t)(sc * 34 + j)) * 16384;
#pragma unroll
                  for (int mt = 0; mt < 2; ++mt) { f32x16 acc = {}; mma128(acc, vT, 64 * mh + 32 * mt, kwT, 32 * nb, r32, hi);
#pragma unroll
                    for (int r = 0; r < 16; ++r) dst[(64 * mh + 32 * mt + crow(r, hi)) * 128 + 32 * nb + r32] = acc[r]; } }
                if (tid < 128) { float s = 0.f;
#pragma unroll
                    for (int i = 0; i < 16; ++i) { const bf16x8 kv = *(const LAS bf16x8*)(kwT + tid * TP + 8 * i);
#pragma unroll
                        for (int e = 0; e < 8; ++e) s += bf2f_s(kv[e]); }
                    MLN[((size_t)(sc * 34 + j)) * 128 + tid] = s; }
              }
              __syncthreads(); }
        PH_END
        PH_BEGIN(6)
            { const int nlat = NB * 8 * 16, nunits = nlat + (need_ctx ? NB * 8 : 0);
              for (int rp_ = 0; rp_ <= DUP_ATT; ++rp_)
              for (int u = bid; u < nunits; u += G) {
                const bf16_t* qp; bf16_t* op; int seq, bh;
                if (u < nlat) { const int xcd = u & 7, idx = ((u & 255) >> 3) + 32 * (u >> 8), qb = idx & 15; bh = xcd * 4 + (idx >> 4); const int h = bh & 7, b = bh >> 3;     qp = QB + ((size_t)(bh * SEQ + qb * 256)) * 192; op = AO + ((size_t)(b * SEQ + qb * 256)) * 1024 + h * 128; seq = NKEY; }
                else { const int v = u - nlat, h = v & 7, b = v >> 3; bh = b * 8 + h; qp = QCB + ((size_t)(bh * CTXL)) * 192; op = AO + ((size_t)(ML + b * CTXL)) * 1024 + h * 128; seq = CTXL; }
                att::attn_body(qp, KB + (size_t)bh * NKEY * 192, VB + (size_t)bh * NKEY * 128, op, 1024, seq, (char*)lds_raw, tid);
              } }
            for (long e = gtid; e < 131072 + 1024; e += GT) {
                int sc; float* base; int stride; bool lead = false;
                if (e < 131072) { sc = (int)(e >> 12); base = CST + (size_t)sc * 34 * 16384 + (e & 4095) * 4; stride = 16384; lead = (e & 4095) == 0; }
                else { const int e2 = (int)(e - 131072); sc = e2 >> 5; base = MLN + (size_t)sc * 34 * 128 + (e2 & 31) * 4; stride = 128; }
                float m = 0.f; f32x4 st = {0.f, 0.f, 0.f, 0.f};
#pragma unroll 1
                for (int jb = 0; jb < 34; jb += 17) { f32x4 tmp[17];
#pragma unroll
                    for (int k = 0; k < 17; ++k) tmp[k] = *(const f32x4*)(base + (size_t)(jb + k) * stride);
#pragma unroll
                    for (int k = 0; k < 17; ++k) { const int j = jb + k; const float ml = MLOC[sc * 34 + j], bl = BLAST[sc * 34 + j]; *(f32x4*)(base + (size_t)j * stride) = st;
                        const float mnew = fmaxf(bl + m, ml), a = expf(bl + m - mnew), wg = expf(ml - mnew); st = st * a + tmp[k] * wg; if (lead) MIN_[sc * 34 + j] = m; m = mnew; } }
            }
        PH_END
        PH_BEGIN(7)
            { LAS bf16_t* qs = (LAS bf16_t*)lds; LAS bf16_t* ks = (LAS bf16_t*)(lds + TILE_B); LAS bf16_t* vT = (LAS bf16_t*)(lds + 2 * TILE_B); LAS bf16_t* CT = (LAS bf16_t*)(lds + 3 * TILE_B);
              LAS float* ar = (LAS float*)(lds + 4 * TILE_B);
              LAS float* a_li = ar, *a_lf = ar + 128, *a_b = ar + 256, *a_u = ar + 384, *a_M = ar + 512, *a_iw = ar + 640, *a_rs = ar + 768, *a_dn = ar + 896, *a_n = ar + 1024, *a_gt = ar + 1152;
              const float* gb = INP(I_MGB) + l * 16;
              for (int rep_ = 0; rep_ <= DUP_ML; ++rep_)
              for (int u = bid; u < 1088; u += G) { const int j = u % 34, h = (u / 34) & 3, b = (u / 136) & 3, dir = u / 544, sc = (dir * 4 + b) * 4 + h; const int rowbase = ml_rowbase(dir, b, j);
                if (j < 2 && !need_ctx) continue;
                __syncthreads();
                bf16x8 rq[4], rk[4], rv[4]; f32x4 rc[8];
#pragma unroll
                for (int i = 0; i < 4; ++i) { const int idx = tid + NTHREADS * i; { const int s = idx >> 4, c8 = (idx & 15) * 8; const int row = rowbase + (dir ? 127 - s : s);
                        rq[i] = *(const bf16x8*)(MLQK2 + (size_t)row * 1024 + h * 128 + c8); rk[i] = *(const bf16x8*)(MLQK2 + (size_t)row * 1024 + 512 + h * 128 + c8); }
                    { const int s = idx & 127, c8 = (idx >> 7) * 8; const int row = rowbase + (dir ? 127 - s : s); rv[i] = *(const bf16x8*)(MLV + (size_t)row * 512 + h * 128 + c8); } }
                { const float* src = CST + ((size_t)(sc * 34 + j)) * 16384;
#pragma unroll
                  for (int i = 0; i < 8; ++i) rc[i] = *(const f32x4*)(src + (tid + NTHREADS * i) * 4); }
                const float m_in = MIN_[sc * 34 + j];
                if (tid < 128) { const int row = rowbase + (dir ? 127 - tid : tid); const float* g = GATES + (size_t)row * 16;
                    a_li[tid] = g[dir * 4 + h] + gb[dir * 4 + h]; a_lf[tid] = logsigmoidf(g[(2 + dir) * 4 + h] + gb[(2 + dir) * 4 + h]);
                    a_n[tid] = MLN[((size_t)(sc * 34 + j)) * 128 + tid]; }
                __syncthreads();
                { float loc = 0.f; if (tid < 128) { loc = scan16_sum(a_lf, tid); if ((tid & 15) == 15) a_gt[tid >> 4] = loc; }
                  __syncthreads();
                  if (tid < 128) { const float sb = group_off_sum(a_gt, tid) + loc; a_b[tid] = sb; a_u[tid] = a_li[tid] - sb; } }
                __syncthreads();
                { float loc = 0.f; if (tid < 128) { loc = scan16_max(a_u, tid); if ((tid & 15) == 15) a_gt[8 + (tid >> 4)] = loc; }
                  __syncthreads();
                  if (tid < 128) { const float mx = fmaxf(m_in, fmaxf(group_off_max(a_gt + 8, tid), loc)); a_M[tid] = mx; a_iw[tid] = expf(m_in - mx); } }
#pragma unroll
                for (int i = 0; i < 4; ++i) { const int idx = tid + NTHREADS * i; { const int s = idx >> 4, c8 = (idx & 15) * 8; *(LAS bf16x8*)(qs + s * TP + c8) = rq[i]; *(LAS bf16x8*)(ks + s * TP + c8) = rk[i]; }
                    { const int s = idx & 127, c8 = (idx >> 7) * 8;
#pragma unroll
                      for (int e = 0; e < 8; ++e) vT[(c8 + e) * TP + s] = (bf16_t)rv[i][e]; } }
#pragma unroll
                for (int i = 0; i < 8; ++i) { const int idx = tid + NTHREADS * i, e = idx >> 5, d = (idx & 31) * 4; u32x2 w; w.x = cvtpk(rc[i].x, rc[i].y); w.y = cvtpk(rc[i].z, rc[i].w); *(LAS u32x2*)(CT + e * TP + d) = w; }
                __syncthreads();
                const int tb = wave & 3, eh = wave >> 2;
                float rsum = 0.f; f32x16 o[2];
#pragma unroll
                for (int et = 0; et < 2; ++et) { o[et] = f32x16{}; mma128(o[et], qs, 32 * tb, CT, 64 * eh + 32 * et, r32, hi);
#pragma unroll
                    for (int r = 0; r < 16; ++r) o[et][r] *= a_iw[32 * tb + crow(r, hi)]; }
                { const float Mt = a_M[32 * tb + r32];
#pragma unroll 1
                  for (int st = 0; st <= tb; ++st) { f32x16 p = {}; mma128(p, ks, 32 * st, qs, 32 * tb, r32, hi);
#pragma unroll
                    for (int r = 0; r < 16; ++r) { const int s = 32 * st + crow(r, hi); const float v = (s <= 32 * tb + r32) ? p[r] * expf(a_u[s] - Mt) : 0.f; p[r] = v; rsum += v; }
                    bf16x8 pa0, pa1; PK4(p, 0, pa0); PK4(p, 8, pa1);
#pragma unroll
                    for (int et = 0; et < 2; ++et) { const LAS bf16_t* vp = vT + (64 * eh + 32 * et + r32) * TP + 32 * st + 8 * hi;
                        o[et] = __builtin_amdgcn_mfma_f32_32x32x16_bf16(pa0, *(const LAS bf16x8*)(vp), o[et], 0, 0, 0);
                        o[et] = __builtin_amdgcn_mfma_f32_32x32x16_bf16(pa1, *(const LAS bf16x8*)(vp + 16), o[et], 0, 0, 0); } } }
                rsum += xor32_get(rsum, hi);
                if (eh == 0 && hi == 0) a_rs[32 * tb + r32] = rsum;
                __syncthreads();
                if (tid < 128) { float qn = 0.f;
#pragma unroll
                    for (int i = 0; i < 16; ++i) { const bf16x8 qv = *(const LAS bf16x8*)(qs + tid * TP + 8 * i); const f32x4 n0 = *(const LAS f32x4*)(a_n + 8 * i), n1 = *(const LAS f32x4*)(a_n + 8 * i + 4);
                        qn += bf2f_s(qv[0]) * n0.x + bf2f_s(qv[1]) * n0.y + bf2f_s(qv[2]) * n0.z + bf2f_s(qv[3]) * n0.w + bf2f_s(qv[4]) * n1.x + bf2f_s(qv[5]) * n1.y + bf2f_s(qv[6]) * n1.z + bf2f_s(qv[7]) * n1.w; }
                    const float den = a_iw[tid] * qn + a_rs[tid]; a_dn[tid] = 1.f / fmaxf(fabsf(den), expf(-(a_b[tid] + a_M[tid]))); }
                __syncthreads();
                { bf16_t* Hd = dir ? HB : HF;
#pragma unroll
                  for (int et = 0; et < 2; ++et)
#pragma unroll
                    for (int r = 0; r < 16; ++r) { const int t = 32 * tb + crow(r, hi); const int row = rowbase + (dir ? 127 - t : t);
                        Hd[(size_t)row * 512 + h * 128 + 64 * eh + 32 * et + r32] = f2bf(o[et][r] * a_dn[t]); } }
              }
              __syncthreads(); }
        PH_END
        PH_BEGIN(8)
            { LAS float* ysm = (LAS float*)lds;
              const float* mg = INP(I_MIXG) + (size_t)l * 2048;
              const int ntile = need_ctx ? MT / 32 : ML / 32;
              for (int rp_ = 0; rp_ <= DUP_COMB; ++rp_)
              for (int tile = bid; tile < ntile; tile += G) { const int r0 = tile * 32;
                __syncthreads();
                { const bool isl = r0 < ML; const int b = isl ? r0 >> 12 : (r0 - ML) >> 8, t0 = isl ? r0 & 4095 : (r0 - ML) & 255; const bf16_t* src = isl ? YT + (size_t)b * 512 * 4096 + t0 : YTC + (size_t)b * 512 * 256 + t0; const int Ls = isl ? 4096 : 256;
                  for (int idx = tid; idx < 512 * 32; idx += NTHREADS) { const int c = idx >> 5, tt = idx & 31; ysm[c * 33 + tt] = bf2f(src[(size_t)c * Ls + tt]); } }
                __syncthreads();
#pragma unroll 2
                for (int q = 0; q < 4; ++q) { const int tt = wave * 4 + q, r = r0 + tt; bf16_t* orow = ABUF + (size_t)r * DM;
                    { const bf16x8 a0 = *(const bf16x8*)(AO + (size_t)r * 1024 + lane * 8), a1 = *(const bf16x8*)(AO + (size_t)r * 1024 + 512 + lane * 8); float x[16], ss = 0.f;
#pragma unroll
                      for (int i = 0; i < 8; ++i) { x[i] = bf2f_s(a0[i]); x[8 + i] = bf2f_s(a1[i]); ss += x[i] * x[i] + x[8 + i] * x[8 + i]; }
                      const float rs = rsqrtf(wave_sum(ss) * (1.f / 1024.f) + EPS);
#pragma unroll
                      for (int hh = 0; hh < 2; ++hh) { const float* gp = mg + hh * 512 + lane * 8; u32x4 o;
                        o.x = cvtpk(x[hh * 8 + 0] * rs * gp[0], x[hh * 8 + 1] * rs * gp[1]); o.y = cvtpk(x[hh * 8 + 2] * rs * gp[2], x[hh * 8 + 3] * rs * gp[3]);
                        o.z = cvtpk(x[hh * 8 + 4] * rs * gp[4], x[hh * 8 + 5] * rs * gp[5]); o.w = cvtpk(x[hh * 8 + 6] * rs * gp[6], x[hh * 8 + 7] * rs * gp[7]);
                        *(u32x4*)(orow + hh * 512 + lane * 8) = o; } }
                    { float y[8], ss = 0.f;
#pragma unroll
                      for (int i = 0; i < 8; ++i) { y[i] = ysm[(lane + 64 * i) * 33 + tt]; ss += y[i] * y[i]; }
                      const float rs = rsqrtf(wave_sum(ss) * (1.f / 512.f) + EPS);
#pragma unroll
                      for (int i = 0; i < 8; ++i) orow[1024 + lane + 64 * i] = f2bf(y[i] * rs * mg[1024 + lane + 64 * i]); }
                    {
#pragma unroll
                      for (int hh = 0; hh < 4; ++hh) { const int c = hh * 128 + 2 * lane; const unsigned fw = *(const unsigned*)(HF + (size_t)r * 512 + c), bw = *(const unsigned*)(HB + (size_t)r * 512 + c); const f32x2 f = {__uint_as_float(fw << 16), __uint_as_float(fw & 0xffff0000u)}, bk = {__uint_as_float(bw << 16), __uint_as_float(bw & 0xffff0000u)};
                        const float v0 = f.x + bk.x, v1 = f.y + bk.y; const float rs = rsqrtf(wave_sum(v0 * v0 + v1 * v1) * (1.f / 128.f) + EPS);
                        const unsigned ow = *(const unsigned*)(MLO + (size_t)r * 512 + c); const float o0 = __uint_as_float(ow << 16), o1 = __uint_as_float(ow & 0xffff0000u);
                        const float g0 = mg[1536 + c], g1 = mg[1536 + c + 1];
                        *(unsigned*)(orow + 1536 + c) = cvtpk(v0 * rs * g0 / (1.f + __expf(-o0)), v1 * rs * g1 / (1.f + __expf(-o1))); } }
                }
              }
              __syncthreads(); }
        PH_END
        constexpr int Mrows = need_ctx ? MT : ML;
        PH_BEGIN(9)
            pg8::Gemm g{ABUF, WOUT, Mrows, DM, DM}; pg8::EpiResid<l, 2> E{(l == 0 ? INP(I_X) : (const float*)OUT), OUT, ws};
            if constexpr (need_ctx) { pg8::SplitCtxOrder S; S.init(G, bid, DM); pg8::gemm_phase<pg8::EpiResid<l, 2>, pg8::SplitCtxOrder, true, true>(lds, g, S, E, tid); }
            else { pg8::StaticOrder S; S.init(Mrows, DM, G, bid, DM); pg8::gemm_phase<pg8::EpiResid<l, 2>, pg8::StaticOrder, true, true>(lds, g, S, E, tid); }
        PH_END
        PH_BEGIN(10)
            NORM_ROWS(l, INP(I_N2G) + l * DM, 3, Mrows, OUT);
        PH_END
        PH_BEGIN(11)
            pg8::Gemm g{ABUF, W1, Mrows, 2 * FFH, DM}; pg8::StaticOrder S; S.init(Mrows, 2 * FFH, G, bid, DM); pg8::EpiSwiglu E{ws};
            for (int rp_ = 0; rp_ <= DUP_W1; ++rp_) pg8::gemm_phase<pg8::EpiSwiglu, pg8::StaticOrder, true, true>(lds, g, S, E, tid);
        PH_END
        PH_BEGIN(12)
            pg8::Gemm g{HID, W2, Mrows, DM, FFH}; pg8::EpiResid<l, 5> E{(const float*)OUT, OUT, ws};
            if constexpr (need_ctx) { pg8::SplitCtxOrder S; S.init(G, bid, FFH); pg8::gemm_phase<pg8::EpiResid<l, 5>, pg8::SplitCtxOrder, true, true>(lds, g, S, E, tid); }
            else { pg8::StaticOrder S; S.init(Mrows, DM, G, bid, FFH); pg8::gemm_phase<pg8::EpiResid<l, 5>, pg8::StaticOrder, true, true>(lds, g, S, E, tid); }
        PH_END


    }
#undef PH_BEGIN
#undef PH_END
}

extern "C" void kernel_launch(void* const* d_in, const int* in_sizes, int n_in, void* d_out, int out_size, void* d_ws, size_t ws_size, hipStream_t stream) {
    static int grid = 0;
    if (grid == 0) {
        if (n_in != 31 || out_size != ML * DM || ws_size < WS_END) { fprintf(stderr, "kernel_launch: unexpected shapes n_in %d out %d ws %zu (need %zu)\n", n_in, out_size, ws_size, (size_t)WS_END); grid = -1; return; }
        int dev = 0, cus = 0, per_cu = 0;
        hipGetDevice(&dev); hipDeviceGetAttribute(&cus, hipDeviceAttributeMultiprocessorCount, dev);
        if (hipFuncSetAttribute((const void*)fwd_kernel, hipFuncAttributeMaxDynamicSharedMemorySize, LDS_BYTES) != hipSuccess) { fprintf(stderr, "kernel_launch: hipFuncSetAttribute failed\n"); grid = -1; return; }
        if (hipOccupancyMaxActiveBlocksPerMultiprocessor(&per_cu, (const void*)fwd_kernel, NTHREADS, LDS_BYTES) != hipSuccess || per_cu < 1) { fprintf(stderr, "kernel_launch: occupancy query gave %d\n", per_cu); per_cu = 1; }
        (void)hipGetLastError();
        grid = cus * 1;
        fprintf(stderr, "kernel_launch: grid %d (cus %d, per_cu %d)\n", grid, cus, per_cu);
    }
    if (grid < 0) return;
    if (hipMemsetAsync(d_ws, 0, 65536, stream) != hipSuccess) { fprintf(stderr, "kernel_launch: memset failed\n"); return; }
    Args a{};
    for (int i = 0; i < 31; ++i) a.in[i] = (const float*)d_in[i];
    a.out = (float*)d_out; a.ws = (unsigned char*)d_ws; a.ph_lo = 0; a.ph_hi = 0;
    void* kargs[] = {&a};
    hipError_t e = hipLaunchCooperativeKernel((const void*)fwd_kernel, dim3(grid), dim3(NTHREADS), kargs, LDS_BYTES, stream);
    if (e != hipSuccess) fprintf(stderr, "kernel_launch: cooperative launch failed: %s (grid %d)\n", hipGetErrorString(e), grid);
}
```
